# Optimizing an MI355X kernel written in HIP

```python
import math
import jax, jax.numpy as jnp
from jax import lax
import numpy as np

D_MODEL = 1024
BATCH = 8
SEQ = 4096
DEPTH = 2

D_MIX = D_MODEL
SSD_INNER = D_MODEL // 2
SSD_HEAD_DIM = 64
SSD_HEADS = SSD_INNER // SSD_HEAD_DIM
SSD_GROUPS = 2
SSD_HEADS_PER_GROUP = SSD_HEADS // SSD_GROUPS
SSD_STATE = 64
SSD_CONV = 4
SSD_CHUNK = 128
SSD_CONV_DIM = SSD_INNER + 2 * SSD_GROUPS * SSD_STATE
DT_MIN = 0.001
DT_MAX = 0.1
MLA_HEADS = 4
MLA_Q_RANK = D_MODEL // 4
MLA_KV_RANK = D_MODEL // 8
MLA_NOPE = 64
MLA_ROPE = 32
MLA_V = 64
MLA_OUT = MLA_HEADS * MLA_V
MLA_SCALE = (MLA_NOPE + MLA_ROPE) ** -0.5
MLA_Q_BLOCK = 128
ROPE_THETA = 10000.0
GM_GROUPS = 4
GM_GROUP_DIM = 64
GM_WIDTH = GM_GROUPS * GM_GROUP_DIM
GM_CHUNK = 128
IN_SIZES = (SSD_INNER, SSD_INNER, SSD_GROUPS * SSD_STATE, SSD_GROUPS * SSD_STATE, SSD_HEADS,
            MLA_Q_RANK, MLA_KV_RANK, MLA_ROPE, GM_WIDTH, GM_WIDTH)
D_IN = sum(IN_SIZES)
D_FF = 2816
N_EXPERTS = 8
TOP_K = 2
DN_ALPHA = (2 * DEPTH) ** 0.25
DN_BETA = (8 * DEPTH) ** -0.25
LN_EPS = 1e-5
RMS_EPS = 1e-6
ADA_SCALE = 0.3

kernel_name = "hymba_ssd_mla_gmlp_moe_deepnorm_adaln"


def layer_norm(x, g, b):
    xf = x.astype(jnp.float32)
    mu = jnp.mean(xf, axis=-1, keepdims=True)
    var = jnp.mean(jnp.square(xf - mu), axis=-1, keepdims=True)
    return ((xf - mu) * lax.rsqrt(var + LN_EPS)).astype(x.dtype) * g + b


def rms_norm(x, g):
    xf = x.astype(jnp.float32)
    return (xf * lax.rsqrt(jnp.mean(jnp.square(xf), axis=-1, keepdims=True) + RMS_EPS)).astype(x.dtype) * g


def modulation(c, w, b):
    m = jnp.einsum("bd,de->be", jax.nn.silu(c), w) + b
    shift, scale, gate = jnp.split(m, 3, axis=-1)
    return shift[:, None], scale[:, None], gate[:, None]


def causal_depthwise_conv(x, w, b):
    k, ch = w.shape
    y = lax.conv_general_dilated(x, w[:, None, :], window_strides=(1,), padding=[(k - 1, 0)],
                                 dimension_numbers=("NWC", "WIO", "NWC"), feature_group_count=ch)
    return y + b


def segsum(a):
    n = a.shape[-1]
    cs = jnp.cumsum(a, axis=-1)
    diff = cs[..., :, None] - cs[..., None, :]
    return jnp.where(jnp.tril(jnp.ones((n, n), dtype=bool)), diff, -jnp.inf)


def ssd_scan(xs, bm, cm, dt, a_log, d_skip):
    b, t, _ = xs.shape
    nc, l = t // SSD_CHUNK, SSD_CHUNK
    g, r, p, n = SSD_GROUPS, SSD_HEADS_PER_GROUP, SSD_HEAD_DIM, SSD_STATE
    x = xs.reshape(b, nc, l, g, r, p)
    bc = bm.reshape(b, nc, l, g, n).astype(jnp.float32)
    cc = cm.reshape(b, nc, l, g, n).astype(jnp.float32)
    dtc = dt.reshape(b, nc, l, g, r)
    a_head = -jnp.exp(a_log.astype(jnp.float32)).reshape(g, r)
    a = jnp.transpose(dtc * a_head, (0, 3, 4, 1, 2))
    a_cs = jnp.cumsum(a, axis=-1)
    xdt = x.astype(jnp.float32) * dtc[..., None]
    decay_in = jnp.exp(segsum(a))
    cb = jnp.einsum("bclgn,bcsgn->bcgls", cc, bc)
    y_diag = jnp.einsum("bcgls,bgrcls,bcsgrp->bclgrp", cb, decay_in, xdt)
    decay_states = jnp.exp(a_cs[..., -1:] - a_cs)
    states = jnp.einsum("bcsgn,bgrcs,bcsgrp->bcgrpn", bc, decay_states, xdt)
    states = jnp.concatenate([jnp.zeros_like(states[:, :1]), states], axis=1)
    chunk_a = jnp.pad(a_cs[..., -1], ((0, 0), (0, 0), (0, 0), (1, 0)))
    decay_chunk = jnp.exp(segsum(chunk_a))
    states = jnp.einsum("bgrzc,bcgrpn->bzgrpn", decay_chunk, states)[:, :-1]
    y_off = jnp.einsum("bclgn,bcgrpn,bgrcl->bclgrp", cc, states, jnp.exp(a_cs))
    y = y_diag + y_off + x.astype(jnp.float32) * d_skip.astype(jnp.float32).reshape(g, r)[:, :, None]
    return y.reshape(b, t, SSD_INNER).astype(xs.dtype)


def gated_group_rmsnorm(y, z, w):
    gy = y * jax.nn.silu(z)
    b, t, _ = gy.shape
    gf = gy.reshape(b, t, SSD_GROUPS, SSD_INNER // SSD_GROUPS).astype(jnp.float32)
    gf = gf * lax.rsqrt(jnp.mean(jnp.square(gf), axis=-1, keepdims=True) + RMS_EPS)
    return gf.reshape(b, t, SSD_INNER).astype(y.dtype) * w


def rope_tables(t):
    inv = ROPE_THETA ** (-jnp.arange(0, MLA_ROPE, 2, dtype=jnp.float32) / MLA_ROPE)
    ang = jnp.arange(t, dtype=jnp.float32)[:, None] * inv[None, :]
    return jnp.cos(ang), jnp.sin(ang)


def apply_rope(x, cos, sin):
    x1, x2 = jnp.split(x.astype(jnp.float32), 2, axis=-1)
    return jnp.concatenate([x1 * cos - x2 * sin, x1 * sin + x2 * cos], axis=-1).astype(x.dtype)


def mla_attention(q_nope, q_pe, k_nope, k_pe, v):
    b, t, h, _ = q_nope.shape
    nb = t // MLA_Q_BLOCK
    qn = jnp.moveaxis(q_nope.reshape(b, nb, MLA_Q_BLOCK, h, MLA_NOPE), 1, 0)
    qp = jnp.moveaxis(q_pe.reshape(b, nb, MLA_Q_BLOCK, h, MLA_ROPE), 1, 0)
    kpos = jnp.arange(t)

    def block(args):
        qn_b, qp_b, i = args
        s = (jnp.einsum("bqhd,bkhd->bhqk", qn_b, k_nope)
             + jnp.einsum("bqhd,bkd->bhqk", qp_b, k_pe)).astype(jnp.float32) * MLA_SCALE
        qpos = i * MLA_Q_BLOCK + jnp.arange(MLA_Q_BLOCK)
        s = jnp.where(kpos[None, :] <= qpos[:, None], s, -jnp.inf)
        pr = jax.nn.softmax(s, axis=-1).astype(v.dtype)
        return jnp.einsum("bhqk,bkhd->bqhd", pr, v)

    out = lax.map(block, (qn, qp, jnp.arange(nb)))
    return jnp.moveaxis(out, 0, 1).reshape(b, t, h * MLA_V)


def spatial_gating(gu, gv, ln_g, ln_b, w_s, b_s):
    gu = jax.nn.gelu(gu, approximate=False)
    gv = layer_norm(jax.nn.gelu(gv, approximate=False), ln_g, ln_b)
    b, t, _ = gv.shape
    vc = gv.reshape(b, t // GM_CHUNK, GM_CHUNK, GM_GROUPS, GM_GROUP_DIM)
    w = w_s * jnp.tril(jnp.ones((GM_CHUNK, GM_CHUNK), dtype=w_s.dtype))
    s = jnp.einsum("gts,bcsgd->bctgd", w, vc) + jnp.transpose(b_s)[:, :, None]
    return gu * s.reshape(b, t, GM_WIDTH)


def hybrid_mixer(h, cos, sin, w_in, conv_w, conv_b, dt_bias, a_log, d_skip, ssd_norm_w,
                 q_norm, w_qb, kv_norm, w_kvb, gm_ln_g, gm_ln_b, gm_w_s, gm_b_s, w_out):
    b, t, _ = h.shape
    proj = jnp.einsum("btd,de->bte", h, w_in)
    split_at = np.cumsum(IN_SIZES)[:-1].tolist()
    z, xs, bm, cm, dt, q_lat, kv_lat, k_pe, gu, gv = jnp.split(proj, split_at, axis=-1)
    xbc = jax.nn.silu(causal_depthwise_conv(jnp.concatenate([xs, bm, cm], axis=-1), conv_w, conv_b))
    xs, bm, cm = jnp.split(xbc, [SSD_INNER, SSD_INNER + SSD_GROUPS * SSD_STATE], axis=-1)
    dt = jax.nn.softplus(dt.astype(jnp.float32) + dt_bias.astype(jnp.float32))
    y_ssd = gated_group_rmsnorm(ssd_scan(xs, bm, cm, dt, a_log, d_skip), z, ssd_norm_w)
    q = jnp.einsum("btr,re->bte", rms_norm(q_lat, q_norm), w_qb).reshape(b, t, MLA_HEADS, MLA_NOPE + MLA_ROPE)
    q_nope, q_pe = jnp.split(q, [MLA_NOPE], axis=-1)
    q_pe = apply_rope(q_pe, cos[:, None, :], sin[:, None, :])
    kv = jnp.einsum("btr,re->bte", rms_norm(kv_lat, kv_norm), w_kvb).reshape(b, t, MLA_HEADS, MLA_NOPE + MLA_V)
    k_nope, v_heads = jnp.split(kv, [MLA_NOPE], axis=-1)
    k_pe = apply_rope(k_pe, cos, sin)
    y_mla = mla_attention(q_nope, q_pe, k_nope, k_pe, v_heads)
    y_gm = spatial_gating(gu, gv, gm_ln_g, gm_ln_b, gm_w_s, gm_b_s)
    y = jnp.concatenate([y_ssd, y_mla.astype(y_ssd.dtype), y_gm.astype(y_ssd.dtype)], axis=-1)
    return jnp.einsum("bte,ed->btd", y, w_out)


def swiglu(h, w1, w3, w2):
    a = jnp.einsum("btd,df->btf", h, w1)
    g = jnp.einsum("btd,df->btf", h, w3)
    return jnp.einsum("btf,fd->btd", jax.nn.silu(a) * g, w2)


def moe_swiglu(h, w_router, w1, w3, w2):
    logits = jnp.einsum("btd,de->bte", h, w_router).astype(jnp.float32)
    top_v, top_i = lax.top_k(logits, TOP_K)
    gates = jax.nn.softmax(top_v, axis=-1)
    combine = jnp.sum(jax.nn.one_hot(top_i, N_EXPERTS, dtype=jnp.float32) * gates[..., None], axis=-2)
    combine = combine.astype(h.dtype)
    out = jnp.zeros_like(h)
    for e in range(N_EXPERTS):
        out = out + combine[..., e:e + 1] * swiglu(h, w1[e], w3[e], w2[e])
    return out


def setup_inputs(seed: int = 0) -> dict:
    key = jax.random.key(seed)
    ks = iter(jax.random.split(key, 40))
    f32 = jnp.float32

    def nrm(shape, scale):
        return jax.random.normal(next(ks), shape, f32) * scale

    def gain(shape):
        return 1.0 + nrm(shape, 0.02)

    def bias(shape):
        return nrm(shape, 0.02)

    n_dense = (DEPTH + 1) // 2
    n_moe = DEPTH // 2
    u = jax.random.uniform(next(ks), (DEPTH, SSD_HEADS), f32)
    dt0 = jnp.exp(u * (math.log(DT_MAX) - math.log(DT_MIN)) + math.log(DT_MIN))
    dt_bias = dt0 + jnp.log(-jnp.expm1(-dt0))
    a_log = jnp.log(jax.random.uniform(next(ks), (DEPTH, SSD_HEADS), f32, 1.0, 16.0))
    return {
        "x": nrm((BATCH, SEQ, D_MODEL), 1.0),
        "c": nrm((BATCH, D_MODEL), 1.0),
        "ln0_g": gain((D_MODEL,)),
        "ln0_b": bias((D_MODEL,)),
        "ada_w": nrm((DEPTH, 2, D_MODEL, 3 * D_MODEL), ADA_SCALE * D_MODEL ** -0.5),
        "ada_b": bias((DEPTH, 2, 3 * D_MODEL)),
        "post_ln_g": gain((DEPTH, 2, D_MODEL)),
        "post_ln_b": bias((DEPTH, 2, D_MODEL)),
        "w_in": nrm((DEPTH, D_MODEL, D_IN), D_MODEL ** -0.5),
        "ssd_conv_w": nrm((DEPTH, SSD_CONV, SSD_CONV_DIM), SSD_CONV ** -0.5),
        "ssd_conv_b": bias((DEPTH, SSD_CONV_DIM)),
        "ssd_dt_bias": dt_bias,
        "ssd_a_log": a_log,
        "ssd_d": gain((DEPTH, SSD_HEADS)),
        "ssd_norm_w": gain((DEPTH, SSD_INNER)),
        "mla_q_norm": gain((DEPTH, MLA_Q_RANK)),
        "mla_w_qb": nrm((DEPTH, MLA_Q_RANK, MLA_HEADS * (MLA_NOPE + MLA_ROPE)), MLA_Q_RANK ** -0.5),
        "mla_kv_norm": gain((DEPTH, MLA_KV_RANK)),
        "mla_w_kvb": nrm((DEPTH, MLA_KV_RANK, MLA_HEADS * (MLA_NOPE + MLA_V)), MLA_KV_RANK ** -0.5),
        "gm_ln_g": gain((DEPTH, GM_WIDTH)),
        "gm_ln_b": bias((DEPTH, GM_WIDTH)),
        "gm_w_s": nrm((DEPTH, GM_GROUPS, GM_CHUNK, GM_CHUNK), GM_CHUNK ** -0.5),
        "gm_b_s": 1.0 + nrm((DEPTH, GM_GROUPS, GM_CHUNK), 0.1),
        "w_out": nrm((DEPTH, D_MIX, D_MODEL), DN_BETA * D_MIX ** -0.5),
        "ffn_w1": nrm((n_dense, D_MODEL, D_FF), D_MODEL ** -0.5),
        "ffn_w3": nrm((n_dense, D_MODEL, D_FF), D_MODEL ** -0.5),
        "ffn_w2": nrm((n_dense, D_FF, D_MODEL), DN_BETA * D_FF ** -0.5),
        "moe_router": nrm((n_moe, D_MODEL, N_EXPERTS), D_MODEL ** -0.5),
        "moe_w1": nrm((n_moe, N_EXPERTS, D_MODEL, D_FF), D_MODEL ** -0.5),
        "moe_w3": nrm((n_moe, N_EXPERTS, D_MODEL, D_FF), D_MODEL ** -0.5),
        "moe_w2": nrm((n_moe, N_EXPERTS, D_FF, D_MODEL), DN_BETA * D_FF ** -0.5),
    }


def reference(x, c, ln0_g, ln0_b, ada_w, ada_b, post_ln_g, post_ln_b, w_in, ssd_conv_w, ssd_conv_b,
              ssd_dt_bias, ssd_a_log, ssd_d, ssd_norm_w, mla_q_norm, mla_w_qb, mla_kv_norm, mla_w_kvb,
              gm_ln_g, gm_ln_b, gm_w_s, gm_b_s, w_out, ffn_w1, ffn_w3, ffn_w2,
              moe_router, moe_w1, moe_w3, moe_w2):
    cos, sin = rope_tables(x.shape[1])
    x = layer_norm(x, ln0_g, ln0_b)
    for layer in range(DEPTH):
        shift, scale, gate = modulation(c, ada_w[layer, 0], ada_b[layer, 0])
        h = x * (1.0 + scale) + shift
        y = hybrid_mixer(h, cos, sin, w_in[layer], ssd_conv_w[layer], ssd_conv_b[layer],
                         ssd_dt_bias[layer], ssd_a_log[layer], ssd_d[layer], ssd_norm_w[layer],
                         mla_q_norm[layer], mla_w_qb[layer], mla_kv_norm[layer], mla_w_kvb[layer],
                         gm_ln_g[layer], gm_ln_b[layer], gm_w_s[layer], gm_b_s[layer], w_out[layer])
        x = layer_norm(DN_ALPHA * x + (1.0 + gate) * y, post_ln_g[layer, 0], post_ln_b[layer, 0])
        shift, scale, gate = modulation(c, ada_w[layer, 1], ada_b[layer, 1])
        h = x * (1.0 + scale) + shift
        i = layer // 2
        if layer % 2 == 0:
            y = swiglu(h, ffn_w1[i], ffn_w3[i], ffn_w2[i])
        else:
            y = moe_swiglu(h, moe_router[i], moe_w1[i], moe_w3[i], moe_w2[i])
        x = layer_norm(DN_ALPHA * x + (1.0 + gate) * y, post_ln_g[layer, 1], post_ln_b[layer, 1])
    return x
```

```cpp
#include <hip/hip_runtime.h>
#include <cstdio>
#include <cstdint>
#ifndef N_LAUNCH_MODE
#define N_LAUNCH_MODE 1
#endif
namespace pg8 {
#define PG8_LAS __attribute__((address_space(3)))
typedef unsigned short bf16_t;
typedef short bf16x8 __attribute__((ext_vector_type(8)));
typedef float f32x4 __attribute__((ext_vector_type(4)));
typedef unsigned u32x4 __attribute__((ext_vector_type(4)));
constexpr int BM = 256, BK = 64, HALF = 128, HTB = HALF * BK * 2  , STAGE_BYTES = 8 * HTB, NXCD = 8, WGM = 8;

__host__ __device__ __forceinline__ int lds_byte(int r, int c) { const int st = (r >> 4) * 2 + (c >> 5), rr = r & 15, cc = c & 31, ob = rr * 64 + cc * 2; return st * 1024 + (ob ^ (((ob >> 9) & 1) << 5)); }
__host__ __device__ __forceinline__ void stage_rc(int b, int& R, int& C) { const int st = b / 1024, sb = b % 1024, swz = sb ^ (((sb >> 9) & 1) << 5); R = (st >> 1) * 16 + swz / 64; C = (st & 1) * 32 + (swz % 64) / 2; }
__host__ __device__ __forceinline__ int perm32(int rho) { const int n = rho >> 4, i = rho & 15; return 8 * (i >> 2) + 4 * n + (i & 3); }

struct Unit { int pm, pn, e; };
struct Gemm { const bf16_t* A; const bf16_t* Bt; int M, N, K, lda; size_t estride, aestride; };

struct StaticOrder {
    int nM, nN, nwg, G, c;
    __host__ __device__ void init(int M, int N, int G_, int c_) { nM = M / BM; nN = N / BM; nwg = nM * nN; G = G_; c = c_; }
    __host__ __device__ bool next(int i, Unit& u) const {
        const long L = (long)i * G + c; if (L >= nwg) return false;
        int wgid = (int)L; { const int q = nwg / NXCD, r = nwg % NXCD, xcd = wgid % NXCD, off = wgid / NXCD; wgid = (xcd < r ? xcd * (q + 1) : r * (q + 1) + (xcd - r) * q) + off; }
        const int nig = WGM * nN, gid = wgid / nig, fm = gid * WGM, gsz = (nM - fm) < WGM ? (nM - fm) : WGM;
        u.pm = fm + ((wgid % nig) % gsz); u.pn = (wgid % nig) / gsz; u.e = 0; return true;
    }
    __device__ __forceinline__ void a_ready(const Unit&) const {}
    __device__ __forceinline__ void done(const Unit&) const {}
};
struct MoeOrder : StaticOrder {
    int poff[9];
    __device__ bool next(int i, Unit& u) const {
        if (!StaticOrder::next(i, u)) return false;
        int e = 0;
#pragma unroll
        for (int k = 1; k < 8; ++k) e += (u.pm >= poff[k]) ? 1 : 0;
        u.e = e; return true;
    }
};
struct QkvOrder : StaticOrder {
    __device__ bool next(int i, Unit& u) const { if (!StaticOrder::next(i, u)) return false; u.e = u.pn >> 1; u.pn &= 1; return true; }
};
__device__ __forceinline__ unsigned cvt_pk_bf16(float lo, float hi) { unsigned r; asm volatile("v_cvt_pk_bf16_f32 %0, %1, %2" : "=v"(r) : "v"(lo), "v"(hi)); return r; }
typedef float f32x2 __attribute__((ext_vector_type(2)));
__device__ __forceinline__ u32x4 pack8(const f32x4 v0, const f32x4 v1) { u32x4 w; w.x = cvt_pk_bf16(v0[0], v0[1]); w.y = cvt_pk_bf16(v0[2], v0[3]); w.z = cvt_pk_bf16(v1[0], v1[1]); w.w = cvt_pk_bf16(v1[2], v1[3]); return w; }
__device__ __forceinline__ float silu_f(float a) { return a * __builtin_amdgcn_rcpf(1.f + __expf(-a)); }

struct EpiProj {
    static constexpr bool PERM = true, AFTER_DRAIN = false;
    bf16_t* O; float* dtv;
    __device__ __forceinline__ void operator()(const f32x4 (&acc)[2][2][4][2], const Unit& u, int wr, int wc, int fr, int fq) const {
        const int row0 = u.pm * BM + wr * 64 + fr, col0 = u.pn * BM + wc * 32 + 8 * fq;
#pragma unroll
        for (int ai = 0; ai < 2; ++ai)
#pragma unroll
            for (int m = 0; m < 4; ++m) { bf16_t* rowp = O + (size_t)(row0 + ai * HALF + m * 16) * 2304 + col0;
#pragma unroll
                for (int bj = 0; bj < 2; ++bj) *(u32x4*)(rowp + bj * HALF) = pack8(acc[ai][bj][m][0], acc[ai][bj][m][1]); }
        if (u.pn == 6 && wc == 1 && fq == 0) {
#pragma unroll
            for (int ai = 0; ai < 2; ++ai)
#pragma unroll
                for (int m = 0; m < 4; ++m) { float* dp = dtv + (size_t)(row0 + ai * HALF + m * 16) * 8; *(f32x4*)dp = acc[ai][1][m][0]; *(f32x4*)(dp + 4) = acc[ai][1][m][1]; }
        }
    }
};
struct EpiQ {
    static constexpr bool PERM = true, AFTER_DRAIN = false;
    bf16_t* Q; const float* rstd; const float* ropec; const float* ropes; float qscale;
    __device__ __forceinline__ void operator()(const f32x4 (&acc)[2][2][4][2], const Unit& u, int wr, int wc, int fr, int fq) const {
        const int row0 = u.pm * BM + wr * 64 + fr;
#pragma unroll
        for (int bj = 0; bj < 2; ++bj) { const int lc = bj * HALF + wc * 32 + 8 * fq; if (lc >= 192) continue;
            const int hc = lc % 96, g = (hc - 64) >> 3;
#pragma unroll
            for (int ai = 0; ai < 2; ++ai)
#pragma unroll
                for (int m = 0; m < 4; ++m) { const int row = row0 + ai * HALF + m * 16; const float s = rstd[row] * qscale; f32x4 v0 = acc[ai][bj][m][0] * s, v1 = acc[ai][bj][m][1] * s;
                    if (hc >= 64) { const int t = row & 4095; const f32x4 c4 = *(const f32x4*)(ropec + t * 16 + 4 * g), s4 = *(const f32x4*)(ropes + t * 16 + 4 * g);
                        const f32x4 o0 = v0 * c4 - v1 * s4, o1 = v0 * s4 + v1 * c4; v0 = o0; v1 = o1; }
                    *(u32x4*)(Q + (size_t)row * 384 + u.pn * 192 + lc) = pack8(v0, v1); asm volatile("" ::: "memory"); } }
    }
};
struct EpiKV {
    static constexpr bool PERM = true, AFTER_DRAIN = false;
    bf16_t* KN; bf16_t* V; const float* rstd;
    __device__ __forceinline__ void operator()(const f32x4 (&acc)[2][2][4][2], const Unit& u, int wr, int wc, int fr, int fq) const {
        const int row0 = u.pm * BM + wr * 64 + fr, col0 = wc * 32 + 8 * fq; bf16_t* base = u.pn == 0 ? KN : V;
#pragma unroll
        for (int ai = 0; ai < 2; ++ai)
#pragma unroll
            for (int m = 0; m < 4; ++m) { const int row = row0 + ai * HALF + m * 16; const float s = rstd[row];
#pragma unroll
                for (int bj = 0; bj < 2; ++bj) *(u32x4*)(base + (size_t)row * 256 + col0 + bj * HALF) = pack8(acc[ai][bj][m][0] * s, acc[ai][bj][m][1] * s); }
    }
};
struct EpiQKV {
    static constexpr bool PERM = true, AFTER_DRAIN = false;
    EpiQ q; EpiKV kv;
    __device__ __forceinline__ void operator()(const f32x4 (&acc)[2][2][4][2], const Unit& u, int wr, int wc, int fr, int fq) const { if (u.e == 0) q(acc, u, wr, wc, fr, fq); else kv(acc, u, wr, wc, fr, fq); }
};
struct EpiSwiGLU {
    static constexpr bool PERM = true, AFTER_DRAIN = false;
    bf16_t* O; int ldo;
    __device__ __forceinline__ void operator()(const f32x4 (&acc)[2][2][4][2], const Unit& u, int wr, int wc, int fr, int fq) const {
        const int row0 = u.pm * BM + wr * 64 + fr, col0 = u.pn * HALF + wc * 32 + 8 * fq;
#pragma unroll
        for (int ai = 0; ai < 2; ++ai)
#pragma unroll
            for (int m = 0; m < 4; ++m) { const f32x4 a0 = acc[ai][0][m][0], a1 = acc[ai][0][m][1], g0 = acc[ai][1][m][0], g1 = acc[ai][1][m][1];
                const f32x4 r0 = {silu_f(a0[0]) * g0[0], silu_f(a0[1]) * g0[1], silu_f(a0[2]) * g0[2], silu_f(a0[3]) * g0[3]}, r1 = {silu_f(a1[0]) * g1[0], silu_f(a1[1]) * g1[1], silu_f(a1[2]) * g1[2], silu_f(a1[3]) * g1[3]};
                *(u32x4*)(O + (size_t)(row0 + ai * HALF + m * 16) * ldo + col0) = pack8(r0, r1); }
    }
};
struct EpiResid {
    static constexpr bool PERM = false, AFTER_DRAIN = false;
    float* X; const float* gate; const int* tok; const float* gw; float xscale;
    __device__ __forceinline__ void operator()(const f32x4 (&acc)[2][2][4][2], const Unit& u, int wr, int wc, int fr, int fq) const {
        const int row0 = u.pm * BM + wr * 64 + fr, col0 = u.pn * BM + wc * 32 + 4 * fq;
#pragma unroll
        for (int ai = 0; ai < 2; ++ai)
#pragma unroll
            for (int m = 0; m < 4; ++m) { const int prow = row0 + ai * HALF + m * 16; const int token = tok ? tok[prow] : prow; if (token < 0) continue;
                const float w = gw ? gw[prow] : 1.f; const float* gp = gate + (size_t)(token >> 12) * 3072 + col0; float* xp = X + (size_t)token * 1024 + col0;
#pragma unroll
                for (int bj = 0; bj < 2; ++bj)
#pragma unroll
                    for (int n = 0; n < 2; ++n) { const f32x4 gv = *(const f32x4*)(gp + bj * HALF + n * 16), old = *(const f32x4*)(xp + bj * HALF + n * 16);
                        *(f32x4*)(xp + bj * HALF + n * 16) = old * xscale + (gv + 1.f) * (acc[ai][bj][m][n] * w); } }
    }
};
template <class Epi, class Sched, bool ALIGN_EPI = false, bool SP2 = false>
__device__ __forceinline__ void gemm_phase(PG8_LAS unsigned char* lds, const Gemm g, const Sched& S, const Epi& E) {
    int tid = threadIdx.x; asm volatile("" : "+v"(tid));
    const int wid = __builtin_amdgcn_readfirstlane(tid >> 6), lane = tid & 63, wr = wid >> 2, wc = wid & 3, fr = lane & 15, fq = lane >> 4;
    int K = g.K; asm volatile("" : "+s"(K));
    const int nt = K / BK;
    unsigned voffA[2], voffB[2];
#pragma unroll
    for (int i = 0; i < 2; ++i) { int R, C; stage_rc(tid * 16 + i * 8192, R, C); const int Rb = Epi::PERM ? ((R & ~31) + perm32(R & 31)) : R;
        voffA[i] = (unsigned)(R * g.lda + C) * 2u; voffB[i] = (unsigned)(Rb * K + C) * 2u; }
    const size_t kstep = (size_t)(BK * 2);
    const size_t hstepA = (size_t)HALF * g.lda * 2, hstepB = (size_t)HALF * K * 2;
    const size_t tstepA = 2 * hstepA, tstepB = 2 * hstepB;
    const unsigned ldsw = (unsigned)wid * 1024u;
    const int aoff = lds_byte(wr * 64 + fr, fq * 8), boff = lds_byte(wc * 32 + fr, fq * 8);
#define PG8_SA(b, h) (((b) * 2 + (h)) * HTB)
#define PG8_SB(b, h) ((4 + (b) * 2 + (h)) * HTB)
#define PG8_STAGE(bufoff, gbase, voff) do { _Pragma("unroll") for (int _i = 0; _i < 2; ++_i) \
        __builtin_amdgcn_global_load_lds((const unsigned*)((const char*)(gbase) + (voff)[_i]), (PG8_LAS unsigned*)(lds + (bufoff) + ldsw + _i * 8192), 16, 0, 0); } while (0)
#define PG8_LDA(dst, b, h) do { _Pragma("unroll") for (int m = 0; m < 4; ++m) _Pragma("unroll") for (int k = 0; k < 2; ++k) dst[m][k] = *(const PG8_LAS bf16x8*)(lds + PG8_SA(b, h) + aoff + m * 2048 + k * 1024); } while (0)
#define PG8_LDB(dst, b, h) do { _Pragma("unroll") for (int n = 0; n < 2; ++n) _Pragma("unroll") for (int k = 0; k < 2; ++k) dst[n][k] = *(const PG8_LAS bf16x8*)(lds + PG8_SB(b, h) + boff + n * 2048 + k * 1024); } while (0)
#define PG8_MMA(ai, bj, At, Bt) do { __builtin_amdgcn_s_setprio(1); _Pragma("unroll") for (int m = 0; m < 4; ++m) _Pragma("unroll") for (int n = 0; n < 2; ++n) _Pragma("unroll") for (int k = 0; k < 2; ++k) \
        acc[ai][bj][m][n] = __builtin_amdgcn_mfma_f32_16x16x32_bf16(Bt[n][k], At[m][k], acc[ai][bj][m][n], 0, 0, 0); __builtin_amdgcn_s_setprio(0); } while (0)
#define PG8_WAIT_V(n) asm volatile("s_waitcnt vmcnt(" #n ")" ::: "memory")
#define PG8_WAIT_L(n) asm volatile("s_waitcnt lgkmcnt(" #n ")" ::: "memory")
#define PG8_BAR __builtin_amdgcn_s_barrier()
#define PG8_SCHED __builtin_amdgcn_sched_barrier(0)
    Unit cur, nxt; int ui = 0;
    if (!S.next(0, cur)) return;
    f32x4 acc[2][2][4][2];
#pragma unroll
    for (int a = 0; a < 2; ++a)
#pragma unroll
        for (int b = 0; b < 2; ++b)
#pragma unroll
            for (int m = 0; m < 4; ++m)
#pragma unroll
                for (int n = 0; n < 2; ++n) acc[a][b][m][n] = (f32x4){0.f, 0.f, 0.f, 0.f};
    bf16x8 At[4][2], B0[2][2], B1[2][2];
    const char* cA = (const char*)g.A + (size_t)cur.e * g.aestride + (size_t)cur.pm * tstepA; const char* cB = (const char*)g.Bt + (size_t)cur.e * g.estride + (size_t)cur.pn * tstepB;
    S.a_ready(cur);
    if constexpr (SP2) {
        PG8_STAGE(PG8_SB(0, 0), cB, voffB); PG8_STAGE(PG8_SB(0, 1), cB + hstepB, voffB); PG8_STAGE(PG8_SA(0, 0), cA, voffA); PG8_STAGE(PG8_SA(0, 1), cA + hstepA, voffA);
        if (wr == 1) PG8_BAR;
        PG8_WAIT_V(2); PG8_BAR;
        PG8_STAGE(PG8_SB(1, 0), cB + kstep, voffB); PG8_STAGE(PG8_SA(1, 0), cA + kstep, voffA); PG8_STAGE(PG8_SB(1, 1), cB + hstepB + kstep, voffB);
        PG8_WAIT_V(6); PG8_BAR;
    } else {
        PG8_STAGE(PG8_SB(0, 0), cB, voffB); PG8_STAGE(PG8_SA(0, 0), cA, voffA); PG8_STAGE(PG8_SB(0, 1), cB + hstepB, voffB); PG8_STAGE(PG8_SA(0, 1), cA + hstepA, voffA);
        if (wr == 1) PG8_BAR;
        PG8_WAIT_V(4); PG8_BAR;
        PG8_STAGE(PG8_SB(1, 0), cB + kstep, voffB); PG8_STAGE(PG8_SA(1, 0), cA + kstep, voffA); PG8_STAGE(PG8_SB(1, 1), cB + hstepB + kstep, voffB);
        PG8_WAIT_V(6); PG8_BAR;
    }
    for (;;) {
        const bool has_next = S.next(ui + 1, nxt);
        const char* nA = has_next ? (const char*)g.A + (size_t)nxt.e * g.aestride + (size_t)nxt.pm * tstepA : cA; const char* nB = has_next ? (const char*)g.Bt + (size_t)nxt.e * g.estride + (size_t)nxt.pn * tstepB : cB;
        for (int t = 0; t < nt; t += 2) {
            const bool last = (t == nt - 2);
            const char* a1 = cA + (size_t)(t + 1) * kstep;
            const char* a2 = last ? nA : cA + (size_t)(t + 2) * kstep; const char* b2 = last ? nB : cB + (size_t)(t + 2) * kstep;
            const char* a3 = a2 + kstep; const char* b3 = b2 + kstep;
            if (last && has_next) S.a_ready(nxt);
            if constexpr (SP2) {
            PG8_LDB(B0, 0, 0); PG8_LDB(B1, 0, 1); PG8_SCHED; PG8_LDA(At, 0, 0); PG8_STAGE(PG8_SA(1, 1), a1 + hstepA, voffA);
            PG8_WAIT_V(8); PG8_WAIT_L(0); PG8_BAR; PG8_MMA(0, 0, At, B0); PG8_MMA(0, 1, At, B1); PG8_BAR; PG8_SCHED;
            PG8_LDA(At, 0, 1); PG8_STAGE(PG8_SB(0, 0), b2, voffB); PG8_STAGE(PG8_SB(0, 1), b2 + hstepB, voffB); PG8_STAGE(PG8_SA(0, 0), a2, voffA);
            PG8_WAIT_V(8); PG8_WAIT_L(0); PG8_BAR; PG8_MMA(1, 0, At, B0); PG8_MMA(1, 1, At, B1); PG8_BAR; PG8_SCHED;
            PG8_LDB(B0, 1, 0); PG8_LDB(B1, 1, 1); PG8_SCHED; PG8_LDA(At, 1, 0); PG8_STAGE(PG8_SA(0, 1), a2 + hstepA, voffA);
            PG8_WAIT_V(8); PG8_WAIT_L(0); PG8_BAR; PG8_MMA(0, 0, At, B0); PG8_MMA(0, 1, At, B1); PG8_BAR; PG8_SCHED;
            PG8_LDA(At, 1, 1); PG8_STAGE(PG8_SB(1, 0), b3, voffB); PG8_STAGE(PG8_SB(1, 1), b3 + hstepB, voffB); PG8_STAGE(PG8_SA(1, 0), a3, voffA);
            PG8_WAIT_V(8); PG8_WAIT_L(0); PG8_BAR; PG8_MMA(1, 0, At, B0); PG8_MMA(1, 1, At, B1); PG8_BAR; PG8_SCHED;
            } else {
            PG8_LDB(B0, 0, 0); PG8_SCHED; PG8_LDA(At, 0, 0); PG8_STAGE(PG8_SA(1, 1), a1 + hstepA, voffA);
            PG8_WAIT_L(8); PG8_BAR; PG8_WAIT_L(0); PG8_MMA(0, 0, At, B0); PG8_BAR; PG8_SCHED;
            PG8_LDB(B1, 0, 1); PG8_STAGE(PG8_SB(0, 0), b2, voffB);
            PG8_BAR; PG8_WAIT_L(0); PG8_MMA(0, 1, At, B1); PG8_BAR;
            PG8_LDA(At, 0, 1); PG8_STAGE(PG8_SA(0, 0), a2, voffA);
            PG8_BAR; PG8_WAIT_L(0); PG8_MMA(1, 0, At, B0); PG8_BAR; PG8_SCHED;
            PG8_STAGE(PG8_SB(0, 1), b2 + hstepB, voffB);
            PG8_WAIT_V(6); PG8_BAR; PG8_MMA(1, 1, At, B1); PG8_BAR;
            PG8_LDB(B0, 1, 0); PG8_SCHED; PG8_LDA(At, 1, 0); PG8_STAGE(PG8_SA(0, 1), a2 + hstepA, voffA);
            PG8_WAIT_L(8); PG8_BAR; PG8_WAIT_L(0); PG8_MMA(0, 0, At, B0); PG8_BAR; PG8_SCHED;
            PG8_LDB(B1, 1, 1); PG8_STAGE(PG8_SB(1, 0), b3, voffB);
            PG8_BAR; PG8_WAIT_L(0); PG8_MMA(0, 1, At, B1); PG8_BAR;
            PG8_LDA(At, 1, 1); PG8_STAGE(PG8_SA(1, 0), a3, voffA);
            PG8_BAR; PG8_WAIT_L(0); PG8_MMA(1, 0, At, B0); PG8_BAR; PG8_SCHED;
            PG8_STAGE(PG8_SB(1, 1), b3 + hstepB, voffB);
            PG8_WAIT_V(6); PG8_BAR; PG8_MMA(1, 1, At, B1); PG8_BAR;
            }
        }
        if constexpr (ALIGN_EPI) { if (wr == 0) PG8_BAR; }
        if constexpr (!Epi::AFTER_DRAIN) { E(acc, cur, wr, wc, fr, fq); S.done(cur); }
        if (!has_next) break;
#pragma unroll
        for (int a = 0; a < 2; ++a)
#pragma unroll
            for (int b = 0; b < 2; ++b)
#pragma unroll
                for (int m = 0; m < 4; ++m)
#pragma unroll
                    for (int n = 0; n < 2; ++n) acc[a][b][m][n] = (f32x4){0.f, 0.f, 0.f, 0.f};
        cur = nxt; cA = nA; cB = nB; ++ui;
        if constexpr (ALIGN_EPI) { if (wr == 1) PG8_BAR; }
    }
    PG8_WAIT_V(0);
    if constexpr (!ALIGN_EPI) { if (wr == 0) PG8_BAR; }
    PG8_BAR;
    if constexpr (Epi::AFTER_DRAIN) { E.fused(acc, cur, wr, wc, fr, fq, lds, wid, lane); S.done(cur); }
#undef PG8_SA
#undef PG8_SB
#undef PG8_STAGE
#undef PG8_LDA
#undef PG8_LDB
#undef PG8_MMA
#undef PG8_WAIT_V
#undef PG8_WAIT_L
#undef PG8_BAR
#undef PG8_SCHED
}
}
constexpr int NWAVES = 8, NTHR = 512;
constexpr int NB = 8, T_ = 4096, D_ = 1024, M_ = NB * T_, DIN = 2216, NPROJ = 2304, FF = 2816, NE = 8, NCH = 32  ;
constexpr int PZ = 0, PX = 512, PB = 1024, PC = 1152, PQ = 1280, PKV = 1536, PKPE = 1664, PDT = 1696, PGU = 1792, PGV = 2048;
constexpr float LN_EPS = 1e-5f, RMS_EPS = 1e-6f, DN_ALPHA = 1.41421356237f;
constexpr float QSCALE = 0.10206207261596575f * 1.4426950408889634f;
constexpr int MOE_MAXP = 136;
constexpr size_t MiB = 1u << 20;
constexpr size_t WS_CTL = 0, CTL_ZERO_BYTES = 1 * MiB;
constexpr size_t WS_MOD = 1 * MiB, WS_ROPE = 2 * MiB, WS_WQB = 3 * MiB, WS_WKVB = 4 * MiB, WS_ROUTE = 5 * MiB, WS_RSTD = 6 * MiB, WS_DTV = 7 * MiB, WS_ACS = 8 * MiB, WS_TOK = 9 * MiB, WS_GMW = 10 * MiB;
constexpr size_t WS_WIN = 16 * MiB, WS_WOUT = 25 * MiB, WS_W13 = 29 * MiB, WS_W2 = 40 * MiB, WS_MW13 = 46 * MiB, WS_MW2 = 134 * MiB;
constexpr size_t WS_A = 178 * MiB, WS_PROJ = 242 * MiB, WS_Q = 386 * MiB, WS_KN = 410 * MiB, WS_V = 426 * MiB, WS_KPE = 442 * MiB, WS_ST = 444 * MiB;
constexpr size_t WS_ACT = 242 * MiB, WS_HP = 242 * MiB, WS_ACTM = 310 * MiB, WS_END = 512 * MiB;
static_assert(WS_ACTM + (size_t)MOE_MAXP * 256 * 5632 <= WS_END && WS_ACT + (size_t)M_ * FF * 2 <= WS_END && WS_HP + (size_t)MOE_MAXP * 256 * 2048 <= WS_ACTM, "d_ws map");
constexpr size_t W13_BYTES = (size_t)5632 * 1024 * 2, W2_BYTES = (size_t)1024 * 2816 * 2, WIN_BYTES = (size_t)NPROJ * 1024 * 2, WOUT_BYTES = (size_t)1024 * 1024 * 2, WQB_BYTES = (size_t)512 * 256 * 2;
constexpr int CW_TMO = 0, CW_CODE = 1, CW_BAR = 4096, CW_CNT = 8192;
constexpr int RING_OFF = 0, RING_BYTES = 131072, LDSCTL_OFF = RING_BYTES, MISC_OFF = LDSCTL_OFF + 320, LDS_BYTES = 147456;

#define GAS __attribute__((address_space(1)))
#define LAS __attribute__((address_space(3)))
typedef unsigned short bf16;
typedef unsigned v4u __attribute__((ext_vector_type(4)));
typedef unsigned v2u __attribute__((ext_vector_type(2)));
typedef float f32x4 __attribute__((ext_vector_type(4)));
typedef GAS unsigned gu32;
#define RLX_AGENT __ATOMIC_RELAXED, __HIP_MEMORY_SCOPE_AGENT
#define LDS_WAIT() asm volatile("s_waitcnt lgkmcnt(0)" ::: "memory")
__device__ __forceinline__ unsigned f2bf(float f) { unsigned u = __builtin_bit_cast(unsigned, f); return (u + 0x7fffu + ((u >> 16) & 1u)) >> 16; }
__device__ __forceinline__ unsigned pk2(float lo, float hi) { return f2bf(lo) | (f2bf(hi) << 16); }
__device__ __forceinline__ float bf2f(bf16 v) { return __uint_as_float((unsigned)v << 16); }
__device__ __forceinline__ float bflo(unsigned w) { return __uint_as_float(w << 16); }
__device__ __forceinline__ float bfhi(unsigned w) { return __uint_as_float(w & 0xffff0000u); }
__device__ __forceinline__ float silu(float a) { return a / (1.f + __expf(-a)); }
__device__ __forceinline__ float gelu_erf(float v) { return 0.5f * v * (1.f + erff(v * 0.70710678118654752f)); }

#define XB_TMO      128
#define XB_XCNT(j)  (256  + 64 * (j))
#define XB_XSUB(j)  (1280 + 64 * (j))
#define XB_XGEN(j)  (2304 + 64 * (j))
#define XB_TOP      3328
#define XB_TOPGEN   3392
#define XCD_BAR_WORDS 3456
#define XB_SPIN_CAP (1u << 22)
__device__ __forceinline__ unsigned xb_ld(unsigned* p)              { return __hip_atomic_load(p, __ATOMIC_RELAXED, __HIP_MEMORY_SCOPE_AGENT); }
__device__ __forceinline__ unsigned xb_add(unsigned* p, unsigned v) { return __hip_atomic_fetch_add(p, v, __ATOMIC_RELAXED, __HIP_MEMORY_SCOPE_AGENT); }
__device__ __forceinline__ unsigned xb_xcc_id() { return (unsigned)__builtin_amdgcn_s_getreg((3 << 11) | 20) & 0xFu; }
#define XB_SPIN(cond, bar) do { unsigned _sp = 0; while (cond) { __builtin_amdgcn_s_sleep(1); \
    if ((++_sp & 255u) == 0u) { if (xb_ld(&(bar)[XB_TMO])) break; if (_sp > XB_SPIN_CAP) { atomicAdd(&(bar)[XB_TMO], 1u); break; } } } } while (0)
struct XcdBarrier { unsigned* bar; unsigned x; volatile LAS unsigned* st; };
__device__ __forceinline__ XcdBarrier xcd_barrier_post(unsigned* bar, volatile LAS unsigned* st) {
    XcdBarrier b; b.bar = bar; b.x = xb_xcc_id(); b.st = st;
    if (threadIdx.x == 0) (void)xb_add(&bar[XB_XCNT(b.x)], 1u);
    return b;
}
__device__ __forceinline__ void xcd_barrier_complete(unsigned* bar, unsigned x, unsigned& nloc, unsigned& nx) {
    const unsigned G = gridDim.x * gridDim.y * gridDim.z;
    unsigned sum, cnt, mine, sp = 0u;
    for (;;) {
        sum = 0u; cnt = 0u; mine = 0u;
#pragma unroll
        for (unsigned j = 0; j < 16; ++j) { const unsigned c = xb_ld(&bar[XB_XCNT(j)]); sum += c; cnt += (c > 0u) ? 1u : 0u; mine = (j == x) ? c : mine; }
        if (sum == G) break;
        __builtin_amdgcn_s_sleep(1);
        if ((++sp & 255u) == 0u) { if (xb_ld(&bar[XB_TMO])) break; if (sp > XB_SPIN_CAP) { atomicAdd(&bar[XB_TMO], 1u); break; } }
    }
    nloc = mine > 0u ? mine : 1u; nx = cnt > 0u ? cnt : 1u;
}
__device__ __forceinline__ void xcd_barrier(const XcdBarrier& b) {
    asm volatile("s_waitcnt vmcnt(0)" ::: "memory");
    __syncthreads();
    if (threadIdx.x == 0) {
        unsigned* bar = b.bar;
        __builtin_amdgcn_s_waitcnt(0);
        unsigned nloc = b.st[0], nx = b.st[1];
        if (nloc == 0u) { xcd_barrier_complete(bar, b.x, nloc, nx); b.st[0] = nloc; b.st[1] = nx; }
        const unsigned old = xb_add(&bar[XB_XSUB(b.x)], 1u);
        const unsigned gen = old / nloc;
        if (old + 1u == (gen + 1u) * nloc) {
            __builtin_amdgcn_fence(__ATOMIC_RELEASE, "agent");
            asm volatile("s_waitcnt vmcnt(0)" ::: "memory");
            const unsigned og = xb_add(&bar[XB_TOP], 1u);
            const unsigned tg = og / nx;
            if (og + 1u == (tg + 1u) * nx) xb_add(&bar[XB_TOPGEN], 1u);
            else XB_SPIN(xb_ld(&bar[XB_TOPGEN]) == tg, bar);
            __builtin_amdgcn_fence(__ATOMIC_ACQUIRE, "agent");
            xb_add(&bar[XB_XGEN(b.x)], 1u);
            asm volatile("s_waitcnt vmcnt(0)" ::: "memory");
        } else {
            XB_SPIN(xb_ld(&bar[XB_XGEN(b.x)]) == gen, bar);
            __builtin_amdgcn_fence(__ATOMIC_ACQUIRE, "agent");
            asm volatile("s_waitcnt vmcnt(0)" ::: "memory");
        }
    }
    __syncthreads();
}

struct Args { const float* in[31]; float* out; unsigned char* ws; int ph_lo, ph_hi; };
enum { I_X = 0, I_C, I_LN0G, I_LN0B, I_ADAW, I_ADAB, I_PLG, I_PLB, I_WIN, I_CONVW, I_CONVB, I_DTB, I_ALOG, I_SSDD, I_SSDNW, I_QNORM, I_WQB, I_KVNORM, I_WKVB,
       I_GMLNG, I_GMLNB, I_GMWS, I_GMBS, I_WOUT, I_FW1, I_FW3, I_FW2, I_ROUTER, I_MW1, I_MW3, I_MW2 };
struct Frame {
    LAS unsigned char* lds; gu32* ctl; unsigned char* ws; float* out;
    int tid, lane, wave, G, bid;
};
__device__ __forceinline__ Frame phase_frame(const Frame& F0) {
    Frame P = F0; asm volatile("" : "+v"(P.tid)); asm volatile("" : "+s"(P.ws)); asm volatile("" : "+s"(P.out)); asm volatile("" : "+s"(P.G)); asm volatile("" : "+s"(P.bid));
    P.lane = P.tid & 63; P.wave = __builtin_amdgcn_readfirstlane(P.tid >> 6); P.ctl = (gu32*)(P.ws + WS_CTL); return P;
}
__device__ __forceinline__ float wave_sum(float v) {
#pragma unroll
    for (int o = 1; o < 64; o <<= 1) v += __shfl_xor(v, o);
    return v;
}
__device__ __forceinline__ float wave_max(float v) {
#pragma unroll
    for (int o = 1; o < 64; o <<= 1) v = fmaxf(v, __shfl_xor(v, o));
    return v;
}

struct SrcId   { __device__ __forceinline__ int operator()(int n) const { return n; } };
struct SrcWin  { __device__ __forceinline__ int operator()(int n) const {
    if (n < 1280) return n;
    if (n < 1536) return 1288 + (n - 1280);
    if (n < 1664) return 1544 + (n - 1536);
    if (n < 1696) { const int d = n - 1664, g = d >> 3, w = d & 7; return 1672 + ((w < 4) ? 4 * g + w : 16 + 4 * g + (w - 4)); }
    if (n < 1704) return 1280 + (n - 1696);
    if (n < 1792) return -1;
    if (n < 2048) return 1704 + (n - 1792);
    return 1960 + (n - 2048); } };
struct SrcHalf { __device__ __forceinline__ int operator()(int n) const { return 128 * (n >> 8) + (n & 127); } };
struct SrcQB   { __device__ __forceinline__ int operator()(int n) const { const int pn = n >> 8, lc = n & 255; if (lc >= 192) return -1; const int h = 2 * pn + lc / 96, hc = lc % 96; if (hc < 64) return h * 96 + hc;
    const int d = hc - 64, g = d >> 3, w = d & 7; return h * 96 + 64 + ((w < 4) ? 4 * g + w : 16 + 4 * g + (w - 4)); } };
struct SrcKVB  { __device__ __forceinline__ int operator()(int n) const { const int t = n >> 8, r = n & 255, h = r >> 6, d = r & 63; return h * 128 + t * 64 + d; } };
template <class SrcFn>
__device__ __forceinline__ void tr_item(const float* W, int ldw, int Ksrc, const float* kscale, SrcFn src, bf16* WT, int Kdst, int k0, int n0, LAS float* scr, int lane) {
    const int i = lane & 31, sc = src(n0 + i);
#pragma unroll 8
    for (int j = 0; j < 32; ++j) { const int kk = 2 * j + (lane >> 5), k = k0 + kk; float v = 0.f;
        if (sc >= 0 && k < Ksrc) { v = W[(size_t)k * ldw + sc]; if (kscale) v *= kscale[k]; }
        scr[kk * 33 + i] = v; }
    LDS_WAIT(); asm volatile("" ::: "memory");
    const int c = lane & 7;
#pragma unroll
    for (int j = 0; j < 4; ++j) { const int n = (lane >> 3) + 8 * j; const LAS float* s = scr + (8 * c) * 33 + n;
        v4u o; o.x = pk2(s[0 * 33], s[1 * 33]); o.y = pk2(s[2 * 33], s[3 * 33]); o.z = pk2(s[4 * 33], s[5 * 33]); o.w = pk2(s[6 * 33], s[7 * 33]);
        *(GAS v4u*)(WT + (size_t)(n0 + n) * Kdst + k0 + 8 * c) = o; }
    LDS_WAIT(); asm volatile("" ::: "memory");
}
__device__ __forceinline__ void p0a(Frame& F, const Args& A) {
    if (F.bid < 192) {
        const int ls = F.bid / 48, col0 = (F.bid % 48) * 64;
        LAS float* sc = (LAS float*)(F.lds);
        LAS float* red = (LAS float*)(F.lds + 32768);
        const float* c = A.in[I_C];
        for (int i = F.tid; i < 8 * 1024; i += NTHR) sc[i] = silu(c[i]);
        __syncthreads();
        const float* w = A.in[I_ADAW] + (size_t)ls * 1024 * 3072 + col0 + F.lane;
        float acc[8];
#pragma unroll
        for (int b = 0; b < 8; ++b) acc[b] = 0.f;
        const int kb = F.wave * 128;
#pragma unroll 16
        for (int k = 0; k < 128; ++k) { const float wv = w[(size_t)(kb + k) * 3072];
#pragma unroll
            for (int b = 0; b < 8; ++b) acc[b] += sc[b * 1024 + kb + k] * wv; }
#pragma unroll
        for (int b = 0; b < 8; ++b) red[(F.wave * 8 + b) * 64 + F.lane] = acc[b];
        __syncthreads();
        { const int b = F.tid >> 6, l = F.tid & 63; float s = 0.f;
#pragma unroll
          for (int wv = 0; wv < 8; ++wv) s += red[(wv * 8 + b) * 64 + l];
          float* mod = (float*)(F.ws + WS_MOD);
          mod[((size_t)ls * 8 + b) * 3072 + col0 + l] = s + A.in[I_ADAB][ls * 3072 + col0 + l]; }
        __syncthreads();
    }
    {
        const double inv[16] = {1.0, 0.5623413251903491, 0.31622776601683794, 0.1778279410038923, 0.1, 0.05623413251903491, 0.03162277660168379, 0.01778279410038923,
                                0.01, 0.005623413251903491, 0.0031622776601683794, 0.0017782794100389228, 0.001, 0.0005623413251903491, 0.00031622776601683794, 0.00017782794100389227};
        float* rc = (float*)(F.ws + WS_ROPE); float* rs = rc + 4096 * 16;
        for (int idx = F.bid * NTHR + F.tid; idx < 4096 * 16; idx += F.G * NTHR) { const int t = idx >> 4, i = idx & 15;
            double iv = inv[0];
#pragma unroll
            for (int q = 1; q < 16; ++q) iv = (i == q) ? inv[q] : iv;
            const double rev = (double)t * iv * 0.15915494309189535; const float fr = (float)(rev - floor(rev));
            rc[idx] = __builtin_amdgcn_cosf(fr); rs[idx] = __builtin_amdgcn_sinf(fr); }
    }
    LAS float* scr = (LAS float*)(F.lds + RING_OFF + F.wave * 16384);
    const int gw = F.bid * NWAVES + F.wave, NGW = F.G * NWAVES;
    constexpr int I_WINc = 16 * 72, I_WOUTc = 16 * 32, I_W13c = 16 * 176, I_W2c = 44 * 32, I_QBc = 4 * 16;
    constexpr int NITEMS = 2 * I_WINc + 2 * I_WOUTc + 9 * I_W13c + 9 * I_W2c + 4 * I_QBc;
    for (int it = gw; it < NITEMS; it += NGW) {
        int r = it;
        if (r < 2 * I_WINc) { const int l = r / I_WINc; r %= I_WINc; const int kb = r / 72, nb = r % 72;
            tr_item(A.in[I_WIN] + (size_t)l * 1024 * DIN, DIN, 1024, nullptr, SrcWin(), (bf16*)(F.ws + WS_WIN + l * WIN_BYTES), 1024, kb * 64, nb * 32, scr, F.lane); continue; } r -= 2 * I_WINc;
        if (r < 2 * I_WOUTc) { const int l = r / I_WOUTc; r %= I_WOUTc; const int kb = r / 32, nb = r % 32;
            tr_item(A.in[I_WOUT] + (size_t)l * 1024 * 1024, 1024, 1024, nullptr, SrcId(), (bf16*)(F.ws + WS_WOUT + l * WOUT_BYTES), 1024, kb * 64, nb * 32, scr, F.lane); continue; } r -= 2 * I_WOUTc;
        if (r < 9 * I_W13c) { const int e = r / I_W13c; r %= I_W13c; const int kb = r / 176, nb = r % 176; const int which = (nb >> 2) & 1;
            const float* W = e == 0 ? (which ? A.in[I_FW3] : A.in[I_FW1]) : ((which ? A.in[I_MW3] : A.in[I_MW1]) + (size_t)(e - 1) * 1024 * FF);
            bf16* WT = e == 0 ? (bf16*)(F.ws + WS_W13) : (bf16*)(F.ws + WS_MW13 + (size_t)(e - 1) * W13_BYTES);
            tr_item(W, FF, 1024, nullptr, SrcHalf(), WT, 1024, kb * 64, nb * 32, scr, F.lane); continue; } r -= 9 * I_W13c;
        if (r < 9 * I_W2c) { const int e = r / I_W2c; r %= I_W2c; const int kb = r / 32, nb = r % 32;
            const float* W = e == 0 ? A.in[I_FW2] : A.in[I_MW2] + (size_t)(e - 1) * FF * 1024;
            bf16* WT = e == 0 ? (bf16*)(F.ws + WS_W2) : (bf16*)(F.ws + WS_MW2 + (size_t)(e - 1) * W2_BYTES);
            tr_item(W, 1024, FF, nullptr, SrcId(), WT, FF, kb * 64, nb * 32, scr, F.lane); continue; } r -= 9 * I_W2c;
        { const int l = (r / I_QBc) & 1, isk = r / (2 * I_QBc); r %= I_QBc; const int kb = r / 16, nb = r % 16;
          if (!isk) tr_item(A.in[I_WQB] + (size_t)l * 256 * 384, 384, 256, A.in[I_QNORM] + l * 256, SrcQB(), (bf16*)(F.ws + WS_WQB + l * WQB_BYTES), 256, kb * 64, nb * 32, scr, F.lane);
          else      tr_item(A.in[I_WKVB] + (size_t)l * 128 * 512, 512, 128, A.in[I_KVNORM] + l * 128, SrcKVB(), (bf16*)(F.ws + WS_WKVB + l * WQB_BYTES), 256, kb * 64, nb * 32, scr, F.lane); }
    }
}
__device__ __forceinline__ void ln_row(const float* vin, const float* g, const float* bt, f32x4 (&x)[4], int lane) {
    const GAS f32x4* xr = (const GAS f32x4*)vin + lane; float s = 0.f;
#pragma unroll
    for (int j = 0; j < 4; ++j) { x[j] = xr[64 * j]; s += (x[j].x + x[j].y) + (x[j].z + x[j].w); }
    const float mean = wave_sum(s) * (1.f / 1024.f); float s2 = 0.f;
#pragma unroll
    for (int j = 0; j < 4; ++j) { x[j] = x[j] - mean; s2 += (x[j].x * x[j].x + x[j].y * x[j].y) + (x[j].z * x[j].z + x[j].w * x[j].w); }
    const float rstd = 1.f / sqrtf(wave_sum(s2) * (1.f / 1024.f) + LN_EPS);
#pragma unroll
    for (int j = 0; j < 4; ++j) { const f32x4 gg = ((const GAS f32x4*)g)[lane + 64 * j], bb = ((const GAS f32x4*)bt)[lane + 64 * j]; x[j] = x[j] * rstd * gg + bb; }
}
__device__ __forceinline__ void store_x_h(f32x4 (&x)[4], float* xout, bf16* hout, const float* modp, int lane) {
    if (xout) { GAS f32x4* o = (GAS f32x4*)xout + lane;
#pragma unroll
        for (int j = 0; j < 4; ++j) o[64 * j] = x[j]; }
    if (hout) { GAS v2u* o = (GAS v2u*)hout + lane;
#pragma unroll
        for (int j = 0; j < 4; ++j) { const f32x4 sh = ((const GAS f32x4*)modp)[lane + 64 * j], sc = ((const GAS f32x4*)(modp + 1024))[lane + 64 * j];
            x[j] = x[j] * (sc + 1.f) + sh; v2u w; w.x = pk2(x[j].x, x[j].y); w.y = pk2(x[j].z, x[j].w); o[64 * j] = w; } }
}
__device__ __forceinline__ void ln_phase(Frame& F, const Args& A, const float* vin, const float* g, const float* bt, int ls, bool route) {
    const int gwv = F.bid * NWAVES + F.wave, NGW = F.G * NWAVES;
    const float* mod = (const float*)(F.ws + WS_MOD);
    bf16* hb = (bf16*)(F.ws + WS_A);
    if (!route) {
        for (int m = gwv; m < M_; m += NGW) { f32x4 x[4]; ln_row(vin + (size_t)m * 1024, g, bt, x, F.lane);
            store_x_h(x, F.out + (size_t)m * 1024, ls >= 0 ? hb + (size_t)m * 1024 : nullptr, mod + ((size_t)(ls < 0 ? 0 : ls) * 8 + (m >> 12)) * 3072, F.lane); }
    } else {
        f32x4 wr[4][4][2];
        const float* R = A.in[I_ROUTER];
#pragma unroll
        for (int j = 0; j < 4; ++j)
#pragma unroll
            for (int i = 0; i < 4; ++i) { const float* rp = R + (size_t)(4 * F.lane + i + 256 * j) * 8; wr[j][i][0] = *(const f32x4*)rp; wr[j][i][1] = *(const f32x4*)(rp + 4); }
        int* re = (int*)(F.ws + WS_ROUTE); int* rs = re + 2 * M_; float* rg = (float*)(rs + 2 * M_);
        for (int m = gwv; m < M_; m += NGW) { f32x4 x[4]; ln_row(vin + (size_t)m * 1024, g, bt, x, F.lane);
            store_x_h(x, F.out + (size_t)m * 1024, hb + (size_t)m * 1024, mod + ((size_t)ls * 8 + (m >> 12)) * 3072, F.lane);
            f32x4 p0 = {0.f, 0.f, 0.f, 0.f}, p1 = {0.f, 0.f, 0.f, 0.f};
#pragma unroll
            for (int j = 0; j < 4; ++j) { p0 += wr[j][0][0] * x[j].x + wr[j][1][0] * x[j].y + wr[j][2][0] * x[j].z + wr[j][3][0] * x[j].w;
                                           p1 += wr[j][0][1] * x[j].x + wr[j][1][1] * x[j].y + wr[j][2][1] * x[j].z + wr[j][3][1] * x[j].w; }
            float lg[8] = {wave_sum(p0.x), wave_sum(p0.y), wave_sum(p0.z), wave_sum(p0.w), wave_sum(p1.x), wave_sum(p1.y), wave_sum(p1.z), wave_sum(p1.w)};
            int i0 = 0; float v0 = lg[0];
#pragma unroll
            for (int e = 1; e < 8; ++e) if (lg[e] > v0) { v0 = lg[e]; i0 = e; }
            int i1 = -1; float v1 = -INFINITY;
#pragma unroll
            for (int e = 0; e < 8; ++e) if (e != i0 && lg[e] > v1) { v1 = lg[e]; i1 = e; }
            if (F.lane == 0) { const float g0 = 1.f / (1.f + __expf(v1 - v0));
                const int s0 = (int)atomicAdd((unsigned*)(F.ctl + CW_CNT + (0 * 8 + i0) * 64), 1u), s1 = (int)atomicAdd((unsigned*)(F.ctl + CW_CNT + (1 * 8 + i1) * 64), 1u);
                re[m] = i0; re[M_ + m] = i1; rs[m] = s0; rs[M_ + m] = s1; rg[m] = g0; rg[M_ + m] = 1.f - g0; }
        }
    }
}
__device__ __forceinline__ float conv_silu(const bf16* proj, const float* cw, const float* cb, int b, int t, int ch, int pcol) {
    float a = cb[ch];
#pragma unroll
    for (int k = 0; k < 4; ++k) { const int tt = t - 3 + k; if (tt >= 0) a += cw[k * 768 + ch] * bf2f(proj[((size_t)b * T_ + tt) * NPROJ + pcol]); }
    return silu(a);
}
__device__ __forceinline__ void ssd_chunk_naive(Frame& F, const Args& A, int l, int unit) {
    const int h = unit & 7, c = (unit >> 3) & 31, b = unit >> 8, g = h >> 2;
    const int row0 = b * T_ + c * 128;
    const bf16* proj = (const bf16*)(F.ws + WS_PROJ);
    const float* cw = A.in[I_CONVW] + l * 4 * 768; const float* cb = A.in[I_CONVB] + l * 768;
    LAS float* xs = (LAS float*)(F.lds);
    LAS float* Bs = (LAS float*)(F.lds + 32768);
    LAS float* Cs = (LAS float*)(F.lds + 65536);
    LAS float* dts = (LAS float*)(F.lds + 98304);
    LAS float* acs = dts + 128;
    for (int idx = F.tid; idx < 128 * 64; idx += NTHR) { const int t = idx >> 6, p = idx & 63;
        xs[idx] = conv_silu(proj, cw, cb, b, c * 128 + t, 64 * h + p, PX + 64 * h + p);
        Bs[idx] = conv_silu(proj, cw, cb, b, c * 128 + t, 512 + 64 * g + p, PB + 64 * g + p);
        Cs[idx] = conv_silu(proj, cw, cb, b, c * 128 + t, 640 + 64 * g + p, PC + 64 * g + p); }
    const float* dtv = (const float*)(F.ws + WS_DTV); float* ACS = (float*)(F.ws + WS_ACS);
    if (F.tid < 128) { const float xv = dtv[(size_t)(row0 + F.tid) * 8 + h] + A.in[I_DTB][l * 8 + h]; const float ev = __expf(xv); dts[F.tid] = xv > 20.f ? xv : (ev < 0.01f ? ev * (1.f - ev * (0.5f - ev * 0.33333333f)) : __logf(1.f + ev)); }
    __syncthreads();
    if (F.tid == 0) { const float Ah = -__expf(A.in[I_ALOG][l * 8 + h]); float s = 0.f; for (int t = 0; t < 128; ++t) { s += dts[t] * Ah; acs[t] = s; } }
    __syncthreads();
    if (F.tid < 128) ACS[(size_t)(row0 + F.tid) * 8 + h] = acs[F.tid];
    { float* ST = (float*)(F.ws + WS_ST) + (size_t)((b * NCH + c) * 8 + h) * 4096; const float alast = acs[127];
      for (int idx = F.tid; idx < 4096; idx += NTHR) { const int p = idx >> 6, n = idx & 63; float a = 0.f;
          for (int s = 0; s < 128; ++s) a += xs[s * 64 + p] * Bs[s * 64 + n] * (dts[s] * __expf(alast - acs[s]));
          ST[idx] = a; } }
    { const int lq = F.tid >> 2, pq = (F.tid & 3) * 16; float y[16];
#pragma unroll
      for (int i = 0; i < 16; ++i) y[i] = 0.f;
      const float al = acs[lq];
      for (int s = 0; s <= lq; ++s) { float cbv = 0.f;
#pragma unroll 8
          for (int n = 0; n < 64; ++n) cbv += Cs[lq * 64 + n] * Bs[s * 64 + n];
          const float gg = cbv * __expf(al - acs[s]) * dts[s];
#pragma unroll
          for (int i = 0; i < 16; ++i) y[i] += gg * xs[s * 64 + pq + i]; }
      const float Dh = A.in[I_SSDD][l * 8 + h];
      bf16* yc = (bf16*)(F.ws + WS_A) + (size_t)(row0 + lq) * 1024 + 64 * h + pq;
#pragma unroll
      for (int i = 0; i < 16; i += 2) *(unsigned*)(yc + i) = pk2(y[i] + Dh * xs[lq * 64 + pq + i], y[i + 1] + Dh * xs[lq * 64 + pq + i + 1]); }
    __syncthreads();
}
__device__ __forceinline__ void gmlp_naive(Frame& F, const Args& A, int l, int unit) {
    const int row0 = unit * 128;
    const bf16* proj = (const bf16*)(F.ws + WS_PROJ);
    LAS float* vs = (LAS float*)(F.lds);
    for (int r = F.wave * 16; r < F.wave * 16 + 16; ++r) { const bf16* gp = proj + (size_t)(row0 + r) * NPROJ + PGV + 4 * F.lane; const v2u w = *(const v2u*)gp;
        float v[4] = {gelu_erf(bflo(w.x)), gelu_erf(bfhi(w.x)), gelu_erf(bflo(w.y)), gelu_erf(bfhi(w.y))};
        const float mean = wave_sum((v[0] + v[1]) + (v[2] + v[3])) * (1.f / 256.f); float s2 = 0.f;
#pragma unroll
        for (int i = 0; i < 4; ++i) { v[i] -= mean; s2 += v[i] * v[i]; }
        const float rstd = 1.f / sqrtf(wave_sum(s2) * (1.f / 256.f) + LN_EPS);
#pragma unroll
        for (int i = 0; i < 4; ++i) vs[r * 256 + 4 * F.lane + i] = v[i] * rstd * A.in[I_GMLNG][l * 256 + 4 * F.lane + i] + A.in[I_GMLNB][l * 256 + 4 * F.lane + i]; }
    __syncthreads();
    { const int t = F.tid >> 2, g = F.tid & 3; const float* W = A.in[I_GMWS] + ((size_t)(l * 4 + g) * 128 + t) * 128; float a[64];
#pragma unroll
      for (int i = 0; i < 64; ++i) a[i] = 0.f;
      for (int s = 0; s <= t; ++s) { const float w = W[s];
#pragma unroll
          for (int i = 0; i < 64; ++i) a[i] += w * vs[s * 256 + 64 * g + i]; }
      const float bs = A.in[I_GMBS][(l * 4 + g) * 128 + t];
      const bf16* gu = proj + (size_t)(row0 + t) * NPROJ + PGU + 64 * g; bf16* yc = (bf16*)(F.ws + WS_A) + (size_t)(row0 + t) * 1024 + 768 + 64 * g;
#pragma unroll
      for (int i = 0; i < 64; i += 2) { const unsigned w = *(const unsigned*)(gu + i); *(unsigned*)(yc + i) = pk2(gelu_erf(bflo(w)) * (a[i] + bs), gelu_erf(bfhi(w)) * (a[i + 1] + bs)); } }
    __syncthreads();
}
__device__ __forceinline__ void token_local(Frame& F) {
    const int gwv = F.bid * NWAVES + F.wave, NGW = F.G * NWAVES;
    const bf16* proj = (const bf16*)(F.ws + WS_PROJ); float* rq = (float*)(F.ws + WS_RSTD); float* rkv = rq + M_; bf16* kpe = (bf16*)(F.ws + WS_KPE);
    const float* rc = (const float*)(F.ws + WS_ROPE); const float* rsn = rc + 4096 * 16;
    for (int m = gwv; m < M_; m += NGW) { const bf16* pr = proj + (size_t)m * NPROJ;
        const v2u wq = *(const v2u*)(pr + PQ + 4 * F.lane); const unsigned wk = *(const unsigned*)(pr + PKV + 2 * F.lane);
        float sq = bflo(wq.x) * bflo(wq.x) + bfhi(wq.x) * bfhi(wq.x) + bflo(wq.y) * bflo(wq.y) + bfhi(wq.y) * bfhi(wq.y), sk = bflo(wk) * bflo(wk) + bfhi(wk) * bfhi(wk);
        sq = wave_sum(sq); sk = wave_sum(sk);
        if (F.lane == 0) { rq[m] = 1.f / sqrtf(sq * (1.f / 256.f) + RMS_EPS); rkv[m] = 1.f / sqrtf(sk * (1.f / 128.f) + RMS_EPS); }
        if (F.lane < 16) { const int g = F.lane >> 2, w = F.lane & 3, i = 4 * g + w, t = m & 4095;
            const float x1 = bf2f(pr[PKPE + 8 * g + w]), x2 = bf2f(pr[PKPE + 8 * g + 4 + w]), cs = rc[t * 16 + i], sn = rsn[t * 16 + i];
            kpe[(size_t)m * 32 + 8 * g + w] = (bf16)f2bf(x1 * cs - x2 * sn); kpe[(size_t)m * 32 + 8 * g + 4 + w] = (bf16)f2bf(x1 * sn + x2 * cs); }
    }
}
__device__ __forceinline__ void state_scan(Frame& F) {
    float* ST = (float*)(F.ws + WS_ST); const float* ACS = (const float*)(F.ws + WS_ACS);
    for (int idx = F.bid * NTHR + F.tid; idx < NB * 8 * 4096; idx += F.G * NTHR) { const int pn = idx & 4095, h = (idx >> 12) & 7, b = idx >> 15; float cur = 0.f;
        for (int c = 0; c < NCH; ++c) { const size_t a = (size_t)((b * NCH + c) * 8 + h) * 4096 + pn; const float s = ST[a]; ST[a] = cur;
            cur = cur * __expf(ACS[(size_t)(b * T_ + c * 128 + 127) * 8 + h]) + s; } }
}
__device__ __forceinline__ void ssd_finish_naive(Frame& F, const Args& A, int l, int unit) {
    const int g = unit & 1, c = (unit >> 1) & 31, b = unit >> 6; const int row0 = b * T_ + c * 128;
    const bf16* proj = (const bf16*)(F.ws + WS_PROJ);
    const float* cw = A.in[I_CONVW] + l * 4 * 768; const float* cb = A.in[I_CONVB] + l * 768;
    LAS float* Sin = (LAS float*)(F.lds);
    LAS float* Cs = (LAS float*)(F.lds + 4 * 64 * 65 * 4);
    const float* ST = (const float*)(F.ws + WS_ST) + (size_t)((b * NCH + c) * 8 + 4 * g) * 4096;
    for (int idx = F.tid; idx < 4 * 4096; idx += NTHR) { const int r = idx >> 12, p = (idx >> 6) & 63, n = idx & 63; Sin[(r * 64 + p) * 65 + n] = ST[idx]; }
    for (int idx = F.tid; idx < 128 * 64; idx += NTHR) { const int t = idx >> 6, n = idx & 63; Cs[t * 65 + n] = conv_silu(proj, cw, cb, b, c * 128 + t, 640 + 64 * g + n, PC + 64 * g + n); }
    __syncthreads();
    const int lq = F.tid >> 2, r = F.tid & 3, h = 4 * g + r;
    float cv[64];
#pragma unroll
    for (int n = 0; n < 64; ++n) cv[n] = Cs[lq * 65 + n];
    const float ea = __expf(((const float*)(F.ws + WS_ACS))[(size_t)(row0 + lq) * 8 + h]);
    bf16* yc = (bf16*)(F.ws + WS_A) + (size_t)(row0 + lq) * 1024 + 64 * h; const bf16* zp = proj + (size_t)(row0 + lq) * NPROJ + PZ + 64 * h;
    float ss = 0.f;
#pragma unroll 1
    for (int p = 0; p < 64; ++p) { float a = 0.f;
#pragma unroll
        for (int n = 0; n < 64; ++n) a += cv[n] * Sin[(r * 64 + p) * 65 + n];
        const float y = bf2f(yc[p]) + ea * a, gy = y * silu(bf2f(zp[p])); ss += gy * gy; }
    ss += __shfl_xor(ss, 1); ss += __shfl_xor(ss, 2);
    const float rs = 1.f / sqrtf(ss * (1.f / 256.f) + RMS_EPS); const float* nw = A.in[I_SSDNW] + l * 512 + 64 * h;
#pragma unroll 1
    for (int p = 0; p < 64; ++p) { float a = 0.f;
#pragma unroll
        for (int n = 0; n < 64; ++n) a += cv[n] * Sin[(r * 64 + p) * 65 + n];
        const float y = bf2f(yc[p]) + ea * a, gy = y * silu(bf2f(zp[p])); yc[p] = (bf16)f2bf(gy * rs * nw[p]); }
    __syncthreads();
}
__device__ __forceinline__ void attn_naive(Frame& F, int unit) {
    const int qb = unit & 63, h = (unit >> 6) & 3, b = unit >> 8;
    const bf16* Q = (const bf16*)(F.ws + WS_Q); const bf16* KN = (const bf16*)(F.ws + WS_KN); const bf16* V = (const bf16*)(F.ws + WS_V); const bf16* KPE = (const bf16*)(F.ws + WS_KPE);
    LAS float* Kt = (LAS float*)(F.lds);
    LAS float* Vt = (LAS float*)(F.lds + 64 * 97 * 4);
    LAS float* Qs = Vt + 64 * 64;
    LAS float* Pw = Qs + 64 * 96 + F.wave * 64;
    for (int idx = F.tid; idx < 64 * 96; idx += NTHR) { const int r = idx / 96, d = idx % 96; Qs[idx] = bf2f(Q[(size_t)(b * T_ + qb * 64 + r) * 384 + h * 96 + d]); }
    float mx[8], ls[8], o[8];
#pragma unroll
    for (int i = 0; i < 8; ++i) { mx[i] = -INFINITY; ls[i] = 0.f; o[i] = 0.f; }
    for (int kt = 0; kt <= qb; ++kt) {
        __syncthreads();
        for (int idx = F.tid; idx < 64 * 96; idx += NTHR) { const int j = idx / 96, d = idx % 96; const size_t row = (size_t)(b * T_ + kt * 64 + j);
            Kt[j * 97 + d] = d < 64 ? bf2f(KN[row * 256 + h * 64 + d]) : bf2f(KPE[row * 32 + d - 64]); }
        for (int idx = F.tid; idx < 64 * 64; idx += NTHR) { const int j = idx >> 6, d = idx & 63; Vt[idx] = bf2f(V[(size_t)(b * T_ + kt * 64 + j) * 256 + h * 64 + d]); }
        __syncthreads();
#pragma unroll
        for (int i = 0; i < 8; ++i) { const int qr = F.wave * 8 + i; float s = 0.f;
#pragma unroll 8
            for (int d = 0; d < 96; ++d) s += Qs[qr * 96 + d] * Kt[F.lane * 97 + d];
            if (kt * 64 + F.lane > qb * 64 + qr) s = -INFINITY;
            const float mn = fmaxf(mx[i], wave_max(s)), p = exp2f(s - mn), corr = exp2f(mx[i] - mn);
            ls[i] = ls[i] * corr + wave_sum(p); mx[i] = mn;
            Pw[F.lane] = p; LDS_WAIT(); asm volatile("" ::: "memory");
            float a = 0.f;
#pragma unroll 8
            for (int j = 0; j < 64; ++j) a += Pw[j] * Vt[j * 64 + F.lane];
            o[i] = o[i] * corr + a; LDS_WAIT(); asm volatile("" ::: "memory"); }
    }
    bf16* yc = (bf16*)(F.ws + WS_A);
#pragma unroll
    for (int i = 0; i < 8; ++i) yc[(size_t)(b * T_ + qb * 64 + F.wave * 8 + i) * 1024 + 512 + h * 64 + F.lane] = (bf16)f2bf(o[i] / ls[i]);
    __syncthreads();
}
__device__ __forceinline__ void moe_offsets(Frame& F, int k, int (&poff)[9], int (&cnt)[8]) {
    int acc = 0;
#pragma unroll
    for (int e = 0; e < 8; ++e) { cnt[e] = (int)__hip_atomic_load(F.ctl + CW_CNT + (k * 8 + e) * 64, RLX_AGENT); poff[e] = acc; acc += (cnt[e] + 255) >> 8; }
    poff[8] = acc;
}
__device__ __forceinline__ void moe_permute(Frame& F, int k) {
    int poff[9], cnt[8]; moe_offsets(F, k, poff, cnt);
    const int* re = (const int*)(F.ws + WS_ROUTE) + k * M_; const int* rs = (const int*)(F.ws + WS_ROUTE) + 2 * M_ + k * M_; const float* rg = (const float*)(F.ws + WS_ROUTE) + 4 * M_ + k * M_;
    int* tok = (int*)(F.ws + WS_TOK); float* gwt = (float*)(tok + MOE_MAXP * 256);
    const bf16* hb = (const bf16*)(F.ws + WS_A); bf16* hp = (bf16*)(F.ws + WS_HP);
    const int gwv = F.bid * NWAVES + F.wave, NGW = F.G * NWAVES;
    for (int m = gwv; m < M_; m += NGW) { const int e = re[m], s = rs[m]; int po = 0;
#pragma unroll
        for (int q = 0; q < 8; ++q) po = (e == q) ? poff[q] : po;
        const int prow = po * 256 + s;
        const GAS v4u* src = (const GAS v4u*)(hb + (size_t)m * 1024); GAS v4u* dst = (GAS v4u*)(hp + (size_t)prow * 1024);
        dst[F.lane] = src[F.lane]; dst[64 + F.lane] = src[64 + F.lane];
        if (F.lane == 0) { tok[prow] = m; gwt[prow] = rg[m]; } }
    for (int pr = F.bid * NTHR + F.tid; pr < poff[8] * 256; pr += F.G * NTHR) { const int pm = pr >> 8; int e = 0;
#pragma unroll
        for (int q = 1; q < 8; ++q) e += (pm >= poff[q]) ? 1 : 0;
        int pe = 0, ce = 0;
#pragma unroll
        for (int q = 0; q < 8; ++q) { pe = (e == q) ? poff[q] : pe; ce = (e == q) ? cnt[q] : ce; }
        if (pr - pe * 256 >= ce) tok[pr] = -1; }
}
constexpr int N_PHASES = 25;
#define MODP ((const float*)(F.ws + WS_MOD))
#define HA ((bf16*)(F.ws + WS_A))
#define PROJ ((bf16*)(F.ws + WS_PROJ))
#ifndef PHMASK
#define PHMASK 0xFFF
#endif
#define EN(k) (((PHMASK) >> (k)) & 1)
__global__ void __launch_bounds__(NTHR, 2) fwd_kernel(Args args) {
    extern __shared__ __attribute__((aligned(16))) unsigned char lds[];
    Frame F0;
    F0.lds = (LAS unsigned char*)lds; F0.tid = threadIdx.x; F0.lane = F0.tid & 63; F0.wave = __builtin_amdgcn_readfirstlane(F0.tid >> 6);
    F0.G = gridDim.x; F0.bid = blockIdx.x; F0.ws = args.ws; F0.ctl = (gu32*)(args.ws + WS_CTL); F0.out = args.out;
    for (int u = F0.tid; u < (LDS_BYTES - LDSCTL_OFF) / 4; u += NTHR) ((LAS unsigned*)(F0.lds + LDSCTL_OFF))[u] = 0u;
    __syncthreads();
#if N_LAUNCH_MODE == 0
    XcdBarrier bar = xcd_barrier_post((unsigned*)(F0.ctl + CW_BAR), (volatile LAS unsigned*)(F0.lds + MISC_OFF) + 8);
#define GRID_BAR() xcd_barrier(bar)
#else
#define GRID_BAR() do {} while (0)
#endif
    const int lo = args.ph_lo, hi = args.ph_hi;
#define IN(k) (lo <= (k) && (k) < hi)
#define SEAM(k) do { if (IN(k) && IN((k) + 1)) GRID_BAR(); } while (0)

    if (EN(0) && IN(0)) { Frame F = phase_frame(F0); p0a(F, args); } SEAM(0);
    if (EN(1) && IN(1)) { Frame F = phase_frame(F0); ln_phase(F, args, args.in[I_X], args.in[I_LN0G], args.in[I_LN0B], 0, false); } SEAM(1);

    for (int l = 0; l < 2; ++l) {
        const int base = l == 0 ? 2 : 12;
        if (EN(2) && IN(base + 0)) { Frame F = phase_frame(F0);
            pg8::Gemm g{HA, (const bf16*)(F.ws + WS_WIN + l * WIN_BYTES), M_, NPROJ, 1024, 1024, 0, 0}; pg8::StaticOrder S; S.init(M_, NPROJ, F.G, F.bid);
            pg8::EpiProj E{PROJ, (float*)(F.ws + WS_DTV)};
            pg8::gemm_phase<pg8::EpiProj, pg8::StaticOrder, true, true>(F.lds + RING_OFF, g, S, E);
        } SEAM(base + 0);
        if (EN(3) && IN(base + 1)) { Frame F = phase_frame(F0);
            token_local(F);
            for (int u = F.bid; u < NB * NCH * 8; u += F.G) ssd_chunk_naive(F, args, l, u);
            for (int u = F.bid; u < NB * NCH; u += F.G) gmlp_naive(F, args, l, u);
        } SEAM(base + 1);
        if (EN(4) && IN(base + 2)) { Frame F = phase_frame(F0);
            state_scan(F);
            { pg8::Gemm g{PROJ + PQ, (const bf16*)(F.ws + WS_WQB + l * WQB_BYTES), M_, 1024, 256, NPROJ, WS_WKVB - WS_WQB, (size_t)(PKV - PQ) * 2}; pg8::QkvOrder S; S.init(M_, 1024, F.G, F.bid);
              pg8::EpiQKV E{{(bf16*)(F.ws + WS_Q), (const float*)(F.ws + WS_RSTD), (const float*)(F.ws + WS_ROPE), (const float*)(F.ws + WS_ROPE) + 4096 * 16, QSCALE},
                            {(bf16*)(F.ws + WS_KN), (bf16*)(F.ws + WS_V), (const float*)(F.ws + WS_RSTD) + M_}};
              pg8::gemm_phase<pg8::EpiQKV, pg8::QkvOrder, true, true>(F.lds + RING_OFF, g, S, E); }
        } SEAM(base + 2);
        if (EN(5) && IN(base + 3)) { Frame F = phase_frame(F0);
            for (int u = F.bid; u < NB * NCH * 2; u += F.G) ssd_finish_naive(F, args, l, u);
            for (int u = F.bid; u < NB * 4 * 64; u += F.G) attn_naive(F, u);
        } SEAM(base + 3);
        if (EN(6) && IN(base + 4)) { Frame F = phase_frame(F0);
            pg8::Gemm g{HA, (const bf16*)(F.ws + WS_WOUT + l * WOUT_BYTES), M_, 1024, 1024, 1024, 0, 0}; pg8::StaticOrder S; S.init(M_, 1024, F.G, F.bid);
            pg8::EpiResid E{F.out, MODP + (size_t)((l * 2 + 0) * 8) * 3072 + 2048, nullptr, nullptr, DN_ALPHA};
            pg8::gemm_phase<pg8::EpiResid, pg8::StaticOrder, true, true>(F.lds + RING_OFF, g, S, E);
        } SEAM(base + 4);
        if (EN(7) && IN(base + 5)) { Frame F = phase_frame(F0); ln_phase(F, args, F.out, args.in[I_PLG] + (l * 2 + 0) * 1024, args.in[I_PLB] + (l * 2 + 0) * 1024, l * 2 + 1, l == 1); } SEAM(base + 5);
        const int npass = l == 0 ? 1 : 2;
        for (int k = 0; k < npass; ++k) {
            const int pb = base + 6 + 3 * k;
            if (EN(8) && IN(pb + 0)) { Frame F = phase_frame(F0); if (l == 1) moe_permute(F, k); } if (l == 1) SEAM(pb + 0);
            Frame F = phase_frame(F0);
            pg8::MoeOrder S; int cnt[8]; int npan = M_ / 256;
            if (l == 1) { moe_offsets(F, k, S.poff, cnt); npan = S.poff[8]; }
            else {
#pragma unroll
                for (int e = 0; e < 9; ++e) S.poff[e] = e == 0 ? 0 : npan; }
            if (EN(9) && IN(pb + 1)) { Frame F = phase_frame(F0);
                pg8::Gemm g{l == 0 ? HA : (const bf16*)(F.ws + WS_HP), (const bf16*)(F.ws + (l == 0 ? WS_W13 : WS_MW13)), npan * 256, 5632, 1024, 1024, l == 0 ? 0 : W13_BYTES, 0}; S.init(npan * 256, 5632, F.G, F.bid);
                pg8::EpiSwiGLU E{(bf16*)(F.ws + (l == 0 ? WS_ACT : WS_ACTM)), FF};
                pg8::gemm_phase<pg8::EpiSwiGLU, pg8::MoeOrder, true, true>(F.lds + RING_OFF, g, S, E);
            } SEAM(pb + 1);
            if (EN(10) && IN(pb + 2)) { Frame F = phase_frame(F0);
                pg8::Gemm g{(const bf16*)(F.ws + (l == 0 ? WS_ACT : WS_ACTM)), (const bf16*)(F.ws + (l == 0 ? WS_W2 : WS_MW2)), npan * 256, 1024, FF, FF, l == 0 ? 0 : W2_BYTES, 0}; S.init(npan * 256, 1024, F.G, F.bid);
                const int* tok = l == 0 ? nullptr : (const int*)(F.ws + WS_TOK);
                pg8::EpiResid E{F.out, MODP + (size_t)((l * 2 + 1) * 8) * 3072 + 2048, tok, l == 0 ? nullptr : (const float*)(tok + MOE_MAXP * 256), k == 0 ? DN_ALPHA : 1.f};
                pg8::gemm_phase<pg8::EpiResid, pg8::MoeOrder, true, true>(F.lds + RING_OFF, g, S, E);
            } SEAM(pb + 2);
        }
        const int pl = base + 6 + 3 * npass;
        if (EN(11) && IN(pl)) { Frame F = phase_frame(F0); ln_phase(F, args, F.out, args.in[I_PLG] + (l * 2 + 1) * 1024, args.in[I_PLB] + (l * 2 + 1) * 1024, l == 0 ? 2 : -1, false); } SEAM(pl);
    }
}

extern "C" void kernel_launch(void* const* d_in, const int* in_sizes, int n_in, void* d_out, int out_size, void* d_ws, size_t ws_size, hipStream_t stream) {
    static int grid = 0;
    if (grid == 0) {
        if (n_in != 31 || out_size != M_ * D_ || ws_size < WS_END) { fprintf(stderr, "kernel_launch: unexpected shapes (n_in %d, out %d, ws %zu)\n", n_in, out_size, ws_size); grid = -1; return; }
        int dev = 0, cus = 0;
        if (hipGetDevice(&dev) != hipSuccess || hipDeviceGetAttribute(&cus, hipDeviceAttributeMultiprocessorCount, dev) != hipSuccess) { grid = -1; return; }
        if (hipFuncSetAttribute((const void*)fwd_kernel, hipFuncAttributeMaxDynamicSharedMemorySize, LDS_BYTES) != hipSuccess) { fprintf(stderr, "kernel_launch: hipFuncSetAttribute failed\n"); grid = -1; return; }
        int per_cu = 0;
        if (hipOccupancyMaxActiveBlocksPerMultiprocessor(&per_cu, (const void*)fwd_kernel, NTHR, LDS_BYTES) != hipSuccess || per_cu < 1) fprintf(stderr, "kernel_launch: occupancy query reports %d\n", per_cu);
        (void)hipGetLastError();
        grid = cus;
    }
    if (grid < 0) return;
    (void)hipMemsetAsync((char*)d_ws + WS_CTL, 0, CTL_ZERO_BYTES, stream);
    Args a{};
    for (int i = 0; i < 31; ++i) a.in[i] = (const float*)d_in[i];
    a.out = (float*)d_out; a.ws = (unsigned char*)d_ws;
#if N_LAUNCH_MODE == 0
    a.ph_lo = 0; a.ph_hi = N_PHASES;
    hipLaunchKernelGGL(fwd_kernel, dim3(grid), dim3(NTHR), LDS_BYTES, stream, a);
#else
    for (int p = 0; p < N_PHASES; ++p) { a.ph_lo = p; a.ph_hi = p + 1; hipLaunchKernelGGL(fwd_kernel, dim3(grid), dim3(NTHR), LDS_BYTES, stream, a); }
#endif
}
```

```cpp
#include <hip/hip_runtime.h>
#include <cstdio>
#include <cstdint>
#ifndef N_LAUNCH_MODE
#define N_LAUNCH_MODE 0
#endif
namespace pg8 {
#define PG8_LAS __attribute__((address_space(3)))
typedef unsigned short bf16_t;
typedef short bf16x8 __attribute__((ext_vector_type(8)));
typedef float f32x4 __attribute__((ext_vector_type(4)));
typedef unsigned u32x4 __attribute__((ext_vector_type(4)));
constexpr int BM = 256, BK = 64, HALF = 128, HTB = HALF * BK * 2  , STAGE_BYTES = 8 * HTB, NXCD = 8, WGM = 8;

__host__ __device__ __forceinline__ int lds_byte(int r, int c) { const int st = (r >> 4) * 2 + (c >> 5), rr = r & 15, cc = c & 31, ob = rr * 64 + cc * 2; return st * 1024 + (ob ^ (((ob >> 9) & 1) << 5)); }
__host__ __device__ __forceinline__ void stage_rc(int b, int& R, int& C) { const int st = b / 1024, sb = b % 1024, swz = sb ^ (((sb >> 9) & 1) << 5); R = (st >> 1) * 16 + swz / 64; C = (st & 1) * 32 + (swz % 64) / 2; }
__host__ __device__ __forceinline__ int perm32(int rho) { const int n = rho >> 4, i = rho & 15; return 8 * (i >> 2) + 4 * n + (i & 3); }

struct Unit { int pm, pn, e; };
struct Gemm { const bf16_t* A; const bf16_t* Bt; int M, N, K, lda; size_t estride, aestride; };

struct StaticOrder {
    int nM, nN, nwg, G, c;
    __host__ __device__ void init(int M, int N, int G_, int c_) { nM = M / BM; nN = N / BM; nwg = nM * nN; G = G_; c = c_; }
    __host__ __device__ bool next(int i, Unit& u) const {
        const long L = (long)i * G + c; if (L >= nwg) return false;
        int wgid = (int)L; { const int q = nwg / NXCD, r = nwg % NXCD, xcd = wgid % NXCD, off = wgid / NXCD; wgid = (xcd < r ? xcd * (q + 1) : r * (q + 1) + (xcd - r) * q) + off; }
        const int nig = WGM * nN, gid = wgid / nig, fm = gid * WGM, gsz = (nM - fm) < WGM ? (nM - fm) : WGM;
        u.pm = fm + ((wgid % nig) % gsz); u.pn = (wgid % nig) / gsz; u.e = 0; return true;
    }
    __device__ __forceinline__ void a_ready(const Unit&) const {}
    __device__ __forceinline__ void done(const Unit&) const {}
};
struct MoeOrder : StaticOrder {
    int poff[9];
    __device__ bool next(int i, Unit& u) const {
        if (!StaticOrder::next(i, u)) return false;
        int e = 0;
#pragma unroll
        for (int k = 1; k < 8; ++k) e += (u.pm >= poff[k]) ? 1 : 0;
        u.e = e; return true;
    }
};
struct QkvOrder : StaticOrder {
    __device__ bool next(int i, Unit& u) const { if (!StaticOrder::next(i, u)) return false; u.e = u.pn >> 1; u.pn &= 1; return true; }
};
__device__ __forceinline__ unsigned cvt_pk_bf16(float lo, float hi) { unsigned r; asm volatile("v_cvt_pk_bf16_f32 %0, %1, %2" : "=v"(r) : "v"(lo), "v"(hi)); return r; }
typedef float f32x2 __attribute__((ext_vector_type(2)));
__device__ __forceinline__ u32x4 pack8(const f32x4 v0, const f32x4 v1) { u32x4 w; w.x = cvt_pk_bf16(v0[0], v0[1]); w.y = cvt_pk_bf16(v0[2], v0[3]); w.z = cvt_pk_bf16(v1[0], v1[1]); w.w = cvt_pk_bf16(v1[2], v1[3]); return w; }
__device__ __forceinline__ float silu_f(float a) { return a * __builtin_amdgcn_rcpf(1.f + __expf(-a)); }

struct EpiProj {
    static constexpr bool PERM = true, AFTER_DRAIN = false;
    bf16_t* O; float* dtv;
    __device__ __forceinline__ void operator()(const f32x4 (&acc)[2][2][4][2], const Unit& u, int wr, int wc, int fr, int fq) const {
        const int row0 = u.pm * BM + wr * 64 + fr, col0 = u.pn * BM + wc * 32 + 8 * fq;
#pragma unroll
        for (int ai = 0; ai < 2; ++ai)
#pragma unroll
            for (int m = 0; m < 4; ++m) { bf16_t* rowp = O + (size_t)(row0 + ai * HALF + m * 16) * 2304 + col0;
#pragma unroll
                for (int bj = 0; bj < 2; ++bj) *(u32x4*)(rowp + bj * HALF) = pack8(acc[ai][bj][m][0], acc[ai][bj][m][1]); }
        if (u.pn == 6 && wc == 1 && fq == 0) {
#pragma unroll
            for (int ai = 0; ai < 2; ++ai)
#pragma unroll
                for (int m = 0; m < 4; ++m) { float* dp = dtv + (size_t)(row0 + ai * HALF + m * 16) * 8; *(f32x4*)dp = acc[ai][1][m][0]; *(f32x4*)(dp + 4) = acc[ai][1][m][1]; }
        }
    }
};
struct EpiQ {
    static constexpr bool PERM = true, AFTER_DRAIN = false;
    bf16_t* Q; const float* rstd; const float* ropec; const float* ropes; float qscale;
    __device__ __forceinline__ void operator()(const f32x4 (&acc)[2][2][4][2], const Unit& u, int wr, int wc, int fr, int fq) const {
        const int row0 = u.pm * BM + wr * 64 + fr;
#pragma unroll
        for (int bj = 0; bj < 2; ++bj) { const int lc = bj * HALF + wc * 32 + 8 * fq; if (lc >= 192) continue;
            const int hc = lc % 96, g = (hc - 64) >> 3;
#pragma unroll
            for (int ai = 0; ai < 2; ++ai)
#pragma unroll
                for (int m = 0; m < 4; ++m) { const int row = row0 + ai * HALF + m * 16; const float s = rstd[row] * qscale; f32x4 v0 = acc[ai][bj][m][0] * s, v1 = acc[ai][bj][m][1] * s;
                    if (hc >= 64) { const int t = row & 4095; const f32x4 c4 = *(const f32x4*)(ropec + t * 16 + 4 * g), s4 = *(const f32x4*)(ropes + t * 16 + 4 * g);
                        const f32x4 o0 = v0 * c4 - v1 * s4, o1 = v0 * s4 + v1 * c4; v0 = o0; v1 = o1; }
                    *(u32x4*)(Q + (size_t)row * 384 + u.pn * 192 + lc) = pack8(v0, v1); asm volatile("" ::: "memory"); } }
    }
};
struct EpiKV {
    static constexpr bool PERM = true, AFTER_DRAIN = false;
    bf16_t* KN; bf16_t* V; const float* rstd;
    __device__ __forceinline__ void operator()(const f32x4 (&acc)[2][2][4][2], const Unit& u, int wr, int wc, int fr, int fq) const {
        const int row0 = u.pm * BM + wr * 64 + fr, col0 = wc * 32 + 8 * fq; bf16_t* base = u.pn == 0 ? KN : V;
#pragma unroll
        for (int ai = 0; ai < 2; ++ai)
#pragma unroll
            for (int m = 0; m < 4; ++m) { const int row = row0 + ai * HALF + m * 16; const float s = rstd[row];
#pragma unroll
                for (int bj = 0; bj < 2; ++bj) *(u32x4*)(base + (size_t)row * 256 + col0 + bj * HALF) = pack8(acc[ai][bj][m][0] * s, acc[ai][bj][m][1] * s); }
    }
};
struct EpiQKV {
    static constexpr bool PERM = true, AFTER_DRAIN = false;
    EpiQ q; EpiKV kv;
    __device__ __forceinline__ void operator()(const f32x4 (&acc)[2][2][4][2], const Unit& u, int wr, int wc, int fr, int fq) const { if (u.e == 0) q(acc, u, wr, wc, fr, fq); else kv(acc, u, wr, wc, fr, fq); }
};
struct EpiSwiGLU {
    static constexpr bool PERM = true, AFTER_DRAIN = false;
    bf16_t* O; int ldo;
    __device__ __forceinline__ void operator()(const f32x4 (&acc)[2][2][4][2], const Unit& u, int wr, int wc, int fr, int fq) const {
        const int row0 = u.pm * BM + wr * 64 + fr, col0 = u.pn * HALF + wc * 32 + 8 * fq;
#pragma unroll
        for (int ai = 0; ai < 2; ++ai)
#pragma unroll
            for (int m = 0; m < 4; ++m) { const f32x4 a0 = acc[ai][0][m][0], a1 = acc[ai][0][m][1], g0 = acc[ai][1][m][0], g1 = acc[ai][1][m][1];
                const f32x4 r0 = {silu_f(a0[0]) * g0[0], silu_f(a0[1]) * g0[1], silu_f(a0[2]) * g0[2], silu_f(a0[3]) * g0[3]}, r1 = {silu_f(a1[0]) * g1[0], silu_f(a1[1]) * g1[1], silu_f(a1[2]) * g1[2], silu_f(a1[3]) * g1[3]};
                *(u32x4*)(O + (size_t)(row0 + ai * HALF + m * 16) * ldo + col0) = pack8(r0, r1); }
    }
};
struct EpiResid {
    static constexpr bool PERM = false, AFTER_DRAIN = false;
    float* X; const float* gate; const int* tok; const float* gw; float xscale;
    __device__ __forceinline__ void operator()(const f32x4 (&acc)[2][2][4][2], const Unit& u, int wr, int wc, int fr, int fq) const {
        const int row0 = u.pm * BM + wr * 64 + fr, col0 = u.pn * BM + wc * 32 + 4 * fq;
#pragma unroll
        for (int ai = 0; ai < 2; ++ai)
#pragma unroll
            for (int m = 0; m < 4; ++m) { const int prow = row0 + ai * HALF + m * 16; const int token = tok ? tok[prow] : prow; if (token < 0) continue;
                const float w = gw ? gw[prow] : 1.f; const float* gp = gate + (size_t)(token >> 12) * 3072 + col0; float* xp = X + (size_t)token * 1024 + col0;
#pragma unroll
                for (int bj = 0; bj < 2; ++bj)
#pragma unroll
                    for (int n = 0; n < 2; ++n) { const f32x4 gv = *(const f32x4*)(gp + bj * HALF + n * 16), old = *(const f32x4*)(xp + bj * HALF + n * 16);
                        *(f32x4*)(xp + bj * HALF + n * 16) = old * xscale + (gv + 1.f) * (acc[ai][bj][m][n] * w); } }
    }
};
template <class Epi, class Sched, bool ALIGN_EPI = false, bool SP2 = false>
__device__ __forceinline__ void gemm_phase(PG8_LAS unsigned char* lds, const Gemm g, const Sched& S, const Epi& E, int tid) {
    const int wid = __builtin_amdgcn_readfirstlane(tid >> 6), lane = tid & 63, wr = wid >> 2, wc = wid & 3, fr = lane & 15, fq = lane >> 4;
    int K = g.K; asm volatile("" : "+s"(K));
    const int nt = K / BK;
    unsigned voffA[2], voffB[2];
#pragma unroll
    for (int i = 0; i < 2; ++i) { int R, C; stage_rc(tid * 16 + i * 8192, R, C); const int Rb = Epi::PERM ? ((R & ~31) + perm32(R & 31)) : R;
        voffA[i] = (unsigned)(R * g.lda + C) * 2u; voffB[i] = (unsigned)(Rb * K + C) * 2u; }
    const size_t kstep = (size_t)(BK * 2);
    const size_t hstepA = (size_t)HALF * g.lda * 2, hstepB = (size_t)HALF * K * 2;
    const size_t tstepA = 2 * hstepA, tstepB = 2 * hstepB;
    const unsigned ldsw = (unsigned)wid * 1024u;
    const int aoff = lds_byte(wr * 64 + fr, fq * 8), boff = lds_byte(wc * 32 + fr, fq * 8);
#define PG8_SA(b, h) (((b) * 2 + (h)) * HTB)
#define PG8_SB(b, h) ((4 + (b) * 2 + (h)) * HTB)
#define PG8_STAGE(bufoff, gbase, voff) do { _Pragma("unroll") for (int _i = 0; _i < 2; ++_i) \
        __builtin_amdgcn_global_load_lds((const unsigned*)((const char*)(gbase) + (voff)[_i]), (PG8_LAS unsigned*)(lds + (bufoff) + ldsw + _i * 8192), 16, 0, 0); } while (0)
#define PG8_LDA(dst, b, h) do { _Pragma("unroll") for (int m = 0; m < 4; ++m) _Pragma("unroll") for (int k = 0; k < 2; ++k) dst[m][k] = *(const PG8_LAS bf16x8*)(lds + PG8_SA(b, h) + aoff + m * 2048 + k * 1024); } while (0)
#define PG8_LDB(dst, b, h) do { _Pragma("unroll") for (int n = 0; n < 2; ++n) _Pragma("unroll") for (int k = 0; k < 2; ++k) dst[n][k] = *(const PG8_LAS bf16x8*)(lds + PG8_SB(b, h) + boff + n * 2048 + k * 1024); } while (0)
#define PG8_MMA(ai, bj, At, Bt) do { __builtin_amdgcn_s_setprio(1); _Pragma("unroll") for (int m = 0; m < 4; ++m) _Pragma("unroll") for (int n = 0; n < 2; ++n) _Pragma("unroll") for (int k = 0; k < 2; ++k) \
        acc[ai][bj][m][n] = __builtin_amdgcn_mfma_f32_16x16x32_bf16(Bt[n][k], At[m][k], acc[ai][bj][m][n], 0, 0, 0); __builtin_amdgcn_s_setprio(0); } while (0)
#define PG8_WAIT_V(n) asm volatile("s_waitcnt vmcnt(" #n ")" ::: "memory")
#define PG8_WAIT_L(n) asm volatile("s_waitcnt lgkmcnt(" #n ")" ::: "memory")
#define PG8_BAR __builtin_amdgcn_s_barrier()
#define PG8_SCHED __builtin_amdgcn_sched_barrier(0)
    Unit cur, nxt; int ui = 0;
    if (!S.next(0, cur)) return;
    f32x4 acc[2][2][4][2];
#pragma unroll
    for (int a = 0; a < 2; ++a)
#pragma unroll
        for (int b = 0; b < 2; ++b)
#pragma unroll
            for (int m = 0; m < 4; ++m)
#pragma unroll
                for (int n = 0; n < 2; ++n) acc[a][b][m][n] = (f32x4){0.f, 0.f, 0.f, 0.f};
    bf16x8 At[4][2], B0[2][2], B1[2][2];
    const char* cA = (const char*)g.A + (size_t)cur.e * g.aestride + (size_t)cur.pm * tstepA; const char* cB = (const char*)g.Bt + (size_t)cur.e * g.estride + (size_t)cur.pn * tstepB;
    S.a_ready(cur);
    if constexpr (SP2) {
        PG8_STAGE(PG8_SB(0, 0), cB, voffB); PG8_STAGE(PG8_SB(0, 1), cB + hstepB, voffB); PG8_STAGE(PG8_SA(0, 0), cA, voffA); PG8_STAGE(PG8_SA(0, 1), cA + hstepA, voffA);
        if (wr == 1) PG8_BAR;
        PG8_WAIT_V(2); PG8_BAR;
        PG8_STAGE(PG8_SB(1, 0), cB + kstep, voffB); PG8_STAGE(PG8_SA(1, 0), cA + kstep, voffA); PG8_STAGE(PG8_SB(1, 1), cB + hstepB + kstep, voffB);
        PG8_WAIT_V(6); PG8_BAR;
    } else {
        PG8_STAGE(PG8_SB(0, 0), cB, voffB); PG8_STAGE(PG8_SA(0, 0), cA, voffA); PG8_STAGE(PG8_SB(0, 1), cB + hstepB, voffB); PG8_STAGE(PG8_SA(0, 1), cA + hstepA, voffA);
        if (wr == 1) PG8_BAR;
        PG8_WAIT_V(4); PG8_BAR;
        PG8_STAGE(PG8_SB(1, 0), cB + kstep, voffB); PG8_STAGE(PG8_SA(1, 0), cA + kstep, voffA); PG8_STAGE(PG8_SB(1, 1), cB + hstepB + kstep, voffB);
        PG8_WAIT_V(6); PG8_BAR;
    }
    for (;;) {
        const bool has_next = S.next(ui + 1, nxt);
        const char* nA = has_next ? (const char*)g.A + (size_t)nxt.e * g.aestride + (size_t)nxt.pm * tstepA : cA; const char* nB = has_next ? (const char*)g.Bt + (size_t)nxt.e * g.estride + (size_t)nxt.pn * tstepB : cB;
        for (int t = 0; t < nt; t += 2) {
            const bool last = (t == nt - 2);
            const char* a1 = cA + (size_t)(t + 1) * kstep;
            const char* a2 = last ? nA : cA + (size_t)(t + 2) * kstep; const char* b2 = last ? nB : cB + (size_t)(t + 2) * kstep;
            const char* a3 = a2 + kstep; const char* b3 = b2 + kstep;
            if (last && has_next) S.a_ready(nxt);
            if constexpr (SP2) {
            PG8_LDB(B0, 0, 0); PG8_LDB(B1, 0, 1); PG8_SCHED; PG8_LDA(At, 0, 0); PG8_STAGE(PG8_SA(1, 1), a1 + hstepA, voffA);
            PG8_WAIT_V(8); PG8_WAIT_L(0); PG8_BAR; PG8_MMA(0, 0, At, B0); PG8_MMA(0, 1, At, B1); PG8_BAR; PG8_SCHED;
            PG8_LDA(At, 0, 1); PG8_STAGE(PG8_SB(0, 0), b2, voffB); PG8_STAGE(PG8_SB(0, 1), b2 + hstepB, voffB); PG8_STAGE(PG8_SA(0, 0), a2, voffA);
            PG8_WAIT_V(8); PG8_WAIT_L(0); PG8_BAR; PG8_MMA(1, 0, At, B0); PG8_MMA(1, 1, At, B1); PG8_BAR; PG8_SCHED;
            PG8_LDB(B0, 1, 0); PG8_LDB(B1, 1, 1); PG8_SCHED; PG8_LDA(At, 1, 0); PG8_STAGE(PG8_SA(0, 1), a2 + hstepA, voffA);
            PG8_WAIT_V(8); PG8_WAIT_L(0); PG8_BAR; PG8_MMA(0, 0, At, B0); PG8_MMA(0, 1, At, B1); PG8_BAR; PG8_SCHED;
            PG8_LDA(At, 1, 1); PG8_STAGE(PG8_SB(1, 0), b3, voffB); PG8_STAGE(PG8_SB(1, 1), b3 + hstepB, voffB); PG8_STAGE(PG8_SA(1, 0), a3, voffA);
            PG8_WAIT_V(8); PG8_WAIT_L(0); PG8_BAR; PG8_MMA(1, 0, At, B0); PG8_MMA(1, 1, At, B1); PG8_BAR; PG8_SCHED;
            } else {
            PG8_LDB(B0, 0, 0); PG8_SCHED; PG8_LDA(At, 0, 0); PG8_STAGE(PG8_SA(1, 1), a1 + hstepA, voffA);
            PG8_WAIT_L(8); PG8_BAR; PG8_WAIT_L(0); PG8_MMA(0, 0, At, B0); PG8_BAR; PG8_SCHED;
            PG8_LDB(B1, 0, 1); PG8_STAGE(PG8_SB(0, 0), b2, voffB);
            PG8_BAR; PG8_WAIT_L(0); PG8_MMA(0, 1, At, B1); PG8_BAR;
            PG8_LDA(At, 0, 1); PG8_STAGE(PG8_SA(0, 0), a2, voffA);
            PG8_BAR; PG8_WAIT_L(0); PG8_MMA(1, 0, At, B0); PG8_BAR; PG8_SCHED;
            PG8_STAGE(PG8_SB(0, 1), b2 + hstepB, voffB);
            PG8_WAIT_V(6); PG8_BAR; PG8_MMA(1, 1, At, B1); PG8_BAR;
            PG8_LDB(B0, 1, 0); PG8_SCHED; PG8_LDA(At, 1, 0); PG8_STAGE(PG8_SA(0, 1), a2 + hstepA, voffA);
            PG8_WAIT_L(8); PG8_BAR; PG8_WAIT_L(0); PG8_MMA(0, 0, At, B0); PG8_BAR; PG8_SCHED;
            PG8_LDB(B1, 1, 1); PG8_STAGE(PG8_SB(1, 0), b3, voffB);
            PG8_BAR; PG8_WAIT_L(0); PG8_MMA(0, 1, At, B1); PG8_BAR;
            PG8_LDA(At, 1, 1); PG8_STAGE(PG8_SA(1, 0), a3, voffA);
            PG8_BAR; PG8_WAIT_L(0); PG8_MMA(1, 0, At, B0); PG8_BAR; PG8_SCHED;
            PG8_STAGE(PG8_SB(1, 1), b3 + hstepB, voffB);
            PG8_WAIT_V(6); PG8_BAR; PG8_MMA(1, 1, At, B1); PG8_BAR;
            }
        }
        if constexpr (ALIGN_EPI) { if (wr == 0) PG8_BAR; }
        if constexpr (!Epi::AFTER_DRAIN) { E(acc, cur, wr, wc, fr, fq); S.done(cur); }
        if (!has_next) break;
#pragma unroll
        for (int a = 0; a < 2; ++a)
#pragma unroll
            for (int b = 0; b < 2; ++b)
#pragma unroll
                for (int m = 0; m < 4; ++m)
#pragma unroll
                    for (int n = 0; n < 2; ++n) acc[a][b][m][n] = (f32x4){0.f, 0.f, 0.f, 0.f};
        cur = nxt; cA = nA; cB = nB; ++ui;
        if constexpr (ALIGN_EPI) { if (wr == 1) PG8_BAR; }
    }
    PG8_WAIT_V(0);
    if constexpr (!ALIGN_EPI) { if (wr == 0) PG8_BAR; }
    PG8_BAR;
    if constexpr (Epi::AFTER_DRAIN) { E.fused(acc, cur, wr, wc, fr, fq, lds, wid, lane); S.done(cur); }
#undef PG8_SA
#undef PG8_SB
#undef PG8_STAGE
#undef PG8_LDA
#undef PG8_LDB
#undef PG8_MMA
#undef PG8_WAIT_V
#undef PG8_WAIT_L
#undef PG8_BAR
#undef PG8_SCHED
}
}
constexpr int NWAVES = 8, NTHR = 512;
constexpr int NB = 8, T_ = 4096, D_ = 1024, M_ = NB * T_, DIN = 2216, NPROJ = 2304, FF = 2816, NE = 8, NCH = 32  ;
constexpr int PZ = 0, PX = 512, PB = 1024, PC = 1152, PQ = 1280, PKV = 1536, PKPE = 1664, PDT = 1696, PGU = 1792, PGV = 2048;
constexpr float LN_EPS = 1e-5f, RMS_EPS = 1e-6f, DN_ALPHA = 1.41421356237f;
constexpr float QSCALE = 0.10206207261596575f * 1.4426950408889634f;
constexpr int MOE_MAXP = 136;
constexpr size_t MiB = 1u << 20;
constexpr size_t WS_CTL = 0, CTL_ZERO_BYTES = 1 * MiB;
constexpr size_t WS_MOD = 1 * MiB, WS_ROPE = 2 * MiB, WS_WQB = 3 * MiB, WS_WKVB = 4 * MiB, WS_ROUTE = 5 * MiB, WS_RSTD = 6 * MiB, WS_DTV = 7 * MiB, WS_ACS = 8 * MiB, WS_TOK = 9 * MiB, WS_GMW = 10 * MiB;
constexpr size_t WS_WIN = 16 * MiB, WS_WOUT = 25 * MiB, WS_W13 = 29 * MiB, WS_W2 = 40 * MiB, WS_MW13 = 46 * MiB, WS_MW2 = 134 * MiB;
constexpr size_t WS_A = 178 * MiB, WS_PROJ = 242 * MiB, WS_Q = 386 * MiB, WS_KN = 410 * MiB, WS_V = 426 * MiB, WS_KPE = 442 * MiB, WS_ST = 444 * MiB;
constexpr size_t WS_CC = 476 * MiB, WS_SB = 484 * MiB;
constexpr size_t WS_ACT = 242 * MiB, WS_HP = 242 * MiB, WS_ACTM = 310 * MiB, WS_END = 512 * MiB;
static_assert(WS_ACTM + (size_t)MOE_MAXP * 256 * 5632 <= WS_END && WS_ACT + (size_t)M_ * FF * 2 <= WS_END && WS_HP + (size_t)MOE_MAXP * 256 * 2048 <= WS_ACTM, "d_ws map");
constexpr size_t W13_BYTES = (size_t)5632 * 1024 * 2, W2_BYTES = (size_t)1024 * 2816 * 2, WIN_BYTES = (size_t)NPROJ * 1024 * 2, WOUT_BYTES = (size_t)1024 * 1024 * 2, WQB_BYTES = (size_t)512 * 256 * 2;
constexpr int CW_TMO = 0, CW_CODE = 1, CW_BAR = 4096, CW_CNT = 8192;
constexpr int RING_OFF = 0, RING_BYTES = 131072, LDSCTL_OFF = RING_BYTES, MISC_OFF = LDSCTL_OFF + 320, LDS_BYTES = 147456;

#define GAS __attribute__((address_space(1)))
#define LAS __attribute__((address_space(3)))
typedef unsigned short bf16;
typedef unsigned v4u __attribute__((ext_vector_type(4)));
typedef unsigned v2u __attribute__((ext_vector_type(2)));
typedef float f32x4 __attribute__((ext_vector_type(4)));
typedef GAS unsigned gu32;
#define RLX_AGENT __ATOMIC_RELAXED, __HIP_MEMORY_SCOPE_AGENT
#define LDS_WAIT() asm volatile("s_waitcnt lgkmcnt(0)" ::: "memory")
__device__ __forceinline__ unsigned f2bf(float f) { unsigned u = __builtin_bit_cast(unsigned, f); return (u + 0x7fffu + ((u >> 16) & 1u)) >> 16; }
__device__ __forceinline__ unsigned pk2(float lo, float hi) { return f2bf(lo) | (f2bf(hi) << 16); }
__device__ __forceinline__ float bf2f(bf16 v) { return __uint_as_float((unsigned)v << 16); }
__device__ __forceinline__ float bflo(unsigned w) { return __uint_as_float(w << 16); }
__device__ __forceinline__ float bfhi(unsigned w) { return __uint_as_float(w & 0xffff0000u); }
__device__ __forceinline__ float silu(float a) { return a / (1.f + __expf(-a)); }
__device__ __forceinline__ float gelu_erf(float v) { return 0.5f * v * (1.f + erff(v * 0.70710678118654752f)); }

#define XB_TMO      128
#define XB_XCNT(j)  (256  + 64 * (j))
#define XB_XSUB(j)  (1280 + 64 * (j))
#define XB_XGEN(j)  (2304 + 64 * (j))
#define XB_TOP      3328
#define XB_TOPGEN   3392
#define XCD_BAR_WORDS 3456
#define XB_SPIN_CAP (1u << 22)
__device__ __forceinline__ unsigned xb_ld(unsigned* p)              { return __hip_atomic_load(p, __ATOMIC_RELAXED, __HIP_MEMORY_SCOPE_AGENT); }
__device__ __forceinline__ unsigned xb_add(unsigned* p, unsigned v) { return __hip_atomic_fetch_add(p, v, __ATOMIC_RELAXED, __HIP_MEMORY_SCOPE_AGENT); }
__device__ __forceinline__ unsigned xb_xcc_id() { return (unsigned)__builtin_amdgcn_s_getreg((3 << 11) | 20) & 0xFu; }
#define XB_SPIN(cond, bar) do { unsigned _sp = 0; while (cond) { __builtin_amdgcn_s_sleep(1); \
    if ((++_sp & 255u) == 0u) { if (xb_ld(&(bar)[XB_TMO])) break; if (_sp > XB_SPIN_CAP) { atomicAdd(&(bar)[XB_TMO], 1u); break; } } } } while (0)
struct XcdBarrier { unsigned* bar; unsigned x; volatile LAS unsigned* st; };
__device__ __forceinline__ XcdBarrier xcd_barrier_post(unsigned* bar, volatile LAS unsigned* st) {
    XcdBarrier b; b.bar = bar; b.x = xb_xcc_id(); b.st = st;
    if (threadIdx.x == 0) (void)xb_add(&bar[XB_XCNT(b.x)], 1u);
    return b;
}
__device__ __forceinline__ void xcd_barrier_complete(unsigned* bar, unsigned x, unsigned& nloc, unsigned& nx) {
    const unsigned G = gridDim.x * gridDim.y * gridDim.z;
    unsigned sum, cnt, mine, sp = 0u;
    for (;;) {
        sum = 0u; cnt = 0u; mine = 0u;
#pragma unroll
        for (unsigned j = 0; j < 16; ++j) { const unsigned c = xb_ld(&bar[XB_XCNT(j)]); sum += c; cnt += (c > 0u) ? 1u : 0u; mine = (j == x) ? c : mine; }
        if (sum == G) break;
        __builtin_amdgcn_s_sleep(1);
        if ((++sp & 255u) == 0u) { if (xb_ld(&bar[XB_TMO])) break; if (sp > XB_SPIN_CAP) { atomicAdd(&bar[XB_TMO], 1u); break; } }
    }
    nloc = mine > 0u ? mine : 1u; nx = cnt > 0u ? cnt : 1u;
}
__device__ __forceinline__ void xcd_barrier(const XcdBarrier& b, bool leader) {
    asm volatile("s_waitcnt vmcnt(0)" ::: "memory");
    __syncthreads();
    if (leader) {
        unsigned* bar = b.bar;
        __builtin_amdgcn_s_waitcnt(0);
        unsigned nloc = b.st[0], nx = b.st[1];
        if (nloc == 0u) { xcd_barrier_complete(bar, b.x, nloc, nx); b.st[0] = nloc; b.st[1] = nx; }
        const unsigned old = xb_add(&bar[XB_XSUB(b.x)], 1u);
        const unsigned gen = old / nloc;
        if (old + 1u == (gen + 1u) * nloc) {
            __builtin_amdgcn_fence(__ATOMIC_RELEASE, "agent");
            asm volatile("s_waitcnt vmcnt(0)" ::: "memory");
            const unsigned og = xb_add(&bar[XB_TOP], 1u);
            const unsigned tg = og / nx;
            if (og + 1u == (tg + 1u) * nx) xb_add(&bar[XB_TOPGEN], 1u);
            else XB_SPIN(xb_ld(&bar[XB_TOPGEN]) == tg, bar);
            __builtin_amdgcn_fence(__ATOMIC_ACQUIRE, "agent");
            xb_add(&bar[XB_XGEN(b.x)], 1u);
            asm volatile("s_waitcnt vmcnt(0)" ::: "memory");
        } else {
            XB_SPIN(xb_ld(&bar[XB_XGEN(b.x)]) == gen, bar);
            __builtin_amdgcn_fence(__ATOMIC_ACQUIRE, "agent");
            asm volatile("s_waitcnt vmcnt(0)" ::: "memory");
        }
    }
    __syncthreads();
}

struct Args { const float* in[31]; float* out; unsigned char* ws; int ph_lo, ph_hi; };
enum { I_X = 0, I_C, I_LN0G, I_LN0B, I_ADAW, I_ADAB, I_PLG, I_PLB, I_WIN, I_CONVW, I_CONVB, I_DTB, I_ALOG, I_SSDD, I_SSDNW, I_QNORM, I_WQB, I_KVNORM, I_WKVB,
       I_GMLNG, I_GMLNB, I_GMWS, I_GMBS, I_WOUT, I_FW1, I_FW3, I_FW2, I_ROUTER, I_MW1, I_MW3, I_MW2 };
struct Frame {
    LAS unsigned char* lds; gu32* ctl; unsigned char* ws; float* out;
    int tid, lane, wave, G, bid;
};
__device__ __forceinline__ Frame phase_frame(const Frame& F0) {
    Frame P = F0; asm volatile("" : "+s"(P.wave)); asm volatile("" : "+s"(P.ws)); asm volatile("" : "+s"(P.out)); asm volatile("" : "+s"(P.G)); asm volatile("" : "+s"(P.bid));
    P.lane = (int)__builtin_amdgcn_mbcnt_hi(~0u, __builtin_amdgcn_mbcnt_lo(~0u, 0u)); asm volatile("" : "+v"(P.lane));
    P.tid = P.wave * 64 + P.lane; P.ctl = (gu32*)(P.ws + WS_CTL); return P;
}
__device__ __forceinline__ float wave_sum(float v) {
#pragma unroll
    for (int o = 1; o < 64; o <<= 1) v += __shfl_xor(v, o);
    return v;
}
__device__ __forceinline__ float wave_max(float v) {
#pragma unroll
    for (int o = 1; o < 64; o <<= 1) v = fmaxf(v, __shfl_xor(v, o));
    return v;
}

struct SrcId   { __device__ __forceinline__ int operator()(int n) const { return n; } };
struct SrcWin  { __device__ __forceinline__ int operator()(int n) const {
    if (n < 1280) return n;
    if (n < 1536) return 1288 + (n - 1280);
    if (n < 1664) return 1544 + (n - 1536);
    if (n < 1696) { const int d = n - 1664, g = d >> 3, w = d & 7; return 1672 + ((w < 4) ? 4 * g + w : 16 + 4 * g + (w - 4)); }
    if (n < 1704) return 1280 + (n - 1696);
    if (n < 1792) return -1;
    if (n < 2048) return 1704 + (n - 1792);
    return 1960 + (n - 2048); } };
struct SrcHalf { __device__ __forceinline__ int operator()(int n) const { return 128 * (n >> 8) + (n & 127); } };
struct SrcQB   { __device__ __forceinline__ int operator()(int n) const { const int pn = n >> 8, lc = n & 255; if (lc >= 192) return -1; const int h = 2 * pn + lc / 96, hc = lc % 96; if (hc < 64) return h * 96 + hc;
    const int d = hc - 64, g = d >> 3, w = d & 7; return h * 96 + 64 + ((w < 4) ? 4 * g + w : 16 + 4 * g + (w - 4)); } };
struct SrcKVB  { __device__ __forceinline__ int operator()(int n) const { const int t = n >> 8, r = n & 255, h = r >> 6, d = r & 63; return h * 128 + t * 64 + d; } };
template <class SrcFn>
__device__ __forceinline__ void tr_item(const float* W, int ldw, int Ksrc, const float* kscale, SrcFn src, bf16* WT, int Kdst, int k0, int n0, LAS float* scr, int lane) {
    const int i = lane & 31, sc = src(n0 + i);
#pragma unroll 8
    for (int j = 0; j < 32; ++j) { const int kk = 2 * j + (lane >> 5), k = k0 + kk; float v = 0.f;
        if (sc >= 0 && k < Ksrc) { v = W[(size_t)k * ldw + sc]; if (kscale) v *= kscale[k]; }
        scr[kk * 33 + i] = v; }
    LDS_WAIT(); asm volatile("" ::: "memory");
    const int c = lane & 7;
#pragma unroll
    for (int j = 0; j < 4; ++j) { const int n = (lane >> 3) + 8 * j; const LAS float* s = scr + (8 * c) * 33 + n;
        v4u o; o.x = pk2(s[0 * 33], s[1 * 33]); o.y = pk2(s[2 * 33], s[3 * 33]); o.z = pk2(s[4 * 33], s[5 * 33]); o.w = pk2(s[6 * 33], s[7 * 33]);
        *(GAS v4u*)(WT + (size_t)(n0 + n) * Kdst + k0 + 8 * c) = o; }
    LDS_WAIT(); asm volatile("" ::: "memory");
}
__device__ __forceinline__ void p0a(Frame& F, const Args& A) {
    if (F.bid < 192) {
        const int ls = F.bid / 48, col0 = (F.bid % 48) * 64;
        LAS float* sc = (LAS float*)(F.lds);
        LAS float* red = (LAS float*)(F.lds + 32768);
        const float* c = A.in[I_C];
        for (int i = F.tid; i < 8 * 1024; i += NTHR) sc[i] = silu(c[i]);
        __syncthreads();
        const float* w = A.in[I_ADAW] + (size_t)ls * 1024 * 3072 + col0 + F.lane;
        float acc[8];
#pragma unroll
        for (int b = 0; b < 8; ++b) acc[b] = 0.f;
        const int kb = F.wave * 128;
#pragma unroll 16
        for (int k = 0; k < 128; ++k) { const float wv = w[(size_t)(kb + k) * 3072];
#pragma unroll
            for (int b = 0; b < 8; ++b) acc[b] += sc[b * 1024 + kb + k] * wv; }
#pragma unroll
        for (int b = 0; b < 8; ++b) red[(F.wave * 8 + b) * 64 + F.lane] = acc[b];
        __syncthreads();
        { const int b = F.tid >> 6, l = F.tid & 63; float s = 0.f;
#pragma unroll
          for (int wv = 0; wv < 8; ++wv) s += red[(wv * 8 + b) * 64 + l];
          float* mod = (float*)(F.ws + WS_MOD);
          mod[((size_t)ls * 8 + b) * 3072 + col0 + l] = s + A.in[I_ADAB][ls * 3072 + col0 + l]; }
        __syncthreads();
    }
    {
        const double inv[16] = {1.0, 0.5623413251903491, 0.31622776601683794, 0.1778279410038923, 0.1, 0.05623413251903491, 0.03162277660168379, 0.01778279410038923,
                                0.01, 0.005623413251903491, 0.0031622776601683794, 0.0017782794100389228, 0.001, 0.0005623413251903491, 0.00031622776601683794, 0.00017782794100389227};
        float* rc = (float*)(F.ws + WS_ROPE); float* rs = rc + 4096 * 16;
        for (int idx = F.bid * NTHR + F.tid; idx < 4096 * 16; idx += F.G * NTHR) { const int t = idx >> 4, i = idx & 15;
            double iv = inv[0];
#pragma unroll
            for (int q = 1; q < 16; ++q) iv = (i == q) ? inv[q] : iv;
            const double rev = (double)t * iv * 0.15915494309189535; const float fr = (float)(rev - floor(rev));
            rc[idx] = __builtin_amdgcn_cosf(fr); rs[idx] = __builtin_amdgcn_sinf(fr); }
    }
    { const float* W = A.in[I_GMWS]; bf16* o = (bf16*)(F.ws + WS_GMW);
      for (int idx = F.bid * NTHR + F.tid; idx < 2 * 4 * 128 * 128; idx += F.G * NTHR) { const int s = idx & 127, t = (idx >> 7) & 127; o[idx] = (bf16)(s <= t ? f2bf(W[idx]) : 0u); } }
    LAS float* scr = (LAS float*)(F.lds + RING_OFF + F.wave * 16384);
    const int gw = F.bid * NWAVES + F.wave, NGW = F.G * NWAVES;
    constexpr int I_WINc = 16 * 72, I_WOUTc = 16 * 32, I_W13c = 16 * 176, I_W2c = 44 * 32, I_QBc = 4 * 16;
    constexpr int NITEMS = 2 * I_WINc + 2 * I_WOUTc + 9 * I_W13c + 9 * I_W2c + 4 * I_QBc;
    for (int it = gw; it < NITEMS; it += NGW) {
        int r = it;
        if (r < 2 * I_WINc) { const int l = r / I_WINc; r %= I_WINc; const int kb = r / 72, nb = r % 72;
            tr_item(A.in[I_WIN] + (size_t)l * 1024 * DIN, DIN, 1024, nullptr, SrcWin(), (bf16*)(F.ws + WS_WIN + l * WIN_BYTES), 1024, kb * 64, nb * 32, scr, F.lane); continue; } r -= 2 * I_WINc;
        if (r < 2 * I_WOUTc) { const int l = r / I_WOUTc; r %= I_WOUTc; const int kb = r / 32, nb = r % 32;
            tr_item(A.in[I_WOUT] + (size_t)l * 1024 * 1024, 1024, 1024, nullptr, SrcId(), (bf16*)(F.ws + WS_WOUT + l * WOUT_BYTES), 1024, kb * 64, nb * 32, scr, F.lane); continue; } r -= 2 * I_WOUTc;
        if (r < 9 * I_W13c) { const int e = r / I_W13c; r %= I_W13c; const int kb = r / 176, nb = r % 176; const int which = (nb >> 2) & 1;
            const float* W = e == 0 ? (which ? A.in[I_FW3] : A.in[I_FW1]) : ((which ? A.in[I_MW3] : A.in[I_MW1]) + (size_t)(e - 1) * 1024 * FF);
            bf16* WT = e == 0 ? (bf16*)(F.ws + WS_W13) : (bf16*)(F.ws + WS_MW13 + (size_t)(e - 1) * W13_BYTES);
            tr_item(W, FF, 1024, nullptr, SrcHalf(), WT, 1024, kb * 64, nb * 32, scr, F.lane); continue; } r -= 9 * I_W13c;
        if (r < 9 * I_W2c) { const int e = r / I_W2c; r %= I_W2c; const int kb = r / 32, nb = r % 32;
            const float* W = e == 0 ? A.in[I_FW2] : A.in[I_MW2] + (size_t)(e - 1) * FF * 1024;
            bf16* WT = e == 0 ? (bf16*)(F.ws + WS_W2) : (bf16*)(F.ws + WS_MW2 + (size_t)(e - 1) * W2_BYTES);
            tr_item(W, 1024, FF, nullptr, SrcId(), WT, FF, kb * 64, nb * 32, scr, F.lane); continue; } r -= 9 * I_W2c;
        { const int l = (r / I_QBc) & 1, isk = r / (2 * I_QBc); r %= I_QBc; const int kb = r / 16, nb = r % 16;
          if (!isk) tr_item(A.in[I_WQB] + (size_t)l * 256 * 384, 384, 256, A.in[I_QNORM] + l * 256, SrcQB(), (bf16*)(F.ws + WS_WQB + l * WQB_BYTES), 256, kb * 64, nb * 32, scr, F.lane);
          else      tr_item(A.in[I_WKVB] + (size_t)l * 128 * 512, 512, 128, A.in[I_KVNORM] + l * 128, SrcKVB(), (bf16*)(F.ws + WS_WKVB + l * WQB_BYTES), 256, kb * 64, nb * 32, scr, F.lane); }
    }
}
__device__ __forceinline__ void ln_row(const float* vin, const float* g, const float* bt, f32x4 (&x)[4], int lane) {
    const GAS f32x4* xr = (const GAS f32x4*)vin + lane; float s = 0.f;
#pragma unroll
    for (int j = 0; j < 4; ++j) { x[j] = xr[64 * j]; s += (x[j].x + x[j].y) + (x[j].z + x[j].w); }
    const float mean = wave_sum(s) * (1.f / 1024.f); float s2 = 0.f;
#pragma unroll
    for (int j = 0; j < 4; ++j) { x[j] = x[j] - mean; s2 += (x[j].x * x[j].x + x[j].y * x[j].y) + (x[j].z * x[j].z + x[j].w * x[j].w); }
    const float rstd = 1.f / sqrtf(wave_sum(s2) * (1.f / 1024.f) + LN_EPS);
#pragma unroll
    for (int j = 0; j < 4; ++j) { const f32x4 gg = ((const GAS f32x4*)g)[lane + 64 * j], bb = ((const GAS f32x4*)bt)[lane + 64 * j]; x[j] = x[j] * rstd * gg + bb; }
}
__device__ __forceinline__ void store_x_h(f32x4 (&x)[4], float* xout, bf16* hout, const float* modp, int lane) {
    if (xout) { GAS f32x4* o = (GAS f32x4*)xout + lane;
#pragma unroll
        for (int j = 0; j < 4; ++j) o[64 * j] = x[j]; }
    if (hout) { GAS v2u* o = (GAS v2u*)hout + lane;
#pragma unroll
        for (int j = 0; j < 4; ++j) { const f32x4 sh = ((const GAS f32x4*)modp)[lane + 64 * j], sc = ((const GAS f32x4*)(modp + 1024))[lane + 64 * j];
            x[j] = x[j] * (sc + 1.f) + sh; v2u w; w.x = pk2(x[j].x, x[j].y); w.y = pk2(x[j].z, x[j].w); o[64 * j] = w; } }
}
__device__ __forceinline__ void ln_phase(Frame& F, const Args& A, const float* vin, const float* g, const float* bt, int ls, bool route) {
    const int gwv = F.bid * NWAVES + F.wave, NGW = F.G * NWAVES;
    const float* mod = (const float*)(F.ws + WS_MOD);
    bf16* hb = (bf16*)(F.ws + WS_A);
    if (!route) {
        for (int m = gwv; m < M_; m += NGW) { f32x4 x[4]; ln_row(vin + (size_t)m * 1024, g, bt, x, F.lane);
            store_x_h(x, F.out + (size_t)m * 1024, ls >= 0 ? hb + (size_t)m * 1024 : nullptr, mod + ((size_t)(ls < 0 ? 0 : ls) * 8 + (m >> 12)) * 3072, F.lane); }
    } else {
        f32x4 wr[4][4][2];
        const float* R = A.in[I_ROUTER];
#pragma unroll
        for (int j = 0; j < 4; ++j)
#pragma unroll
            for (int i = 0; i < 4; ++i) { const float* rp = R + (size_t)(4 * F.lane + i + 256 * j) * 8; wr[j][i][0] = *(const f32x4*)rp; wr[j][i][1] = *(const f32x4*)(rp + 4); }
        int* re = (int*)(F.ws + WS_ROUTE); int* rs = re + 2 * M_; float* rg = (float*)(rs + 2 * M_);
        for (int m = gwv; m < M_; m += NGW) { f32x4 x[4]; ln_row(vin + (size_t)m * 1024, g, bt, x, F.lane);
            store_x_h(x, F.out + (size_t)m * 1024, hb + (size_t)m * 1024, mod + ((size_t)ls * 8 + (m >> 12)) * 3072, F.lane);
            f32x4 p0 = {0.f, 0.f, 0.f, 0.f}, p1 = {0.f, 0.f, 0.f, 0.f};
#pragma unroll
            for (int j = 0; j < 4; ++j) { p0 += wr[j][0][0] * x[j].x + wr[j][1][0] * x[j].y + wr[j][2][0] * x[j].z + wr[j][3][0] * x[j].w;
                                           p1 += wr[j][0][1] * x[j].x + wr[j][1][1] * x[j].y + wr[j][2][1] * x[j].z + wr[j][3][1] * x[j].w; }
            float lg[8] = {wave_sum(p0.x), wave_sum(p0.y), wave_sum(p0.z), wave_sum(p0.w), wave_sum(p1.x), wave_sum(p1.y), wave_sum(p1.z), wave_sum(p1.w)};
            int i0 = 0; float v0 = lg[0];
#pragma unroll
            for (int e = 1; e < 8; ++e) if (lg[e] > v0) { v0 = lg[e]; i0 = e; }
            int i1 = -1; float v1 = -INFINITY;
#pragma unroll
            for (int e = 0; e < 8; ++e) if (e != i0 && lg[e] > v1) { v1 = lg[e]; i1 = e; }
            if (F.lane == 0) { const float g0 = 1.f / (1.f + __expf(v1 - v0));
                const int s0 = (int)atomicAdd((unsigned*)(F.ctl + CW_CNT + (0 * 8 + i0) * 64), 1u), s1 = (int)atomicAdd((unsigned*)(F.ctl + CW_CNT + (1 * 8 + i1) * 64), 1u);
                re[m] = i0; re[M_ + m] = i1; rs[m] = s0; rs[M_ + m] = s1; rg[m] = g0; rg[M_ + m] = 1.f - g0; }
        }
    }
}
__device__ __forceinline__ float conv_silu(const bf16* proj, const float* cw, const float* cb, int b, int t, int ch, int pcol) {
    float a = cb[ch];
#pragma unroll
    for (int k = 0; k < 4; ++k) { const int tt = t - 3 + k; if (tt >= 0) a += cw[k * 768 + ch] * bf2f(proj[((size_t)b * T_ + tt) * NPROJ + pcol]); }
    return silu(a);
}
__device__ __forceinline__ void ssd_chunk_naive(Frame& F, const Args& A, int l, int unit) {
    const int h = unit & 7, c = (unit >> 3) & 31, b = unit >> 8, g = h >> 2;
    const int row0 = b * T_ + c * 128;
    const bf16* proj = (const bf16*)(F.ws + WS_PROJ);
    const float* cw = A.in[I_CONVW] + l * 4 * 768; const float* cb = A.in[I_CONVB] + l * 768;
    LAS float* xs = (LAS float*)(F.lds);
    LAS float* Bs = (LAS float*)(F.lds + 32768);
    LAS float* Cs = (LAS float*)(F.lds + 65536);
    LAS float* dts = (LAS float*)(F.lds + 98304);
    LAS float* acs = dts + 128;
    for (int idx = F.tid; idx < 128 * 64; idx += NTHR) { const int t = idx >> 6, p = idx & 63;
        xs[idx] = conv_silu(proj, cw, cb, b, c * 128 + t, 64 * h + p, PX + 64 * h + p);
        Bs[idx] = conv_silu(proj, cw, cb, b, c * 128 + t, 512 + 64 * g + p, PB + 64 * g + p);
        Cs[idx] = conv_silu(proj, cw, cb, b, c * 128 + t, 640 + 64 * g + p, PC + 64 * g + p); }
    const float* dtv = (const float*)(F.ws + WS_DTV); float* ACS = (float*)(F.ws + WS_ACS);
    if (F.tid < 128) { const float xv = dtv[(size_t)(row0 + F.tid) * 8 + h] + A.in[I_DTB][l * 8 + h]; const float ev = __expf(xv); dts[F.tid] = xv > 20.f ? xv : (ev < 0.01f ? ev * (1.f - ev * (0.5f - ev * 0.33333333f)) : __logf(1.f + ev)); }
    __syncthreads();
    if (F.tid == 0) { const float Ah = -__expf(A.in[I_ALOG][l * 8 + h]); float s = 0.f; for (int t = 0; t < 128; ++t) { s += dts[t] * Ah; acs[t] = s; } }
    __syncthreads();
    if (F.tid < 128) ACS[(size_t)(row0 + F.tid) * 8 + h] = acs[F.tid];
    { float* ST = (float*)(F.ws + WS_ST) + (size_t)((b * NCH + c) * 8 + h) * 4096; const float alast = acs[127];
      for (int idx = F.tid; idx < 4096; idx += NTHR) { const int p = idx >> 6, n = idx & 63; float a = 0.f;
          for (int s = 0; s < 128; ++s) a += xs[s * 64 + p] * Bs[s * 64 + n] * (dts[s] * __expf(alast - acs[s]));
          ST[idx] = a; } }
    { const int lq = F.tid >> 2, pq = (F.tid & 3) * 16; float y[16];
#pragma unroll
      for (int i = 0; i < 16; ++i) y[i] = 0.f;
      const float al = acs[lq];
      for (int s = 0; s <= lq; ++s) { float cbv = 0.f;
#pragma unroll 8
          for (int n = 0; n < 64; ++n) cbv += Cs[lq * 64 + n] * Bs[s * 64 + n];
          const float gg = cbv * __expf(al - acs[s]) * dts[s];
#pragma unroll
          for (int i = 0; i < 16; ++i) y[i] += gg * xs[s * 64 + pq + i]; }
      const float Dh = A.in[I_SSDD][l * 8 + h];
      bf16* yc = (bf16*)(F.ws + WS_A) + (size_t)(row0 + lq) * 1024 + 64 * h + pq;
#pragma unroll
      for (int i = 0; i < 16; i += 2) *(unsigned*)(yc + i) = pk2(y[i] + Dh * xs[lq * 64 + pq + i], y[i + 1] + Dh * xs[lq * 64 + pq + i + 1]); }
    __syncthreads();
}
__device__ __forceinline__ void gmlp_naive(Frame& F, const Args& A, int l, int unit) {
    const int row0 = unit * 128;
    const bf16* proj = (const bf16*)(F.ws + WS_PROJ);
    LAS float* vs = (LAS float*)(F.lds);
    for (int r = F.wave * 16; r < F.wave * 16 + 16; ++r) { const bf16* gp = proj + (size_t)(row0 + r) * NPROJ + PGV + 4 * F.lane; const v2u w = *(const v2u*)gp;
        float v[4] = {gelu_erf(bflo(w.x)), gelu_erf(bfhi(w.x)), gelu_erf(bflo(w.y)), gelu_erf(bfhi(w.y))};
        const float mean = wave_sum((v[0] + v[1]) + (v[2] + v[3])) * (1.f / 256.f); float s2 = 0.f;
#pragma unroll
        for (int i = 0; i < 4; ++i) { v[i] -= mean; s2 += v[i] * v[i]; }
        const float rstd = 1.f / sqrtf(wave_sum(s2) * (1.f / 256.f) + LN_EPS);
#pragma unroll
        for (int i = 0; i < 4; ++i) vs[r * 256 + 4 * F.lane + i] = v[i] * rstd * A.in[I_GMLNG][l * 256 + 4 * F.lane + i] + A.in[I_GMLNB][l * 256 + 4 * F.lane + i]; }
    __syncthreads();
    { const int t = F.tid >> 2, g = F.tid & 3; const float* W = A.in[I_GMWS] + ((size_t)(l * 4 + g) * 128 + t) * 128; float a[64];
#pragma unroll
      for (int i = 0; i < 64; ++i) a[i] = 0.f;
      for (int s = 0; s <= t; ++s) { const float w = W[s];
#pragma unroll
          for (int i = 0; i < 64; ++i) a[i] += w * vs[s * 256 + 64 * g + i]; }
      const float bs = A.in[I_GMBS][(l * 4 + g) * 128 + t];
      const bf16* gu = proj + (size_t)(row0 + t) * NPROJ + PGU + 64 * g; bf16* yc = (bf16*)(F.ws + WS_A) + (size_t)(row0 + t) * 1024 + 768 + 64 * g;
#pragma unroll
      for (int i = 0; i < 64; i += 2) { const unsigned w = *(const unsigned*)(gu + i); *(unsigned*)(yc + i) = pk2(gelu_erf(bflo(w)) * (a[i] + bs), gelu_erf(bfhi(w)) * (a[i + 1] + bs)); } }
    __syncthreads();
}
__device__ __forceinline__ void token_local(Frame& F) {
    const int gwv = F.bid * NWAVES + F.wave, NGW = F.G * NWAVES;
    const bf16* proj = (const bf16*)(F.ws + WS_PROJ); float* rq = (float*)(F.ws + WS_RSTD); float* rkv = rq + M_; bf16* kpe = (bf16*)(F.ws + WS_KPE);
    const float* rc = (const float*)(F.ws + WS_ROPE); const float* rsn = rc + 4096 * 16;
    for (int m = gwv; m < M_; m += NGW) { const bf16* pr = proj + (size_t)m * NPROJ;
        const v2u wq = *(const v2u*)(pr + PQ + 4 * F.lane); const unsigned wk = *(const unsigned*)(pr + PKV + 2 * F.lane);
        float sq = bflo(wq.x) * bflo(wq.x) + bfhi(wq.x) * bfhi(wq.x) + bflo(wq.y) * bflo(wq.y) + bfhi(wq.y) * bfhi(wq.y), sk = bflo(wk) * bflo(wk) + bfhi(wk) * bfhi(wk);
        sq = wave_sum(sq); sk = wave_sum(sk);
        if (F.lane == 0) { rq[m] = 1.f / sqrtf(sq * (1.f / 256.f) + RMS_EPS); rkv[m] = 1.f / sqrtf(sk * (1.f / 128.f) + RMS_EPS); }
        if (F.lane < 16) { const int g = F.lane >> 2, w = F.lane & 3, i = 4 * g + w, t = m & 4095;
            const float x1 = bf2f(pr[PKPE + 8 * g + w]), x2 = bf2f(pr[PKPE + 8 * g + 4 + w]), cs = rc[t * 16 + i], sn = rsn[t * 16 + i];
            kpe[(size_t)m * 32 + 8 * g + w] = (bf16)f2bf(x1 * cs - x2 * sn); kpe[(size_t)m * 32 + 8 * g + 4 + w] = (bf16)f2bf(x1 * sn + x2 * cs); }
    }
}
__device__ __forceinline__ void state_scan(Frame& F) {
    float* ST = (float*)(F.ws + WS_ST); const float* ACS = (const float*)(F.ws + WS_ACS);
    for (int idx = F.bid * NTHR + F.tid; idx < NB * 8 * 4096; idx += F.G * NTHR) { const int pn = idx & 4095, h = (idx >> 12) & 7, b = idx >> 15; float cur = 0.f;
        for (int c = 0; c < NCH; ++c) { const size_t a = (size_t)((b * NCH + c) * 8 + h) * 4096 + pn; const float s = ST[a]; ST[a] = cur;
            cur = cur * __expf(ACS[(size_t)(b * T_ + c * 128 + 127) * 8 + h]) + s; } }
}
__device__ __forceinline__ void ssd_finish_naive(Frame& F, const Args& A, int l, int unit) {
    const int g = unit & 1, c = (unit >> 1) & 31, b = unit >> 6; const int row0 = b * T_ + c * 128;
    const bf16* proj = (const bf16*)(F.ws + WS_PROJ);
    const float* cw = A.in[I_CONVW] + l * 4 * 768; const float* cb = A.in[I_CONVB] + l * 768;
    LAS float* Sin = (LAS float*)(F.lds);
    LAS float* Cs = (LAS float*)(F.lds + 4 * 64 * 65 * 4);
    const float* ST = (const float*)(F.ws + WS_ST) + (size_t)((b * NCH + c) * 8 + 4 * g) * 4096;
    for (int idx = F.tid; idx < 4 * 4096; idx += NTHR) { const int r = idx >> 12, p = (idx >> 6) & 63, n = idx & 63; Sin[(r * 64 + p) * 65 + n] = ST[idx]; }
    for (int idx = F.tid; idx < 128 * 64; idx += NTHR) { const int t = idx >> 6, n = idx & 63; Cs[t * 65 + n] = conv_silu(proj, cw, cb, b, c * 128 + t, 640 + 64 * g + n, PC + 64 * g + n); }
    __syncthreads();
    const int lq = F.tid >> 2, r = F.tid & 3, h = 4 * g + r;
    float cv[64];
#pragma unroll
    for (int n = 0; n < 64; ++n) cv[n] = Cs[lq * 65 + n];
    const float ea = __expf(((const float*)(F.ws + WS_ACS))[(size_t)(row0 + lq) * 8 + h]);
    bf16* yc = (bf16*)(F.ws + WS_A) + (size_t)(row0 + lq) * 1024 + 64 * h; const bf16* zp = proj + (size_t)(row0 + lq) * NPROJ + PZ + 64 * h;
    float ss = 0.f;
#pragma unroll 1
    for (int p = 0; p < 64; ++p) { float a = 0.f;
#pragma unroll
        for (int n = 0; n < 64; ++n) a += cv[n] * Sin[(r * 64 + p) * 65 + n];
        const float y = bf2f(yc[p]) + ea * a, gy = y * silu(bf2f(zp[p])); ss += gy * gy; }
    ss += __shfl_xor(ss, 1); ss += __shfl_xor(ss, 2);
    const float rs = 1.f / sqrtf(ss * (1.f / 256.f) + RMS_EPS); const float* nw = A.in[I_SSDNW] + l * 512 + 64 * h;
#pragma unroll 1
    for (int p = 0; p < 64; ++p) { float a = 0.f;
#pragma unroll
        for (int n = 0; n < 64; ++n) a += cv[n] * Sin[(r * 64 + p) * 65 + n];
        const float y = bf2f(yc[p]) + ea * a, gy = y * silu(bf2f(zp[p])); yc[p] = (bf16)f2bf(gy * rs * nw[p]); }
    __syncthreads();
}
__device__ __forceinline__ void attn_naive(Frame& F, int unit) {
    const int qb = unit & 63, h = (unit >> 6) & 3, b = unit >> 8;
    const bf16* Q = (const bf16*)(F.ws + WS_Q); const bf16* KN = (const bf16*)(F.ws + WS_KN); const bf16* V = (const bf16*)(F.ws + WS_V); const bf16* KPE = (const bf16*)(F.ws + WS_KPE);
    LAS float* Kt = (LAS float*)(F.lds);
    LAS float* Vt = (LAS float*)(F.lds + 64 * 97 * 4);
    LAS float* Qs = Vt + 64 * 64;
    LAS float* Pw = Qs + 64 * 96 + F.wave * 64;
    for (int idx = F.tid; idx < 64 * 96; idx += NTHR) { const int r = idx / 96, d = idx % 96; Qs[idx] = bf2f(Q[(size_t)(b * T_ + qb * 64 + r) * 384 + h * 96 + d]); }
    float mx[8], ls[8], o[8];
#pragma unroll
    for (int i = 0; i < 8; ++i) { mx[i] = -INFINITY; ls[i] = 0.f; o[i] = 0.f; }
    for (int kt = 0; kt <= qb; ++kt) {
        __syncthreads();
        for (int idx = F.tid; idx < 64 * 96; idx += NTHR) { const int j = idx / 96, d = idx % 96; const size_t row = (size_t)(b * T_ + kt * 64 + j);
            Kt[j * 97 + d] = d < 64 ? bf2f(KN[row * 256 + h * 64 + d]) : bf2f(KPE[row * 32 + d - 64]); }
        for (int idx = F.tid; idx < 64 * 64; idx += NTHR) { const int j = idx >> 6, d = idx & 63; Vt[idx] = bf2f(V[(size_t)(b * T_ + kt * 64 + j) * 256 + h * 64 + d]); }
        __syncthreads();
#pragma unroll
        for (int i = 0; i < 8; ++i) { const int qr = F.wave * 8 + i; float s = 0.f;
#pragma unroll 8
            for (int d = 0; d < 96; ++d) s += Qs[qr * 96 + d] * Kt[F.lane * 97 + d];
            if (kt * 64 + F.lane > qb * 64 + qr) s = -INFINITY;
            const float mn = fmaxf(mx[i], wave_max(s)), p = exp2f(s - mn), corr = exp2f(mx[i] - mn);
            ls[i] = ls[i] * corr + wave_sum(p); mx[i] = mn;
            Pw[F.lane] = p; LDS_WAIT(); asm volatile("" ::: "memory");
            float a = 0.f;
#pragma unroll 8
            for (int j = 0; j < 64; ++j) a += Pw[j] * Vt[j * 64 + F.lane];
            o[i] = o[i] * corr + a; LDS_WAIT(); asm volatile("" ::: "memory"); }
    }
    bf16* yc = (bf16*)(F.ws + WS_A);
#pragma unroll
    for (int i = 0; i < 8; ++i) yc[(size_t)(b * T_ + qb * 64 + F.wave * 8 + i) * 1024 + 512 + h * 64 + F.lane] = (bf16)f2bf(o[i] / ls[i]);
    __syncthreads();
}
namespace att {
typedef short bf16x8 __attribute__((ext_vector_type(8)));
typedef short s16x4 __attribute__((ext_vector_type(4)));
typedef float f32x16 __attribute__((ext_vector_type(16)));
typedef unsigned u32x4 __attribute__((ext_vector_type(4)));
constexpr int KSLOT = 12288, VSLOT = 8192, NSLOT = 3, LDS_K = 0, LDS_V = NSLOT * KSLOT, LDS_TOTAL = NSLOT * (KSLOT + VSLOT);
__device__ __forceinline__ int crow(int r, int hi) { return (r & 3) + 8 * (r >> 2) + 4 * hi; }
__device__ __forceinline__ s16x4 vtr(const LAS unsigned char* p) { return __builtin_bit_cast(s16x4, __builtin_amdgcn_ds_read_tr16_b64_v4i16((LAS s16x4*)p)); }
__device__ __forceinline__ float xhalf(float v) { return __shfl_xor(v, 32); }
__device__ __forceinline__ unsigned pk(float lo, float hi) { typedef float f2 __attribute__((ext_vector_type(2))); typedef __bf16 b2 __attribute__((ext_vector_type(2))); f2 v = {lo, hi}; b2 b = __builtin_convertvector(v, b2); return __builtin_bit_cast(unsigned, b); }
__device__ __forceinline__ bf16x8 pack8r(const f32x16& x, int s) { u32x4 w; w.x = pk(x[8 * s], x[8 * s + 1]); w.y = pk(x[8 * s + 2], x[8 * s + 3]); w.z = pk(x[8 * s + 4], x[8 * s + 5]); w.w = pk(x[8 * s + 6], x[8 * s + 7]); return __builtin_bit_cast(bf16x8, w); }
#define ATT_MFMA(a, b, c) __builtin_amdgcn_mfma_f32_32x32x16_bf16((a), (b), (c), 0, 0, 0)
__device__ __forceinline__ void attn_unit(Frame& F, int b, int h, int qb) {
    const int lane = F.lane, r32 = lane & 31, hi = lane >> 5, wid = F.wave;
    const size_t rowbase = (size_t)b * T_; const int q0 = qb * 256, qrow = q0 + 32 * wid + r32;
    const bf16* Q = (const bf16*)(F.ws + WS_Q); const bf16* KN = (const bf16*)(F.ws + WS_KN); const bf16* V = (const bf16*)(F.ws + WS_V); const bf16* KPE = (const bf16*)(F.ws + WS_KPE);
    LAS unsigned char* lds = F.lds;
    const int NT = (q0 + 256) / 64;
    const bf16* srcA = KN + (rowbase + lane) * 256 + h * 64 + 8 * wid; const int dstA = LDS_K + wid * 1024;
    const bf16* srcB; int dstB; size_t strB;
    if (wid < 4) { srcB = KPE + (rowbase + lane) * 32 + 8 * wid; dstB = LDS_K + (8 + wid) * 1024; strB = 64 * 32; }
    else { srcB = V + (rowbase + 16 * (wid - 4) + (lane >> 2)) * 256 + h * 64 + 8 * (lane & 3); dstB = LDS_V + (wid - 4) * 1024; strB = 64 * 256; }
    const bf16* srcC = V + (rowbase + 16 * (wid & 3) + (lane >> 2)) * 256 + h * 64 + 32 + 8 * (lane & 3); const int dstC = LDS_V + (4 + (wid & 3)) * 1024;
    const int slotB = wid < 4 ? KSLOT : VSLOT;
#define ATT_DMA(t, s) do { \
        __builtin_amdgcn_global_load_lds((const unsigned*)(srcA + (size_t)(t) * 64 * 256), (LAS unsigned*)(lds + dstA + (s) * KSLOT), 16, 0, 0); \
        __builtin_amdgcn_global_load_lds((const unsigned*)(srcB + (size_t)(t) * strB), (LAS unsigned*)(lds + dstB + (s) * slotB), 16, 0, 0); \
        __builtin_amdgcn_global_load_lds((const unsigned*)(srcC + (size_t)(t) * 64 * 256), (LAS unsigned*)(lds + dstC + (s) * VSLOT), 16, 0, 0); } while (0)
    bf16x8 qr[6];
#pragma unroll
    for (int d0 = 0; d0 < 6; ++d0) qr[d0] = *(const bf16x8*)(Q + (rowbase + qrow) * 384 + h * 96 + 16 * d0 + 8 * hi);
    asm volatile("s_waitcnt vmcnt(0)" ::: "memory");
    ATT_DMA(0, 0); ATT_DMA(1, 1);
    f32x16 o0, o1;
#pragma unroll
    for (int i = 0; i < 16; ++i) { o0[i] = 0.f; o1[i] = 0.f; }
    float m = -INFINITY, l = 0.f;
    const int voff = ((lane >> 4) & 1) * 32 + (lane & 3) * 8 + (4 * hi + ((lane & 15) >> 2)) * 64;
    int slot = 0;
    for (int t = 0; t < NT; ++t) {
        if (t + 1 < NT) asm volatile("s_waitcnt vmcnt(3)" ::: "memory"); else asm volatile("s_waitcnt vmcnt(0)" ::: "memory");
        __builtin_amdgcn_s_barrier(); asm volatile("" ::: "memory");
        if (t + 2 < NT) { const int s2 = slot == 0 ? 2 : slot - 1; ATT_DMA(t + 2, s2); }
        if (64 * t <= q0 + 32 * wid + 31) {
            const LAS unsigned char* kb = lds + LDS_K + slot * KSLOT + hi * 1024 + r32 * 16;
            f32x16 p0, p1;
#pragma unroll
            for (int i = 0; i < 16; ++i) { p0[i] = 0.f; p1[i] = 0.f; }
#pragma unroll
            for (int d0 = 0; d0 < 6; ++d0) { const bf16x8 k0 = *(const LAS bf16x8*)(kb + d0 * 2048), k1 = *(const LAS bf16x8*)(kb + d0 * 2048 + 512);
                p0 = ATT_MFMA(k0, qr[d0], p0); p1 = ATT_MFMA(k1, qr[d0], p1); }
            if (64 * t + 63 > q0 + 32 * wid) {
#pragma unroll
                for (int r = 0; r < 16; ++r) { const int kv = 64 * t + crow(r, hi); if (kv > qrow) p0[r] = -INFINITY; if (kv + 32 > qrow) p1[r] = -INFINITY; }
            }
            float mx = fmaxf(p0[0], p1[0]);
#pragma unroll
            for (int r = 1; r < 16; ++r) mx = fmaxf(mx, fmaxf(p0[r], p1[r]));
            mx = fmaxf(mx, xhalf(mx));
            const float mn = fmaxf(m, mx);
            if (__any(mn > m)) { const float corr = __builtin_amdgcn_exp2f(m - mn); l *= corr;
#pragma unroll
                for (int i = 0; i < 16; ++i) { o0[i] *= corr; o1[i] *= corr; }
                m = mn; }
            float sum = 0.f;
#pragma unroll
            for (int r = 0; r < 16; ++r) { p0[r] = __builtin_amdgcn_exp2f(p0[r] - m); p1[r] = __builtin_amdgcn_exp2f(p1[r] - m); sum += p0[r] + p1[r]; }
            l += sum;
            const bf16x8 pa0 = pack8r(p0, 0), pa1 = pack8r(p0, 1), pa2 = pack8r(p1, 0), pa3 = pack8r(p1, 1);
            const LAS unsigned char* vb = lds + LDS_V + slot * VSLOT + voff;
#define ATT_VF(dh, ks) ({ const s16x4 lo_ = vtr(vb + (dh) * 4096 + (ks) * 1024), hi_ = vtr(vb + (dh) * 4096 + (ks) * 1024 + 512); (bf16x8){lo_[0], lo_[1], lo_[2], lo_[3], hi_[0], hi_[1], hi_[2], hi_[3]}; })
            o0 = ATT_MFMA(ATT_VF(0, 0), pa0, o0); o1 = ATT_MFMA(ATT_VF(1, 0), pa0, o1);
            o0 = ATT_MFMA(ATT_VF(0, 1), pa1, o0); o1 = ATT_MFMA(ATT_VF(1, 1), pa1, o1);
            o0 = ATT_MFMA(ATT_VF(0, 2), pa2, o0); o1 = ATT_MFMA(ATT_VF(1, 2), pa2, o1);
            o0 = ATT_MFMA(ATT_VF(0, 3), pa3, o0); o1 = ATT_MFMA(ATT_VF(1, 3), pa3, o1);
#undef ATT_VF
        }
        slot = slot == 2 ? 0 : slot + 1;
    }
    l += xhalf(l);
    const float rl = 1.f / l;
    bf16* yc = (bf16*)(F.ws + WS_A) + (rowbase + qrow) * 1024 + 512 + h * 64;
#pragma unroll
    for (int g = 0; g < 4; ++g) { v2u w0, w1; w0.x = pk(o0[4 * g] * rl, o0[4 * g + 1] * rl); w0.y = pk(o0[4 * g + 2] * rl, o0[4 * g + 3] * rl); w1.x = pk(o1[4 * g] * rl, o1[4 * g + 1] * rl); w1.y = pk(o1[4 * g + 2] * rl, o1[4 * g + 3] * rl);
        *(v2u*)(yc + 8 * g + 4 * hi) = w0; *(v2u*)(yc + 32 + 8 * g + 4 * hi) = w1; }
    asm volatile("s_waitcnt lgkmcnt(0)" ::: "memory"); __builtin_amdgcn_s_barrier(); asm volatile("" ::: "memory");
#undef ATT_DMA
}
#undef ATT_MFMA
}
namespace mix {
typedef short bf16x8 __attribute__((ext_vector_type(8)));
typedef short s16x4 __attribute__((ext_vector_type(4)));
typedef float f32x2 __attribute__((ext_vector_type(2)));
#define MIX_MFMA(a, b, c) __builtin_amdgcn_mfma_f32_16x16x32_bf16((a), (b), (c), 0, 0, 0)
constexpr int BS_STR = 72, XT_STR = 136;
constexpr int LBS = 0, LCS = LBS + 128 * BS_STR * 2, LBT = LCS + 128 * BS_STR * 2, LXT = LBT + 64 * XT_STR * 2, LDT = LXT + 4 * 64 * XT_STR * 2, LACS = LDT + 4 * 128 * 4, LEND = LACS + 4 * 128 * 4;
static_assert(LEND <= RING_BYTES, "SSD LDS map");
__device__ __forceinline__ float softplus(float xv) { const float ev = __expf(xv); return xv > 20.f ? xv : (ev < 0.01f ? ev * (1.f - ev * (0.5f - ev * 0.33333333f)) : __logf(1.f + ev)); }
__device__ __forceinline__ f32x2 gelu_pk(f32x2 v) {
    const f32x2 av = __builtin_elementwise_abs(v), d = av * 0.2316418882f + 1.0f;
    f32x2 t; t.x = __builtin_amdgcn_rcpf(d.x); t.y = __builtin_amdgcn_rcpf(d.y);
    f32x2 q = t * 0.5307027145f + (-0.7265760135f); q = q * t + 0.7107068705f; q = q * t + (-0.142248368f); q = q * t + 0.127414796f; q = q * t;
    const f32x2 s = (v * v) * (-0.72134752044f);
    f32x2 e; e.x = __builtin_amdgcn_exp2f(s.x); e.y = __builtin_amdgcn_exp2f(s.y);
    const f32x2 m = v * (q * e), r = v - m;
    f32x2 o; o.x = v.x < 0.f ? m.x : r.x; o.y = v.y < 0.f ? m.y : r.y; return o;
}
__device__ __forceinline__ void ssd_chunk(Frame& F, const Args& A, int l, int unit) {
    const int g = unit & 1, c = (unit >> 1) & 31, b = unit >> 6; const int row0 = b * T_ + c * 128, tq0 = c * 128;
    const int tid = F.tid, lane = F.lane, w = F.wave, fr = lane & 15, fq = lane >> 4;
    const bf16* proj = (const bf16*)(F.ws + WS_PROJ);
    const float* cw = A.in[I_CONVW] + l * 4 * 768; const float* cb = A.in[I_CONVB] + l * 768;
    LAS unsigned char* lds = F.lds;
    { const int chp = tid & 127, tseg = tid >> 7, cg = 2 * chp, ch = 256 * g + cg;
      float wk[4][2];
#pragma unroll
      for (int k = 0; k < 4; ++k) { wk[k][0] = cw[k * 768 + ch]; wk[k][1] = cw[k * 768 + ch + 1]; }
      const float b0 = cb[ch], b1 = cb[ch + 1];
      unsigned xin[35];
#pragma unroll
      for (int i = 0; i < 35; ++i) { const int tt = tq0 + 32 * tseg - 3 + i; xin[i] = tt >= 0 ? *(const unsigned*)(proj + (size_t)(b * T_ + tt) * NPROJ + PX + ch) : 0u; }
      LAS unsigned char* x0p = lds + LXT + ((cg >> 6) * 64 + (cg & 63)) * XT_STR * 2 + 32 * tseg * 2;
#pragma unroll
      for (int i = 0; i < 32; i += 2) { float y[2][2];
#pragma unroll
          for (int u = 0; u < 2; ++u) { float a0 = b0, a1 = b1;
#pragma unroll
              for (int k = 0; k < 4; ++k) { a0 += wk[k][0] * bflo(xin[i + u + k]); a1 += wk[k][1] * bfhi(xin[i + u + k]); }
              y[u][0] = silu(a0); y[u][1] = silu(a1); }
          *(LAS unsigned*)(x0p + i * 2) = pk2(y[0][0], y[1][0]); *(LAS unsigned*)(x0p + XT_STR * 2 + i * 2) = pk2(y[0][1], y[1][1]); } }
    { const int which = tid >> 8, chp = tid & 31, tseg = (tid >> 5) & 7, n0 = 2 * chp, ch = 512 + which * 128 + 64 * g + n0, pcol = (which ? PC : PB) + 64 * g + n0;
      float wk[4][2];
#pragma unroll
      for (int k = 0; k < 4; ++k) { wk[k][0] = cw[k * 768 + ch]; wk[k][1] = cw[k * 768 + ch + 1]; }
      const float b0 = cb[ch], b1 = cb[ch + 1];
      unsigned xin[19];
#pragma unroll
      for (int i = 0; i < 19; ++i) { const int tt = tq0 + 16 * tseg - 3 + i; xin[i] = tt >= 0 ? *(const unsigned*)(proj + (size_t)(b * T_ + tt) * NPROJ + pcol) : 0u; }
      bf16* CC = (bf16*)(F.ws + WS_CC);
#pragma unroll
      for (int i = 0; i < 16; i += 2) { float y[2][2];
#pragma unroll
          for (int u = 0; u < 2; ++u) { float a0 = b0, a1 = b1;
#pragma unroll
              for (int k = 0; k < 4; ++k) { a0 += wk[k][0] * bflo(xin[i + u + k]); a1 += wk[k][1] * bfhi(xin[i + u + k]); }
              y[u][0] = silu(a0); y[u][1] = silu(a1); }
          const int s = 16 * tseg + i;
          const unsigned r0 = pk2(y[0][0], y[0][1]), r1 = pk2(y[1][0], y[1][1]);
          if (which == 0) { *(LAS unsigned*)(lds + LBS + (s * BS_STR + n0) * 2) = r0; *(LAS unsigned*)(lds + LBS + ((s + 1) * BS_STR + n0) * 2) = r1;
              *(LAS unsigned*)(lds + LBT + (n0 * XT_STR + s) * 2) = pk2(y[0][0], y[1][0]); *(LAS unsigned*)(lds + LBT + ((n0 + 1) * XT_STR + s) * 2) = pk2(y[0][1], y[1][1]); }
          else { *(LAS unsigned*)(lds + LCS + (s * BS_STR + n0) * 2) = r0; *(LAS unsigned*)(lds + LCS + ((s + 1) * BS_STR + n0) * 2) = r1;
              *(unsigned*)(CC + (size_t)(row0 + s) * 128 + 64 * g + n0) = r0; *(unsigned*)(CC + (size_t)(row0 + s + 1) * 128 + 64 * g + n0) = r1; } } }
    if (w < 4) { const int h = 4 * g + w; const float* dtv = (const float*)(F.ws + WS_DTV); const float bias = A.in[I_DTB][l * 8 + h], Ah = -__expf(A.in[I_ALOG][l * 8 + h]);
        const float d0 = softplus(dtv[(size_t)(row0 + 2 * lane) * 8 + h] + bias), d1 = softplus(dtv[(size_t)(row0 + 2 * lane + 1) * 8 + h] + bias);
        const float a0 = d0 * Ah, a1 = d1 * Ah; float s = a0 + a1;
#pragma unroll
        for (int o = 1; o < 64; o <<= 1) { const float v = __shfl_up(s, o); if (lane >= o) s += v; }
        const float c1 = s, c0 = s - a1;
        LAS float* dts = (LAS float*)(lds + LDT) + w * 128; LAS float* acs = (LAS float*)(lds + LACS) + w * 128;
        dts[2 * lane] = d0; dts[2 * lane + 1] = d1; acs[2 * lane] = c0; acs[2 * lane + 1] = c1;
        float* ACS = (float*)(F.ws + WS_ACS); ACS[(size_t)(row0 + 2 * lane) * 8 + h] = c0; ACS[(size_t)(row0 + 2 * lane + 1) * 8 + h] = c1; }
    __syncthreads();
    f32x4 cbT[8];
    { bf16x8 cf[2];
#pragma unroll
      for (int ks = 0; ks < 2; ++ks) cf[ks] = *(const LAS bf16x8*)(lds + LCS + ((16 * w + fr) * BS_STR + 32 * ks + 8 * fq) * 2);
#pragma unroll
      for (int st = 0; st < 8; ++st) { cbT[st] = (f32x4){0.f, 0.f, 0.f, 0.f};
          if (st <= w) {
#pragma unroll
              for (int ks = 0; ks < 2; ++ks) { const bf16x8 bfg = *(const LAS bf16x8*)(lds + LBS + ((16 * st + fr) * BS_STR + 32 * ks + 8 * fq) * 2); cbT[st] = MIX_MFMA(bfg, cf[ks], cbT[st]); } } } }
    const int lrow = 16 * w + fr;
#pragma unroll 1
    for (int r = 0; r < 4; ++r) { const int h = 4 * g + r;
        const LAS float* dts = (const LAS float*)(lds + LDT) + r * 128; const LAS float* acs = (const LAS float*)(lds + LACS) + r * 128;
        const float al = acs[lrow];
        bf16x8 gf[4];
#pragma unroll
        for (int i = 0; i < 4; ++i) { float gv[8];
#pragma unroll
            for (int hf = 0; hf < 2; ++hf) { const int st = 2 * i + hf; const f32x4 a4 = *(const LAS f32x4*)(acs + 16 * st + 4 * fq), d4 = *(const LAS f32x4*)(dts + 16 * st + 4 * fq);
#pragma unroll
                for (int j = 0; j < 4; ++j) { const int s = 16 * st + 4 * fq + j; gv[4 * hf + j] = s <= lrow ? cbT[st][j] * __expf(al - a4[j]) * d4[j] : 0.f; } }
            v4u pw; pw.x = pk2(gv[0], gv[1]); pw.y = pk2(gv[2], gv[3]); pw.z = pk2(gv[4], gv[5]); pw.w = pk2(gv[6], gv[7]); gf[i] = __builtin_bit_cast(bf16x8, pw); }
        const float Dh = A.in[I_SSDD][l * 8 + h];
        const LAS unsigned char* xt = lds + LXT + r * 64 * XT_STR * 2;
        bf16* yc = (bf16*)(F.ws + WS_A) + (size_t)(row0 + lrow) * 1024 + 64 * h;
#pragma unroll
        for (int pt = 0; pt < 4; ++pt) { f32x4 acc = {0.f, 0.f, 0.f, 0.f};
#pragma unroll
            for (int i = 0; i < 4; ++i) if (2 * i <= w) { const LAS unsigned char* xp = xt + ((16 * pt + fr) * XT_STR + 32 * i + 4 * fq) * 2;
                const s16x4 x0 = *(const LAS s16x4*)xp, x1 = *(const LAS s16x4*)(xp + 32);
                acc = MIX_MFMA(((bf16x8){x0[0], x0[1], x0[2], x0[3], x1[0], x1[1], x1[2], x1[3]}), gf[i], acc); }
            float xl[4];
#pragma unroll
            for (int j = 0; j < 4; ++j) xl[j] = bf2f(*(const LAS bf16*)(xt + ((16 * pt + 4 * fq + j) * XT_STR + lrow) * 2));
            v2u o; o.x = pk2(acc[0] + Dh * xl[0], acc[1] + Dh * xl[1]); o.y = pk2(acc[2] + Dh * xl[2], acc[3] + Dh * xl[3]);
            *(v2u*)(yc + 16 * pt + 4 * fq) = o; }
        { const float alast = acs[127]; const int pt = w >> 1; f32x4 s0 = {0.f, 0.f, 0.f, 0.f}, s1 = {0.f, 0.f, 0.f, 0.f};
#pragma unroll
          for (int ks = 0; ks < 4; ++ks) { const v4u xw = *(const LAS v4u*)(xt + ((16 * pt + fr) * XT_STR + 32 * ks + 8 * fq) * 2);
              const f32x4 a0 = *(const LAS f32x4*)(acs + 32 * ks + 8 * fq), a1 = *(const LAS f32x4*)(acs + 32 * ks + 8 * fq + 4), d0 = *(const LAS f32x4*)(dts + 32 * ks + 8 * fq), d1 = *(const LAS f32x4*)(dts + 32 * ks + 8 * fq + 4);
              v4u sw; sw.x = pk2(bflo(xw.x) * d0[0] * __expf(alast - a0[0]), bfhi(xw.x) * d0[1] * __expf(alast - a0[1])); sw.y = pk2(bflo(xw.y) * d0[2] * __expf(alast - a0[2]), bfhi(xw.y) * d0[3] * __expf(alast - a0[3]));
              sw.z = pk2(bflo(xw.z) * d1[0] * __expf(alast - a1[0]), bfhi(xw.z) * d1[1] * __expf(alast - a1[1])); sw.w = pk2(bflo(xw.w) * d1[2] * __expf(alast - a1[2]), bfhi(xw.w) * d1[3] * __expf(alast - a1[3]));
              const bf16x8 xa = __builtin_bit_cast(bf16x8, sw);
              const bf16x8 bt0 = *(const LAS bf16x8*)(lds + LBT + ((16 * (2 * (w & 1)) + fr) * XT_STR + 32 * ks + 8 * fq) * 2), bt1 = *(const LAS bf16x8*)(lds + LBT + ((16 * (2 * (w & 1) + 1) + fr) * XT_STR + 32 * ks + 8 * fq) * 2);
              s0 = MIX_MFMA(xa, bt0, s0); s1 = MIX_MFMA(xa, bt1, s1); }
          float* ST = (float*)(F.ws + WS_ST) + (size_t)((b * NCH + c) * 8 + h) * 4096 + (16 * pt + 4 * fq) * 64 + 32 * (w & 1) + fr;
#pragma unroll
          for (int j = 0; j < 4; ++j) { ST[j * 64] = s0[j]; ST[j * 64 + 16] = s1[j]; } }
    }
    __syncthreads();
}
__device__ __forceinline__ void state_scan2(Frame& F) {
    const float* ST = (const float*)(F.ws + WS_ST); const float* ACS = (const float*)(F.ws + WS_ACS); bf16* SB = (bf16*)(F.ws + WS_SB);
    for (int idx = F.bid * NTHR + F.tid; idx < NB * 8 * 4096; idx += F.G * NTHR) { const int pn = idx & 4095, h = (idx >> 12) & 7, b = idx >> 15; float cur = 0.f;
#pragma unroll 4
        for (int c = 0; c < NCH; ++c) { const size_t a = (size_t)((b * NCH + c) * 8 + h) * 4096 + pn; const float s = ST[a]; SB[a] = (bf16)f2bf(cur);
            cur = cur * __expf(ACS[(size_t)(b * T_ + c * 128 + 127) * 8 + h]) + s; } }
}
__device__ __forceinline__ void ssd_finish(Frame& F, const Args& A, int l, int unit) {
    const int g = unit & 1, c = (unit >> 1) & 31, b = unit >> 6; const int row0 = b * T_ + c * 128;
    const int lane = F.lane, w = F.wave, fr = lane & 15, fq = lane >> 4, lrow = row0 + 16 * w + fr;
    const bf16* proj = (const bf16*)(F.ws + WS_PROJ); const bf16* CC = (const bf16*)(F.ws + WS_CC); const bf16* SB = (const bf16*)(F.ws + WS_SB) + (size_t)((b * NCH + c) * 8 + 4 * g) * 4096;
    bf16x8 cf[2];
#pragma unroll
    for (int ks = 0; ks < 2; ++ks) cf[ks] = *(const bf16x8*)(CC + (size_t)lrow * 128 + 64 * g + 32 * ks + 8 * fq);
    const f32x4 acs4 = *(const f32x4*)((const float*)(F.ws + WS_ACS) + (size_t)lrow * 8 + 4 * g);
    bf16* yc = (bf16*)(F.ws + WS_A) + (size_t)lrow * 1024 + 256 * g + 4 * fq; const bf16* zp = proj + (size_t)lrow * NPROJ + PZ + 256 * g + 4 * fq;
    float gy[4][4][4]; float ss = 0.f;
#pragma unroll
    for (int r = 0; r < 4; ++r) { const float ea = __expf(acs4[r]);
#pragma unroll
        for (int pt = 0; pt < 4; ++pt) { f32x4 acc = {0.f, 0.f, 0.f, 0.f};
#pragma unroll
            for (int ks = 0; ks < 2; ++ks) { const bf16x8 sf = *(const bf16x8*)(SB + (size_t)r * 4096 + (16 * pt + fr) * 64 + 32 * ks + 8 * fq); acc = MIX_MFMA(sf, cf[ks], acc); }
            const v2u yd = *(const v2u*)(yc + 64 * r + 16 * pt), zz = *(const v2u*)(zp + 64 * r + 16 * pt);
            const float y0 = bflo(yd.x) + ea * acc[0], y1 = bfhi(yd.x) + ea * acc[1], y2 = bflo(yd.y) + ea * acc[2], y3 = bfhi(yd.y) + ea * acc[3];
            gy[r][pt][0] = y0 * silu(bflo(zz.x)); gy[r][pt][1] = y1 * silu(bfhi(zz.x)); gy[r][pt][2] = y2 * silu(bflo(zz.y)); gy[r][pt][3] = y3 * silu(bfhi(zz.y));
            ss += (gy[r][pt][0] * gy[r][pt][0] + gy[r][pt][1] * gy[r][pt][1]) + (gy[r][pt][2] * gy[r][pt][2] + gy[r][pt][3] * gy[r][pt][3]); } }
    ss += __shfl_xor(ss, 16); ss += __shfl_xor(ss, 32);
    const float rs = 1.f / sqrtf(ss * (1.f / 256.f) + RMS_EPS); const float* nw = A.in[I_SSDNW] + l * 512 + 256 * g + 4 * fq;
#pragma unroll
    for (int r = 0; r < 4; ++r)
#pragma unroll
        for (int pt = 0; pt < 4; ++pt) { const f32x4 n4 = *(const f32x4*)(nw + 64 * r + 16 * pt); v2u o; o.x = pk2(gy[r][pt][0] * rs * n4[0], gy[r][pt][1] * rs * n4[1]); o.y = pk2(gy[r][pt][2] * rs * n4[2], gy[r][pt][3] * rs * n4[3]);
            *(v2u*)(yc + 64 * r + 16 * pt) = o; }
}
__device__ __forceinline__ void gmlp(Frame& F, const Args& A, int l, int unit) {
    const int row0 = unit * 128; const int lane = F.lane, w = F.wave, fr = lane & 15, fq = lane >> 4;
    const bf16* proj = (const bf16*)(F.ws + WS_PROJ); LAS unsigned char* lds = F.lds;
    { const f32x4 lg = *(const f32x4*)(A.in[I_GMLNG] + l * 256 + 4 * lane), lb = *(const f32x4*)(A.in[I_GMLNB] + l * 256 + 4 * lane);
#pragma unroll 4
      for (int i = 0; i < 16; ++i) { const int s = 16 * w + i; const v2u wv = *(const v2u*)(proj + (size_t)(row0 + s) * NPROJ + PGV + 4 * lane);
          const f32x2 g0 = gelu_pk((f32x2){bflo(wv.x), bfhi(wv.x)}), g1 = gelu_pk((f32x2){bflo(wv.y), bfhi(wv.y)}); float v[4] = {g0.x, g0.y, g1.x, g1.y};
          const float mean = wave_sum((v[0] + v[1]) + (v[2] + v[3])) * (1.f / 256.f); float s2 = 0.f;
#pragma unroll
          for (int k = 0; k < 4; ++k) { v[k] -= mean; s2 += v[k] * v[k]; }
          const float rstd = 1.f / sqrtf(wave_sum(s2) * (1.f / 256.f) + LN_EPS);
#pragma unroll
          for (int k = 0; k < 4; ++k) *(LAS bf16*)(lds + ((4 * lane + k) * XT_STR + s) * 2) = (bf16)f2bf(v[k] * rstd * lg[k] + lb[k]); } }
    __syncthreads();
    const int trow = row0 + 16 * w + fr; const bf16* GMW = (const bf16*)(F.ws + WS_GMW) + (size_t)l * 4 * 128 * 128;
    bf16* yc = (bf16*)(F.ws + WS_A) + (size_t)trow * 1024 + 768 + 4 * fq; const bf16* gu = proj + (size_t)trow * NPROJ + PGU + 4 * fq;
#pragma unroll 1
    for (int gi = 0; gi < 4; ++gi) { bf16x8 wf[4];
#pragma unroll
        for (int ks = 0; ks < 4; ++ks) wf[ks] = *(const bf16x8*)(GMW + ((size_t)gi * 128 + 16 * w + fr) * 128 + 32 * ks + 8 * fq);
        const float bs = A.in[I_GMBS][(l * 4 + gi) * 128 + 16 * w + fr];
#pragma unroll
        for (int c4 = 0; c4 < 4; ++c4) { const int ct = 4 * gi + c4; f32x4 acc = {0.f, 0.f, 0.f, 0.f};
#pragma unroll
            for (int ks = 0; ks < 4; ++ks) if (2 * ks <= w) { const bf16x8 vf = *(const LAS bf16x8*)(lds + ((16 * ct + fr) * XT_STR + 32 * ks + 8 * fq) * 2); acc = MIX_MFMA(vf, wf[ks], acc); }
            const v2u gw = *(const v2u*)(gu + 16 * ct); const f32x2 g0 = gelu_pk((f32x2){bflo(gw.x), bfhi(gw.x)}), g1 = gelu_pk((f32x2){bflo(gw.y), bfhi(gw.y)});
            v2u o; o.x = pk2(g0.x * (acc[0] + bs), g0.y * (acc[1] + bs)); o.y = pk2(g1.x * (acc[2] + bs), g1.y * (acc[3] + bs)); *(v2u*)(yc + 16 * ct) = o; } }
    __syncthreads();
}
#undef MIX_MFMA
}
__device__ __forceinline__ void moe_offsets(Frame& F, int k, int (&poff)[9], int (&cnt)[8]) {
    int acc = 0;
#pragma unroll
    for (int e = 0; e < 8; ++e) { cnt[e] = (int)__hip_atomic_load(F.ctl + CW_CNT + (k * 8 + e) * 64, RLX_AGENT); poff[e] = acc; acc += (cnt[e] + 255) >> 8; }
    poff[8] = acc;
}
__device__ __forceinline__ void moe_permute(Frame& F, int k) {
    int poff[9], cnt[8]; moe_offsets(F, k, poff, cnt);
    const int* re = (const int*)(F.ws + WS_ROUTE) + k * M_; const int* rs = (const int*)(F.ws + WS_ROUTE) + 2 * M_ + k * M_; const float* rg = (const float*)(F.ws + WS_ROUTE) + 4 * M_ + k * M_;
    int* tok = (int*)(F.ws + WS_TOK); float* gwt = (float*)(tok + MOE_MAXP * 256);
    const bf16* hb = (const bf16*)(F.ws + WS_A); bf16* hp = (bf16*)(F.ws + WS_HP);
    const int gwv = F.bid * NWAVES + F.wave, NGW = F.G * NWAVES;
    for (int m = gwv; m < M_; m += NGW) { const int e = re[m], s = rs[m]; int po = 0;
#pragma unroll
        for (int q = 0; q < 8; ++q) po = (e == q) ? poff[q] : po;
        const int prow = po * 256 + s;
        const GAS v4u* src = (const GAS v4u*)(hb + (size_t)m * 1024); GAS v4u* dst = (GAS v4u*)(hp + (size_t)prow * 1024);
        dst[F.lane] = src[F.lane]; dst[64 + F.lane] = src[64 + F.lane];
        if (F.lane == 0) { tok[prow] = m; gwt[prow] = rg[m]; } }
    for (int pr = F.bid * NTHR + F.tid; pr < poff[8] * 256; pr += F.G * NTHR) { const int pm = pr >> 8; int e = 0;
#pragma unroll
        for (int q = 1; q < 8; ++q) e += (pm >= poff[q]) ? 1 : 0;
        int pe = 0, ce = 0;
#pragma unroll
        for (int q = 0; q < 8; ++q) { pe = (e == q) ? poff[q] : pe; ce = (e == q) ? cnt[q] : ce; }
        if (pr - pe * 256 >= ce) tok[pr] = -1; }
}
constexpr int N_PHASES = 25;
#define MODP ((const float*)(F.ws + WS_MOD))
#define HA ((bf16*)(F.ws + WS_A))
#define PROJ ((bf16*)(F.ws + WS_PROJ))
#ifndef PHMASK
#define PHMASK 0xFFF
#endif
#define EN(k) (((PHMASK) >> (k)) & 1)
__global__ void __launch_bounds__(NTHR, 2) fwd_kernel(Args args) {
    extern __shared__ __attribute__((aligned(16))) unsigned char lds[];
    Frame F0;
    F0.lds = (LAS unsigned char*)lds; F0.tid = threadIdx.x; F0.lane = F0.tid & 63; F0.wave = __builtin_amdgcn_readfirstlane(F0.tid >> 6);
    F0.G = gridDim.x; F0.bid = blockIdx.x; F0.ws = args.ws; F0.ctl = (gu32*)(args.ws + WS_CTL); F0.out = args.out;
    for (int u = F0.tid; u < (LDS_BYTES - LDSCTL_OFF) / 4; u += NTHR) ((LAS unsigned*)(F0.lds + LDSCTL_OFF))[u] = 0u;
    __syncthreads();
#if N_LAUNCH_MODE == 0
    XcdBarrier bar = xcd_barrier_post((unsigned*)(F0.ctl + CW_BAR), (volatile LAS unsigned*)(F0.lds + MISC_OFF) + 8);
#define GRID_BAR() do { const Frame Fb = phase_frame(F0); xcd_barrier(bar, Fb.tid == 0); } while (0)
#else
#define GRID_BAR() do {} while (0)
#endif
    const int lo = args.ph_lo, hi = args.ph_hi;
#define IN(k) (lo <= (k) && (k) < hi)
#define SEAM(k) do { if (IN(k) && IN((k) + 1)) GRID_BAR(); } while (0)

    if (EN(0) && IN(0)) { Frame F = phase_frame(F0); p0a(F, args); } SEAM(0);
    if (EN(1) && IN(1)) { Frame F = phase_frame(F0); ln_phase(F, args, args.in[I_X], args.in[I_LN0G], args.in[I_LN0B], 0, false); } SEAM(1);

    for (int l = 0; l < 2; ++l) {
        const int base = l == 0 ? 2 : 12;
        if (EN(2) && IN(base + 0)) { Frame F = phase_frame(F0);
            pg8::Gemm g{HA, (const bf16*)(F.ws + WS_WIN + l * WIN_BYTES), M_, NPROJ, 1024, 1024, 0, 0}; pg8::StaticOrder S; S.init(M_, NPROJ, F.G, F.bid);
            pg8::EpiProj E{PROJ, (float*)(F.ws + WS_DTV)};
            pg8::gemm_phase<pg8::EpiProj, pg8::StaticOrder, true, true>(F.lds + RING_OFF, g, S, E, F.tid);
        } SEAM(base + 0);
        if (EN(3) && IN(base + 1)) { Frame F = phase_frame(F0);
            token_local(F);
#ifdef MIX_NAIVE
            for (int u = F.bid; u < NB * NCH * 8; u += F.G) ssd_chunk_naive(F, args, l, u);
            for (int u = F.bid; u < NB * NCH; u += F.G) gmlp_naive(F, args, l, u);
#else
            for (int u = F.bid; u < NB * NCH * 2; u += F.G) mix::ssd_chunk(F, args, l, u);
            for (int u = F.bid; u < NB * NCH; u += F.G) mix::gmlp(F, args, l, u);
#endif
        } SEAM(base + 1);
        if (EN(4) && IN(base + 2)) { Frame F = phase_frame(F0);
#ifdef MIX_NAIVE
            state_scan(F);
#else
            mix::state_scan2(F);
#endif
            { pg8::Gemm g{PROJ + PQ, (const bf16*)(F.ws + WS_WQB + l * WQB_BYTES), M_, 1024, 256, NPROJ, WS_WKVB - WS_WQB, (size_t)(PKV - PQ) * 2}; pg8::QkvOrder S; S.init(M_, 1024, F.G, F.bid);
              pg8::EpiQKV E{{(bf16*)(F.ws + WS_Q), (const float*)(F.ws + WS_RSTD), (const float*)(F.ws + WS_ROPE), (const float*)(F.ws + WS_ROPE) + 4096 * 16, QSCALE},
                            {(bf16*)(F.ws + WS_KN), (bf16*)(F.ws + WS_V), (const float*)(F.ws + WS_RSTD) + M_}};
              pg8::gemm_phase<pg8::EpiQKV, pg8::QkvOrder, true, true>(F.lds + RING_OFF, g, S, E, F.tid); }
        } SEAM(base + 2);
        if (EN(5) && IN(base + 3)) { Frame F = phase_frame(F0);
#ifdef MIX_NAIVE
            for (int u = F.bid; u < NB * NCH * 2; u += F.G) ssd_finish_naive(F, args, l, u);
#else
            for (int u = F.bid; u < NB * NCH * 2; u += F.G) mix::ssd_finish(F, args, l, u);
#endif
#ifdef ATTN_NAIVE
            for (int u = F.bid; u < NB * 4 * 64; u += F.G) attn_naive(F, u);
#else
            for (int v = F.bid; v < NB * 4 * 8; v += F.G) { const int bh = v >> 3, s = v & 7; att::attn_unit(F, bh >> 2, bh & 3, s); att::attn_unit(F, bh >> 2, bh & 3, 15 - s); }
#endif
        } SEAM(base + 3);
        if (EN(6) && IN(base + 4)) { Frame F = phase_frame(F0);
            pg8::Gemm g{HA, (const bf16*)(F.ws + WS_WOUT + l * WOUT_BYTES), M_, 1024, 1024, 1024, 0, 0}; pg8::StaticOrder S; S.init(M_, 1024, F.G, F.bid);
            pg8::EpiResid E{F.out, MODP + (size_t)((l * 2 + 0) * 8) * 3072 + 2048, nullptr, nullptr, DN_ALPHA};
            pg8::gemm_phase<pg8::EpiResid, pg8::StaticOrder, true, true>(F.lds + RING_OFF, g, S, E, F.tid);
        } SEAM(base + 4);
        if (EN(7) && IN(base + 5)) { Frame F = phase_frame(F0); ln_phase(F, args, F.out, args.in[I_PLG] + (l * 2 + 0) * 1024, args.in[I_PLB] + (l * 2 + 0) * 1024, l * 2 + 1, l == 1); } SEAM(base + 5);
        const int npass = l == 0 ? 1 : 2;
        for (int k = 0; k < npass; ++k) {
            const int pb = base + 6 + 3 * k;
            if (EN(8) && IN(pb + 0)) { Frame F = phase_frame(F0); if (l == 1) moe_permute(F, k); } if (l == 1) SEAM(pb + 0);
            Frame F = phase_frame(F0);
            pg8::MoeOrder S; int cnt[8]; int npan = M_ / 256;
            if (l == 1) { moe_offsets(F, k, S.poff, cnt); npan = S.poff[8]; }
            else {
#pragma unroll
                for (int e = 0; e < 9; ++e) S.poff[e] = e == 0 ? 0 : npan; }
            if (EN(9) && IN(pb + 1)) { Frame F = phase_frame(F0);
                pg8::Gemm g{l == 0 ? HA : (const bf16*)(F.ws + WS_HP), (const bf16*)(F.ws + (l == 0 ? WS_W13 : WS_MW13)), npan * 256, 5632, 1024, 1024, l == 0 ? 0 : W13_BYTES, 0}; S.init(npan * 256, 5632, F.G, F.bid);
                pg8::EpiSwiGLU E{(bf16*)(F.ws + (l == 0 ? WS_ACT : WS_ACTM)), FF};
                pg8::gemm_phase<pg8::EpiSwiGLU, pg8::MoeOrder, true, true>(F.lds + RING_OFF, g, S, E, F.tid);
            } SEAM(pb + 1);
            if (EN(10) && IN(pb + 2)) { Frame F = phase_frame(F0);
                pg8::Gemm g{(const bf16*)(F.ws + (l == 0 ? WS_ACT : WS_ACTM)), (const bf16*)(F.ws + (l == 0 ? WS_W2 : WS_MW2)), npan * 256, 1024, FF, FF, l == 0 ? 0 : W2_BYTES, 0}; S.init(npan * 256, 1024, F.G, F.bid);
                const int* tok = l == 0 ? nullptr : (const int*)(F.ws + WS_TOK);
                pg8::EpiResid E{F.out, MODP + (size_t)((l * 2 + 1) * 8) * 3072 + 2048, tok, l == 0 ? nullptr : (const float*)(tok + MOE_MAXP * 256), k == 0 ? DN_ALPHA : 1.f};
                pg8::gemm_phase<pg8::EpiResid, pg8::MoeOrder, true, true>(F.lds + RING_OFF, g, S, E, F.tid);
            } SEAM(pb + 2);
        }
        const int pl = base + 6 + 3 * npass;
        if (EN(11) && IN(pl)) { Frame F = phase_frame(F0); ln_phase(F, args, F.out, args.in[I_PLG] + (l * 2 + 1) * 1024, args.in[I_PLB] + (l * 2 + 1) * 1024, l == 0 ? 2 : -1, false); } SEAM(pl);
    }
}

extern "C" void kernel_launch(void* const* d_in, const int* in_sizes, int n_in, void* d_out, int out_size, void* d_ws, size_t ws_size, hipStream_t stream) {
    static int grid = 0;
    if (grid == 0) {
        if (n_in != 31 || out_size != M_ * D_ || ws_size < WS_END) { fprintf(stderr, "kernel_launch: unexpected shapes (n_in %d, out %d, ws %zu)\n", n_in, out_size, ws_size); grid = -1; return; }
        int dev = 0, cus = 0;
        if (hipGetDevice(&dev) != hipSuccess || hipDeviceGetAttribute(&cus, hipDeviceAttributeMultiprocessorCount, dev) != hipSuccess) { grid = -1; return; }
        if (hipFuncSetAttribute((const void*)fwd_kernel, hipFuncAttributeMaxDynamicSharedMemorySize, LDS_BYTES) != hipSuccess) { fprintf(stderr, "kernel_launch: hipFuncSetAttribute failed\n"); grid = -1; return; }
        int per_cu = 0;
        if (hipOccupancyMaxActiveBlocksPerMultiprocessor(&per_cu, (const void*)fwd_kernel, NTHR, LDS_BYTES) != hipSuccess || per_cu < 1) fprintf(stderr, "kernel_launch: occupancy query reports %d\n", per_cu);
        (void)hipGetLastError();
        grid = cus;
    }
    if (grid < 0) return;
    (void)hipMemsetAsync((char*)d_ws + WS_CTL, 0, CTL_ZERO_BYTES, stream);
    Args a{};
    for (int i = 0; i < 31; ++i) a.in[i] = (const float*)d_in[i];
    a.out = (float*)d_out; a.ws = (unsigned char*)d_ws;
#if N_LAUNCH_MODE == 0
    a.ph_lo = 0; a.ph_hi = N_PHASES;
    hipLaunchKernelGGL(fwd_kernel, dim3(grid), dim3(NTHR), LDS_BYTES, stream, a);
#else
    for (int p = 0; p < N_PHASES; ++p) { a.ph_lo = p; a.ph_hi = p + 1; hipLaunchKernelGGL(fwd_kernel, dim3(grid), dim3(NTHR), LDS_BYTES, stream, a); }
#endif
}
```

```cpp
#include <hip/hip_runtime.h>
#include <cstdio>
#include <cstdint>
#ifndef MOE_FP8
#define MOE_FP8 1
#endif
#ifndef N_LAUNCH_MODE
#define N_LAUNCH_MODE 0
#endif
namespace pg8 {
#define PG8_LAS __attribute__((address_space(3)))
typedef unsigned short bf16_t;
typedef short bf16x8 __attribute__((ext_vector_type(8)));
typedef float f32x4 __attribute__((ext_vector_type(4)));
typedef unsigned u32x4 __attribute__((ext_vector_type(4)));
typedef int i32x4 __attribute__((ext_vector_type(4)));
typedef int i32x8 __attribute__((ext_vector_type(8)));
constexpr int BM = 256, BK = 64, HALF = 128, HTB = HALF * BK * 2  , STAGE_BYTES = 8 * HTB, NXCD = 8, WGM = 8;

__host__ __device__ __forceinline__ int lds_byte(int r, int c) { const int st = (r >> 4) * 2 + (c >> 5), rr = r & 15, cc = c & 31, ob = rr * 64 + cc * 2; return st * 1024 + (ob ^ (((ob >> 9) & 1) << 5)); }
__host__ __device__ __forceinline__ void stage_rc(int b, int& R, int& C) { const int st = b / 1024, sb = b % 1024, swz = sb ^ (((sb >> 9) & 1) << 5); R = (st >> 1) * 16 + swz / 64; C = (st & 1) * 32 + (swz % 64) / 2; }
__host__ __device__ __forceinline__ int perm32(int rho) { const int n = rho >> 4, i = rho & 15; return 8 * (i >> 2) + 4 * n + (i & 3); }

struct Unit { int pm, pn, e; };
struct Gemm { const bf16_t* A; const bf16_t* Bt; int M, N, K, lda; size_t estride, aestride; };

struct StaticOrder {
    int nM, nN, nwg, G, c;
    __host__ __device__ void init(int M, int N, int G_, int c_) { nM = M / BM; nN = N / BM; nwg = nM * nN; G = G_; c = c_; }
    __host__ __device__ bool next(int i, Unit& u) const {
        const long L = (long)i * G + c; if (L >= nwg) return false;
        int wgid = (int)L; { const int q = nwg / NXCD, r = nwg % NXCD, xcd = wgid % NXCD, off = wgid / NXCD; wgid = (xcd < r ? xcd * (q + 1) : r * (q + 1) + (xcd - r) * q) + off; }
        const int nig = WGM * nN, gid = wgid / nig, fm = gid * WGM, gsz = (nM - fm) < WGM ? (nM - fm) : WGM;
        u.pm = fm + ((wgid % nig) % gsz); u.pn = (wgid % nig) / gsz; u.e = 0; return true;
    }
    __device__ __forceinline__ void a_ready(const Unit&) const {}
    __device__ __forceinline__ void done(const Unit&) const {}
};
struct MoeOrder : StaticOrder {
    int poff[9];
    __device__ bool next(int i, Unit& u) const {
        if (!StaticOrder::next(i, u)) return false;
        int e = 0;
#pragma unroll
        for (int k = 1; k < 8; ++k) e += (u.pm >= poff[k]) ? 1 : 0;
        u.e = e; return true;
    }
};
struct QkvOrder : StaticOrder {
    __device__ bool next(int i, Unit& u) const { if (!StaticOrder::next(i, u)) return false; u.e = u.pn >> 1; u.pn &= 1; return true; }
};
__device__ __forceinline__ unsigned cvt_pk_bf16(float lo, float hi) { unsigned r; asm volatile("v_cvt_pk_bf16_f32 %0, %1, %2" : "=v"(r) : "v"(lo), "v"(hi)); return r; }
typedef float f32x2 __attribute__((ext_vector_type(2)));
__device__ __forceinline__ u32x4 pack8(const f32x4 v0, const f32x4 v1) { u32x4 w; w.x = cvt_pk_bf16(v0[0], v0[1]); w.y = cvt_pk_bf16(v0[2], v0[3]); w.z = cvt_pk_bf16(v1[0], v1[1]); w.w = cvt_pk_bf16(v1[2], v1[3]); return w; }
__device__ __forceinline__ float silu_f(float a) { return a * __builtin_amdgcn_rcpf(1.f + __expf(-a)); }
__device__ __forceinline__ float q8(float x) { x = fminf(fmaxf(x, -448.f), 448.f); const int p = __builtin_amdgcn_cvt_pk_fp8_f32(x, x, 0, false); return __builtin_amdgcn_cvt_f32_fp8(p, 0); }
__device__ __forceinline__ float clamp8(float x) { return fminf(fmaxf(x, -448.f), 448.f); }
__device__ __forceinline__ unsigned fp8x4(const f32x4 v) { int p = __builtin_amdgcn_cvt_pk_fp8_f32(clamp8(v[0]), clamp8(v[1]), 0, false); p = __builtin_amdgcn_cvt_pk_fp8_f32(clamp8(v[2]), clamp8(v[3]), p, true); return (unsigned)p; }

struct EpiProj {
    static constexpr bool PERM = true, AFTER_DRAIN = false;
    bf16_t* O; float* dtv;
    __device__ __forceinline__ void operator()(const f32x4 (&acc)[2][2][4][2], const Unit& u, int wr, int wc, int fr, int fq) const {
        const int row0 = u.pm * BM + wr * 64 + fr, col0 = u.pn * BM + wc * 32 + 8 * fq;
#pragma unroll
        for (int ai = 0; ai < 2; ++ai)
#pragma unroll
            for (int m = 0; m < 4; ++m) { bf16_t* rowp = O + (size_t)(row0 + ai * HALF + m * 16) * 2304 + col0;
#pragma unroll
                for (int bj = 0; bj < 2; ++bj) *(u32x4*)(rowp + bj * HALF) = pack8(acc[ai][bj][m][0], acc[ai][bj][m][1]); }
        if (u.pn == 6 && wc == 1 && fq == 0) {
#pragma unroll
            for (int ai = 0; ai < 2; ++ai)
#pragma unroll
                for (int m = 0; m < 4; ++m) { float* dp = dtv + (size_t)(row0 + ai * HALF + m * 16) * 8; *(f32x4*)dp = acc[ai][1][m][0]; *(f32x4*)(dp + 4) = acc[ai][1][m][1]; }
        }
    }
};
struct EpiQ {
    static constexpr bool PERM = true, AFTER_DRAIN = false;
    bf16_t* Q; const float* rstd; const float* ropec; const float* ropes; float qscale;
    __device__ __forceinline__ void operator()(const f32x4 (&acc)[2][2][4][2], const Unit& u, int wr, int wc, int fr, int fq) const {
        const int row0 = u.pm * BM + wr * 64 + fr;
#pragma unroll
        for (int bj = 0; bj < 2; ++bj) { const int lc = bj * HALF + wc * 32 + 8 * fq; if (lc >= 192) continue;
            const int hc = lc % 96, g = (hc - 64) >> 3;
#pragma unroll
            for (int ai = 0; ai < 2; ++ai)
#pragma unroll
                for (int m = 0; m < 4; ++m) { const int row = row0 + ai * HALF + m * 16; const float s = rstd[row] * qscale; f32x4 v0 = acc[ai][bj][m][0] * s, v1 = acc[ai][bj][m][1] * s;
                    if (hc >= 64) { const int t = row & 4095; const f32x4 c4 = *(const f32x4*)(ropec + t * 16 + 4 * g), s4 = *(const f32x4*)(ropes + t * 16 + 4 * g);
                        const f32x4 o0 = v0 * c4 - v1 * s4, o1 = v0 * s4 + v1 * c4; v0 = o0; v1 = o1; }
                    *(u32x4*)(Q + (size_t)row * 384 + u.pn * 192 + lc) = pack8(v0, v1); asm volatile("" ::: "memory"); } }
    }
};
struct EpiKV {
    static constexpr bool PERM = true, AFTER_DRAIN = false;
    bf16_t* KN; bf16_t* V; const float* rstd;
    __device__ __forceinline__ void operator()(const f32x4 (&acc)[2][2][4][2], const Unit& u, int wr, int wc, int fr, int fq) const {
        const int row0 = u.pm * BM + wr * 64 + fr, col0 = wc * 32 + 8 * fq; bf16_t* base = u.pn == 0 ? KN : V;
#pragma unroll
        for (int ai = 0; ai < 2; ++ai)
#pragma unroll
            for (int m = 0; m < 4; ++m) { const int row = row0 + ai * HALF + m * 16; const float s = rstd[row];
#pragma unroll
                for (int bj = 0; bj < 2; ++bj) *(u32x4*)(base + (size_t)row * 256 + col0 + bj * HALF) = pack8(acc[ai][bj][m][0] * s, acc[ai][bj][m][1] * s); }
    }
};
struct EpiQKV {
    static constexpr bool PERM = true, AFTER_DRAIN = false;
    EpiQ q; EpiKV kv;
    __device__ __forceinline__ void operator()(const f32x4 (&acc)[2][2][4][2], const Unit& u, int wr, int wc, int fr, int fq) const { if (u.e == 0) q(acc, u, wr, wc, fr, fq); else kv(acc, u, wr, wc, fr, fq); }
};
struct EpiSwiGLU {
    static constexpr bool PERM = true, AFTER_DRAIN = false;
    void* O; int ldo; float ain, qs;
    __device__ __forceinline__ void operator()(const f32x4 (&acc)[2][2][4][2], const Unit& u, int wr, int wc, int fr, int fq) const {
        const int row0 = u.pm * BM + wr * 64 + fr, col0 = u.pn * HALF + wc * 32 + 8 * fq;
#pragma unroll
        for (int ai = 0; ai < 2; ++ai)
#pragma unroll
            for (int m = 0; m < 4; ++m) { const f32x4 a0 = acc[ai][0][m][0] * ain, a1 = acc[ai][0][m][1] * ain, g0 = acc[ai][1][m][0] * ain, g1 = acc[ai][1][m][1] * ain;
                const f32x4 r0 = {silu_f(a0[0]) * g0[0], silu_f(a0[1]) * g0[1], silu_f(a0[2]) * g0[2], silu_f(a0[3]) * g0[3]}, r1 = {silu_f(a1[0]) * g1[0], silu_f(a1[1]) * g1[1], silu_f(a1[2]) * g1[2], silu_f(a1[3]) * g1[3]};
                const size_t off = (size_t)(row0 + ai * HALF + m * 16) * ldo + col0;
                if (qs == 0.f) *(u32x4*)((bf16_t*)O + off) = pack8(r0, r1);
                else { typedef unsigned u32x2 __attribute__((ext_vector_type(2))); u32x2 w; w.x = fp8x4(r0 * qs); w.y = fp8x4(r1 * qs); *(u32x2*)((unsigned char*)O + off) = w; } }
    }
};
struct EpiResid {
    static constexpr bool PERM = false, AFTER_DRAIN = false;
    float* X; const float* gate; const int* tok; const float* gw; float xscale; bool dry; float ascale;
    __device__ __forceinline__ void operator()(const f32x4 (&acc)[2][2][4][2], const Unit& u, int wr, int wc, int fr, int fq) const {
        const int row0 = u.pm * BM + wr * 64 + fr, col0 = u.pn * BM + wc * 32 + 4 * fq;
#pragma unroll
        for (int ai = 0; ai < 2; ++ai)
#pragma unroll
            for (int m = 0; m < 4; ++m) { const int prow = row0 + ai * HALF + m * 16; const int token = tok ? tok[prow] : prow; if (token < 0) continue;
                const float w = (gw ? gw[prow] : 1.f) * ascale; const float* gp = gate + (size_t)(token >> 12) * 3072 + col0; float* xp = X + (size_t)token * 1024 + col0;
#pragma unroll
                for (int bj = 0; bj < 2; ++bj)
#pragma unroll
                    for (int n = 0; n < 2; ++n) { const f32x4 gv = *(const f32x4*)(gp + bj * HALF + n * 16), old = *(const f32x4*)(xp + bj * HALF + n * 16);
                        if (!dry) *(f32x4*)(xp + bj * HALF + n * 16) = old * xscale + (gv + 1.f) * (acc[ai][bj][m][n] * w); } }
    }
};
template <class Epi, class Sched, bool ALIGN_EPI = false, bool SP2 = false, int ES = 2  >
__device__ __forceinline__ void gemm_phase(PG8_LAS unsigned char* lds, const Gemm g, const Sched& S, const Epi& E, int tid) {
    const int wid = __builtin_amdgcn_readfirstlane(tid >> 6), lane = tid & 63, wr = wid >> 2, wc = wid & 3, fr = lane & 15, fq = lane >> 4;
    int K = g.K; asm volatile("" : "+s"(K));
    const int nt = (K * ES) / (BK * 2);
    unsigned voffA[2], voffB[2];
#pragma unroll
    for (int i = 0; i < 2; ++i) { int R, C; stage_rc(tid * 16 + i * 8192, R, C); const int Rb = Epi::PERM ? ((R & ~31) + perm32(R & 31)) : R;
        voffA[i] = (unsigned)(R * g.lda * ES + C * 2); voffB[i] = (unsigned)(Rb * K * ES + C * 2); }
    const size_t kstep = (size_t)(BK * 2);
    const size_t hstepA = (size_t)HALF * g.lda * ES, hstepB = (size_t)HALF * K * ES;
    const size_t tstepA = 2 * hstepA, tstepB = 2 * hstepB;
    const unsigned ldsw = (unsigned)wid * 1024u;
    const int aoff = lds_byte(wr * 64 + fr, fq * 8), boff = lds_byte(wc * 32 + fr, fq * 8);
#define PG8_SA(b, h) (((b) * 2 + (h)) * HTB)
#define PG8_SB(b, h) ((4 + (b) * 2 + (h)) * HTB)
#define PG8_STAGE(bufoff, gbase, voff) do { _Pragma("unroll") for (int _i = 0; _i < 2; ++_i) \
        __builtin_amdgcn_global_load_lds((const unsigned*)((const char*)(gbase) + (voff)[_i]), (PG8_LAS unsigned*)(lds + (bufoff) + ldsw + _i * 8192), 16, 0, 0); } while (0)
#define PG8_LDA(dst, b, h) do { _Pragma("unroll") for (int m = 0; m < 4; ++m) _Pragma("unroll") for (int k = 0; k < 2; ++k) dst[m][k] = *(const PG8_LAS bf16x8*)(lds + PG8_SA(b, h) + aoff + m * 2048 + k * 1024); } while (0)
#define PG8_LDB(dst, b, h) do { _Pragma("unroll") for (int n = 0; n < 2; ++n) _Pragma("unroll") for (int k = 0; k < 2; ++k) dst[n][k] = *(const PG8_LAS bf16x8*)(lds + PG8_SB(b, h) + boff + n * 2048 + k * 1024); } while (0)
#define PG8_CAT(x) __builtin_shufflevector(__builtin_bit_cast(i32x4, (x)[0]), __builtin_bit_cast(i32x4, (x)[1]), 0, 1, 2, 3, 4, 5, 6, 7)
#define PG8_MMA(ai, bj, At, Bt) do { __builtin_amdgcn_s_setprio(1); if constexpr (ES == 2) { _Pragma("unroll") for (int m = 0; m < 4; ++m) _Pragma("unroll") for (int n = 0; n < 2; ++n) _Pragma("unroll") for (int k = 0; k < 2; ++k) \
        acc[ai][bj][m][n] = __builtin_amdgcn_mfma_f32_16x16x32_bf16(Bt[n][k], At[m][k], acc[ai][bj][m][n], 0, 0, 0); } else { _Pragma("unroll") for (int m = 0; m < 4; ++m) _Pragma("unroll") for (int n = 0; n < 2; ++n) \
        asm volatile("v_mfma_scale_f32_16x16x128_f8f6f4 %0, %1, %2, %0, %3, %3 op_sel_hi:[0,0,0]" : "+v"(acc[ai][bj][m][n]) : "v"(PG8_CAT(Bt[n])), "v"(PG8_CAT(At[m])), "v"(sc1)); } __builtin_amdgcn_s_setprio(0); } while (0)
#define PG8_WAIT_V(n) asm volatile("s_waitcnt vmcnt(" #n ")" ::: "memory")
#define PG8_WAIT_L(n) asm volatile("s_waitcnt lgkmcnt(" #n ")" ::: "memory")
#define PG8_BAR __builtin_amdgcn_s_barrier()
#define PG8_SCHED __builtin_amdgcn_sched_barrier(0)
    Unit cur, nxt; int ui = 0;
    if (!S.next(0, cur)) return;
    const int sc1 = 0x7f7f7f7f; (void)sc1;
    f32x4 acc[2][2][4][2];
#pragma unroll
    for (int a = 0; a < 2; ++a)
#pragma unroll
        for (int b = 0; b < 2; ++b)
#pragma unroll
            for (int m = 0; m < 4; ++m)
#pragma unroll
                for (int n = 0; n < 2; ++n) acc[a][b][m][n] = (f32x4){0.f, 0.f, 0.f, 0.f};
    bf16x8 At[4][2], B0[2][2], B1[2][2];
    const char* cA = (const char*)g.A + (size_t)cur.e * g.aestride + (size_t)cur.pm * tstepA; const char* cB = (const char*)g.Bt + (size_t)cur.e * g.estride + (size_t)cur.pn * tstepB;
    S.a_ready(cur);
    if constexpr (SP2) {
        PG8_STAGE(PG8_SB(0, 0), cB, voffB); PG8_STAGE(PG8_SB(0, 1), cB + hstepB, voffB); PG8_STAGE(PG8_SA(0, 0), cA, voffA); PG8_STAGE(PG8_SA(0, 1), cA + hstepA, voffA);
        if (wr == 1) PG8_BAR;
        PG8_WAIT_V(2); PG8_BAR;
        PG8_STAGE(PG8_SB(1, 0), cB + kstep, voffB); PG8_STAGE(PG8_SA(1, 0), cA + kstep, voffA); PG8_STAGE(PG8_SB(1, 1), cB + hstepB + kstep, voffB);
        PG8_WAIT_V(6); PG8_BAR;
    } else {
        PG8_STAGE(PG8_SB(0, 0), cB, voffB); PG8_STAGE(PG8_SA(0, 0), cA, voffA); PG8_STAGE(PG8_SB(0, 1), cB + hstepB, voffB); PG8_STAGE(PG8_SA(0, 1), cA + hstepA, voffA);
        if (wr == 1) PG8_BAR;
        PG8_WAIT_V(4); PG8_BAR;
        PG8_STAGE(PG8_SB(1, 0), cB + kstep, voffB); PG8_STAGE(PG8_SA(1, 0), cA + kstep, voffA); PG8_STAGE(PG8_SB(1, 1), cB + hstepB + kstep, voffB);
        PG8_WAIT_V(6); PG8_BAR;
    }
    for (;;) {
        const bool has_next = S.next(ui + 1, nxt);
        const char* nA = has_next ? (const char*)g.A + (size_t)nxt.e * g.aestride + (size_t)nxt.pm * tstepA : cA; const char* nB = has_next ? (const char*)g.Bt + (size_t)nxt.e * g.estride + (size_t)nxt.pn * tstepB : cB;
        for (int t = 0; t < nt; t += 2) {
            const bool last = (t == nt - 2);
            const char* a1 = cA + (size_t)(t + 1) * kstep;
            const char* a2 = last ? nA : cA + (size_t)(t + 2) * kstep; const char* b2 = last ? nB : cB + (size_t)(t + 2) * kstep;
            const char* a3 = a2 + kstep; const char* b3 = b2 + kstep;
            if (last && has_next) S.a_ready(nxt);
            if constexpr (SP2) {
            PG8_LDB(B0, 0, 0); PG8_LDB(B1, 0, 1); PG8_SCHED; PG8_LDA(At, 0, 0); PG8_STAGE(PG8_SA(1, 1), a1 + hstepA, voffA);
            PG8_WAIT_V(8); PG8_WAIT_L(0); PG8_BAR; PG8_MMA(0, 0, At, B0); PG8_MMA(0, 1, At, B1); PG8_BAR; PG8_SCHED;
            PG8_LDA(At, 0, 1); PG8_STAGE(PG8_SB(0, 0), b2, voffB); PG8_STAGE(PG8_SB(0, 1), b2 + hstepB, voffB); PG8_STAGE(PG8_SA(0, 0), a2, voffA);
            PG8_WAIT_V(8); PG8_WAIT_L(0); PG8_BAR; PG8_MMA(1, 0, At, B0); PG8_MMA(1, 1, At, B1); PG8_BAR; PG8_SCHED;
            PG8_LDB(B0, 1, 0); PG8_LDB(B1, 1, 1); PG8_SCHED; PG8_LDA(At, 1, 0); PG8_STAGE(PG8_SA(0, 1), a2 + hstepA, voffA);
            PG8_WAIT_V(8); PG8_WAIT_L(0); PG8_BAR; PG8_MMA(0, 0, At, B0); PG8_MMA(0, 1, At, B1); PG8_BAR; PG8_SCHED;
            PG8_LDA(At, 1, 1); PG8_STAGE(PG8_SB(1, 0), b3, voffB); PG8_STAGE(PG8_SB(1, 1), b3 + hstepB, voffB); PG8_STAGE(PG8_SA(1, 0), a3, voffA);
            PG8_WAIT_V(8); PG8_WAIT_L(0); PG8_BAR; PG8_MMA(1, 0, At, B0); PG8_MMA(1, 1, At, B1); PG8_BAR; PG8_SCHED;
            } else {
            PG8_LDB(B0, 0, 0); PG8_SCHED; PG8_LDA(At, 0, 0); PG8_STAGE(PG8_SA(1, 1), a1 + hstepA, voffA);
            PG8_WAIT_L(8); PG8_BAR; PG8_WAIT_L(0); PG8_MMA(0, 0, At, B0); PG8_BAR; PG8_SCHED;
            PG8_LDB(B1, 0, 1); PG8_STAGE(PG8_SB(0, 0), b2, voffB);
            PG8_BAR; PG8_WAIT_L(0); PG8_MMA(0, 1, At, B1); PG8_BAR;
            PG8_LDA(At, 0, 1); PG8_STAGE(PG8_SA(0, 0), a2, voffA);
            PG8_BAR; PG8_WAIT_L(0); PG8_MMA(1, 0, At, B0); PG8_BAR; PG8_SCHED;
            PG8_STAGE(PG8_SB(0, 1), b2 + hstepB, voffB);
            PG8_WAIT_V(6); PG8_BAR; PG8_MMA(1, 1, At, B1); PG8_BAR;
            PG8_LDB(B0, 1, 0); PG8_SCHED; PG8_LDA(At, 1, 0); PG8_STAGE(PG8_SA(0, 1), a2 + hstepA, voffA);
            PG8_WAIT_L(8); PG8_BAR; PG8_WAIT_L(0); PG8_MMA(0, 0, At, B0); PG8_BAR; PG8_SCHED;
            PG8_LDB(B1, 1, 1); PG8_STAGE(PG8_SB(1, 0), b3, voffB);
            PG8_BAR; PG8_WAIT_L(0); PG8_MMA(0, 1, At, B1); PG8_BAR;
            PG8_LDA(At, 1, 1); PG8_STAGE(PG8_SA(1, 0), a3, voffA);
            PG8_BAR; PG8_WAIT_L(0); PG8_MMA(1, 0, At, B0); PG8_BAR; PG8_SCHED;
            PG8_STAGE(PG8_SB(1, 1), b3 + hstepB, voffB);
            PG8_WAIT_V(6); PG8_BAR; PG8_MMA(1, 1, At, B1); PG8_BAR;
            }
        }
        if constexpr (ES == 1) asm volatile("s_nop 15\n\ts_nop 15" ::: "memory");
        if constexpr (ALIGN_EPI) { if (wr == 0) PG8_BAR; }
        if constexpr (!Epi::AFTER_DRAIN) { E(acc, cur, wr, wc, fr, fq); S.done(cur); }
        if (!has_next) break;
#pragma unroll
        for (int a = 0; a < 2; ++a)
#pragma unroll
            for (int b = 0; b < 2; ++b)
#pragma unroll
                for (int m = 0; m < 4; ++m)
#pragma unroll
                    for (int n = 0; n < 2; ++n) acc[a][b][m][n] = (f32x4){0.f, 0.f, 0.f, 0.f};
        cur = nxt; cA = nA; cB = nB; ++ui;
        if constexpr (ALIGN_EPI) { if (wr == 1) PG8_BAR; }
    }
    PG8_WAIT_V(0);
    if constexpr (!ALIGN_EPI) { if (wr == 0) PG8_BAR; }
    PG8_BAR;
    if constexpr (Epi::AFTER_DRAIN) { E.fused(acc, cur, wr, wc, fr, fq, lds, wid, lane); S.done(cur); }
#undef PG8_SA
#undef PG8_SB
#undef PG8_STAGE
#undef PG8_LDA
#undef PG8_LDB
#undef PG8_MMA
#undef PG8_CAT
#undef PG8_WAIT_V
#undef PG8_WAIT_L
#undef PG8_BAR
#undef PG8_SCHED
}
}
constexpr int NWAVES = 8, NTHR = 512;
constexpr int NB = 8, T_ = 4096, D_ = 1024, M_ = NB * T_, DIN = 2216, NPROJ = 2304, FF = 2816, NE = 8, NCH = 32  ;
constexpr int PZ = 0, PX = 512, PB = 1024, PC = 1152, PQ = 1280, PKV = 1536, PKPE = 1664, PDT = 1696, PGU = 1792, PGV = 2048;
constexpr float LN_EPS = 1e-5f, RMS_EPS = 1e-6f, DN_ALPHA = 1.41421356237f;
constexpr float QSCALE = 0.10206207261596575f * 1.4426950408889634f;
constexpr int MOE_MAXP = 136;
constexpr size_t MiB = 1u << 20;
constexpr size_t WS_CTL = 0, CTL_ZERO_BYTES = 1 * MiB;
constexpr size_t WS_MOD = 1 * MiB, WS_ROPE = 2 * MiB, WS_WQB = 3 * MiB, WS_WKVB = 4 * MiB, WS_ROUTE = 5 * MiB, WS_RSTD = 6 * MiB, WS_DTV = 7 * MiB, WS_ACS = 8 * MiB, WS_TOK = 9 * MiB, WS_GMW = 10 * MiB;
constexpr size_t WS_WIN = 16 * MiB, WS_WOUT = 25 * MiB, WS_W13 = 29 * MiB, WS_W2 = 40 * MiB, WS_MW13 = 46 * MiB, WS_MW2 = 134 * MiB;
constexpr size_t WS_A = 178 * MiB, WS_PROJ = 242 * MiB, WS_Q = 386 * MiB, WS_KN = 410 * MiB, WS_V = 426 * MiB, WS_KPE = 442 * MiB, WS_ST = 444 * MiB;
constexpr size_t WS_CC = 476 * MiB, WS_SB = 484 * MiB;
constexpr size_t WS_ACT = 242 * MiB, WS_HP = 242 * MiB, WS_ACTM = 310 * MiB, WS_END = 512 * MiB;
static_assert(WS_ACTM + (size_t)MOE_MAXP * 256 * 5632 <= WS_END && WS_ACT + (size_t)M_ * FF * 2 <= WS_END && WS_HP + (size_t)MOE_MAXP * 256 * 2048 <= WS_ACTM, "d_ws map");
constexpr size_t W13_BYTES = (size_t)5632 * 1024 * 2, W2_BYTES = (size_t)1024 * 2816 * 2, WIN_BYTES = (size_t)NPROJ * 1024 * 2, WOUT_BYTES = (size_t)1024 * 1024 * 2, WQB_BYTES = (size_t)512 * 256 * 2;
constexpr int CW_TMO = 0, CW_CODE = 1, CW_BAR = 4096, CW_CNT = 8192;
constexpr int RING_OFF = 0, RING_BYTES = 131072, LDSCTL_OFF = RING_BYTES, MISC_OFF = LDSCTL_OFF + 320, LDS_BYTES = 147456;

#define GAS __attribute__((address_space(1)))
#define LAS __attribute__((address_space(3)))
typedef unsigned short bf16;
typedef unsigned v4u __attribute__((ext_vector_type(4)));
typedef unsigned v2u __attribute__((ext_vector_type(2)));
typedef float f32x4 __attribute__((ext_vector_type(4)));
typedef GAS unsigned gu32;
#define RLX_AGENT __ATOMIC_RELAXED, __HIP_MEMORY_SCOPE_AGENT
#define LDS_WAIT() asm volatile("s_waitcnt lgkmcnt(0)" ::: "memory")
__device__ __forceinline__ unsigned f2bf(float f) { unsigned u = __builtin_bit_cast(unsigned, f); return (u + 0x7fffu + ((u >> 16) & 1u)) >> 16; }
__device__ __forceinline__ unsigned pk2(float lo, float hi) { return f2bf(lo) | (f2bf(hi) << 16); }
__device__ __forceinline__ float bf2f(bf16 v) { return __uint_as_float((unsigned)v << 16); }
__device__ __forceinline__ float bflo(unsigned w) { return __uint_as_float(w << 16); }
__device__ __forceinline__ float bfhi(unsigned w) { return __uint_as_float(w & 0xffff0000u); }
__device__ __forceinline__ float silu(float a) { return a / (1.f + __expf(-a)); }
__device__ __forceinline__ float gelu_erf(float v) { return 0.5f * v * (1.f + erff(v * 0.70710678118654752f)); }

#define XB_TMO      128
#define XB_XCNT(j)  (256  + 64 * (j))
#define XB_XSUB(j)  (1280 + 64 * (j))
#define XB_XGEN(j)  (2304 + 64 * (j))
#define XB_TOP      3328
#define XB_TOPGEN   3392
#define XCD_BAR_WORDS 3456
#define XB_SPIN_CAP (1u << 22)
__device__ __forceinline__ unsigned xb_ld(unsigned* p)              { return __hip_atomic_load(p, __ATOMIC_RELAXED, __HIP_MEMORY_SCOPE_AGENT); }
__device__ __forceinline__ unsigned xb_add(unsigned* p, unsigned v) { return __hip_atomic_fetch_add(p, v, __ATOMIC_RELAXED, __HIP_MEMORY_SCOPE_AGENT); }
__device__ __forceinline__ unsigned xb_xcc_id() { return (unsigned)__builtin_amdgcn_s_getreg((3 << 11) | 20) & 0xFu; }
#define XB_SPIN(cond, bar) do { unsigned _sp = 0; while (cond) { __builtin_amdgcn_s_sleep(1); \
    if ((++_sp & 255u) == 0u) { if (xb_ld(&(bar)[XB_TMO])) break; if (_sp > XB_SPIN_CAP) { atomicAdd(&(bar)[XB_TMO], 1u); break; } } } } while (0)
struct XcdBarrier { unsigned* bar; unsigned x; volatile LAS unsigned* st; };
__device__ __forceinline__ XcdBarrier xcd_barrier_post(unsigned* bar, volatile LAS unsigned* st) {
    XcdBarrier b; b.bar = bar; b.x = xb_xcc_id(); b.st = st;
    if (threadIdx.x == 0) (void)xb_add(&bar[XB_XCNT(b.x)], 1u);
    return b;
}
__device__ __forceinline__ void xcd_barrier_complete(unsigned* bar, unsigned x, unsigned& nloc, unsigned& nx) {
    const unsigned G = gridDim.x * gridDim.y * gridDim.z;
    unsigned sum, cnt, mine, sp = 0u;
    for (;;) {
        sum = 0u; cnt = 0u; mine = 0u;
#pragma unroll
        for (unsigned j = 0; j < 16; ++j) { const unsigned c = xb_ld(&bar[XB_XCNT(j)]); sum += c; cnt += (c > 0u) ? 1u : 0u; mine = (j == x) ? c : mine; }
        if (sum == G) break;
        __builtin_amdgcn_s_sleep(1);
        if ((++sp & 255u) == 0u) { if (xb_ld(&bar[XB_TMO])) break; if (sp > XB_SPIN_CAP) { atomicAdd(&bar[XB_TMO], 1u); break; } }
    }
    nloc = mine > 0u ? mine : 1u; nx = cnt > 0u ? cnt : 1u;
}
__device__ __forceinline__ void xcd_barrier(const XcdBarrier& b, bool leader) {
    asm volatile("s_waitcnt vmcnt(0)" ::: "memory");
    __syncthreads();
    if (leader) {
        unsigned* bar = b.bar;
        __builtin_amdgcn_s_waitcnt(0);
        unsigned nloc = b.st[0], nx = b.st[1];
        if (nloc == 0u) { xcd_barrier_complete(bar, b.x, nloc, nx); b.st[0] = nloc; b.st[1] = nx; }
        const unsigned old = xb_add(&bar[XB_XSUB(b.x)], 1u);
        const unsigned gen = old / nloc;
        if (old + 1u == (gen + 1u) * nloc) {
            __builtin_amdgcn_fence(__ATOMIC_RELEASE, "agent");
            asm volatile("s_waitcnt vmcnt(0)" ::: "memory");
            const unsigned og = xb_add(&bar[XB_TOP], 1u);
            const unsigned tg = og / nx;
            if (og + 1u == (tg + 1u) * nx) xb_add(&bar[XB_TOPGEN], 1u);
            else XB_SPIN(xb_ld(&bar[XB_TOPGEN]) == tg, bar);
            __builtin_amdgcn_fence(__ATOMIC_ACQUIRE, "agent");
            xb_add(&bar[XB_XGEN(b.x)], 1u);
            asm volatile("s_waitcnt vmcnt(0)" ::: "memory");
        } else {
            XB_SPIN(xb_ld(&bar[XB_XGEN(b.x)]) == gen, bar);
            __builtin_amdgcn_fence(__ATOMIC_ACQUIRE, "agent");
            asm volatile("s_waitcnt vmcnt(0)" ::: "memory");
        }
    }
    __syncthreads();
}

struct Args { const float* in[31]; float* out; unsigned char* ws; int ph_lo, ph_hi; };
enum { I_X = 0, I_C, I_LN0G, I_LN0B, I_ADAW, I_ADAB, I_PLG, I_PLB, I_WIN, I_CONVW, I_CONVB, I_DTB, I_ALOG, I_SSDD, I_SSDNW, I_QNORM, I_WQB, I_KVNORM, I_WKVB,
       I_GMLNG, I_GMLNB, I_GMWS, I_GMBS, I_WOUT, I_FW1, I_FW3, I_FW2, I_ROUTER, I_MW1, I_MW3, I_MW2 };
struct Frame {
    LAS unsigned char* lds; gu32* ctl; unsigned char* ws; float* out;
    int tid, lane, wave, G, bid;
};
__device__ __forceinline__ Frame phase_frame(const Frame& F0) {
    Frame P = F0; asm volatile("" : "+s"(P.wave)); asm volatile("" : "+s"(P.ws)); asm volatile("" : "+s"(P.out)); asm volatile("" : "+s"(P.G)); asm volatile("" : "+s"(P.bid));
    P.lane = (int)__builtin_amdgcn_mbcnt_hi(~0u, __builtin_amdgcn_mbcnt_lo(~0u, 0u)); asm volatile("" : "+v"(P.lane));
    P.tid = P.wave * 64 + P.lane; P.ctl = (gu32*)(P.ws + WS_CTL); return P;
}
__device__ __forceinline__ float wave_sum(float v) {
#pragma unroll
    for (int o = 1; o < 64; o <<= 1) v += __shfl_xor(v, o);
    return v;
}
__device__ __forceinline__ float wave_max(float v) {
#pragma unroll
    for (int o = 1; o < 64; o <<= 1) v = fmaxf(v, __shfl_xor(v, o));
    return v;
}

struct SrcId   { __device__ __forceinline__ int operator()(int n) const { return n; } };
struct SrcWin  { __device__ __forceinline__ int operator()(int n) const {
    if (n < 1280) return n;
    if (n < 1536) return 1288 + (n - 1280);
    if (n < 1664) return 1544 + (n - 1536);
    if (n < 1696) { const int d = n - 1664, g = d >> 3, w = d & 7; return 1672 + ((w < 4) ? 4 * g + w : 16 + 4 * g + (w - 4)); }
    if (n < 1704) return 1280 + (n - 1696);
    if (n < 1792) return -1;
    if (n < 2048) return 1704 + (n - 1792);
    return 1960 + (n - 2048); } };
struct SrcHalf { __device__ __forceinline__ int operator()(int n) const { return 128 * (n >> 8) + (n & 127); } };
struct SrcQB   { __device__ __forceinline__ int operator()(int n) const { const int pn = n >> 8, lc = n & 255; if (lc >= 192) return -1; const int h = 2 * pn + lc / 96, hc = lc % 96; if (hc < 64) return h * 96 + hc;
    const int d = hc - 64, g = d >> 3, w = d & 7; return h * 96 + 64 + ((w < 4) ? 4 * g + w : 16 + 4 * g + (w - 4)); } };
struct SrcKVB  { __device__ __forceinline__ int operator()(int n) const { const int t = n >> 8, r = n & 255, h = r >> 6, d = r & 63; return h * 128 + t * 64 + d; } };
template <class SrcFn>
__device__ __forceinline__ void tr_item(const float* W, int ldw, int Ksrc, const float* kscale, SrcFn src, bf16* WT, int Kdst, int k0, int n0, LAS unsigned char* scr, int lane, float qs = 0.f, bool out8 = false) {
    const int n4 = (lane & 15) * 4, kr = lane >> 4, sc = src(n0 + n4);
    f32x4 v[16];
#pragma unroll
    for (int i = 0; i < 16; ++i) { const int k = k0 + 4 * i + kr; v[i] = (sc >= 0 && k < Ksrc) ? *(const GAS f32x4*)(W + (size_t)k * ldw + sc) : (f32x4){0.f, 0.f, 0.f, 0.f}; }
    if (kscale) {
#pragma unroll
        for (int i = 0; i < 16; ++i) { const int k = k0 + 4 * i + kr; if (k < Ksrc) v[i] = v[i] * kscale[k]; } }
    if (qs != 0.f) { const float iq = out8 ? 1.f : 1.f / qs;
#pragma unroll
        for (int i = 0; i < 16; ++i) { v[i].x = pg8::q8(v[i].x * qs) * iq; v[i].y = pg8::q8(v[i].y * qs) * iq; v[i].z = pg8::q8(v[i].z * qs) * iq; v[i].w = pg8::q8(v[i].w * qs) * iq; } }
#pragma unroll
    for (int i = 0; i < 16; ++i) { LAS unsigned char* p = scr + (4 * i + kr) * 132 + n4 * 2; *(LAS unsigned*)p = pk2(v[i].x, v[i].y); *(LAS unsigned*)(p + 4) = pk2(v[i].z, v[i].w); }
    LDS_WAIT(); asm volatile("" ::: "memory");
    const int c = lane & 7;
#pragma unroll
    for (int j = 0; j < 8; ++j) { const int n = (lane >> 3) + 8 * j; const LAS unsigned char* p = scr + (8 * c) * 132 + n * 2;
        v4u o; o.x = (unsigned)*(const LAS bf16*)(p) | ((unsigned)*(const LAS bf16*)(p + 132) << 16); o.y = (unsigned)*(const LAS bf16*)(p + 264) | ((unsigned)*(const LAS bf16*)(p + 396) << 16);
        o.z = (unsigned)*(const LAS bf16*)(p + 528) | ((unsigned)*(const LAS bf16*)(p + 660) << 16); o.w = (unsigned)*(const LAS bf16*)(p + 792) | ((unsigned)*(const LAS bf16*)(p + 924) << 16);
        if (!out8) *(GAS v4u*)(WT + (size_t)(n0 + n) * Kdst + k0 + 8 * c) = o;
        else { v2u o8; o8.x = pg8::fp8x4((f32x4){bflo(o.x), bfhi(o.x), bflo(o.y), bfhi(o.y)}); o8.y = pg8::fp8x4((f32x4){bflo(o.z), bfhi(o.z), bflo(o.w), bfhi(o.w)});
            *(GAS v2u*)((unsigned char*)WT + (size_t)(n0 + n) * Kdst + k0 + 8 * c) = o8; } }
    LDS_WAIT(); asm volatile("" ::: "memory");
}
__device__ __forceinline__ void p0a(Frame& F, const Args& A) {
    if (F.bid < 192) {
        const int ls = F.bid / 48, col0 = (F.bid % 48) * 64;
        LAS float* sc = (LAS float*)(F.lds);
        LAS float* red = (LAS float*)(F.lds + 32768);
        const float* c = A.in[I_C];
        for (int i = F.tid; i < 8 * 1024; i += NTHR) sc[i] = silu(c[i]);
        __syncthreads();
        const float* w = A.in[I_ADAW] + (size_t)ls * 1024 * 3072 + col0 + F.lane;
        float acc[8];
#pragma unroll
        for (int b = 0; b < 8; ++b) acc[b] = 0.f;
        const int kb = F.wave * 128;
#pragma unroll 16
        for (int k = 0; k < 128; ++k) { const float wv = w[(size_t)(kb + k) * 3072];
#pragma unroll
            for (int b = 0; b < 8; ++b) acc[b] += sc[b * 1024 + kb + k] * wv; }
#pragma unroll
        for (int b = 0; b < 8; ++b) red[(F.wave * 8 + b) * 64 + F.lane] = acc[b];
        __syncthreads();
        { const int b = F.tid >> 6, l = F.tid & 63; float s = 0.f;
#pragma unroll
          for (int wv = 0; wv < 8; ++wv) s += red[(wv * 8 + b) * 64 + l];
          float* mod = (float*)(F.ws + WS_MOD);
          mod[((size_t)ls * 8 + b) * 3072 + col0 + l] = s + A.in[I_ADAB][ls * 3072 + col0 + l]; }
        __syncthreads();
    }
    {
        const double inv[16] = {1.0, 0.5623413251903491, 0.31622776601683794, 0.1778279410038923, 0.1, 0.05623413251903491, 0.03162277660168379, 0.01778279410038923,
                                0.01, 0.005623413251903491, 0.0031622776601683794, 0.0017782794100389228, 0.001, 0.0005623413251903491, 0.00031622776601683794, 0.00017782794100389227};
        float* rc = (float*)(F.ws + WS_ROPE); float* rs = rc + 4096 * 16;
        for (int idx = F.bid * NTHR + F.tid; idx < 4096 * 16; idx += F.G * NTHR) { const int t = idx >> 4, i = idx & 15;
            double iv = inv[0];
#pragma unroll
            for (int q = 1; q < 16; ++q) iv = (i == q) ? inv[q] : iv;
            const double rev = (double)t * iv * 0.15915494309189535; const float fr = (float)(rev - floor(rev));
            rc[idx] = __builtin_amdgcn_cosf(fr); rs[idx] = __builtin_amdgcn_sinf(fr); }
    }
    { const float* W = A.in[I_GMWS]; bf16* o = (bf16*)(F.ws + WS_GMW);
      for (int idx = F.bid * NTHR + F.tid; idx < 2 * 4 * 128 * 128; idx += F.G * NTHR) { const int s = idx & 127, t = (idx >> 7) & 127; o[idx] = (bf16)(s <= t ? f2bf(W[idx]) : 0u); } }
    LAS unsigned char* scr = F.lds + RING_OFF + F.wave * 16384;
    const int gw = F.bid * NWAVES + F.wave, NGW = F.G * NWAVES;
    constexpr int I_WINc = 16 * 36, I_WOUTc = 16 * 16, I_W13c = 16 * 88, I_W2c = 44 * 16, I_QBc = 4 * 8;
    constexpr int NITEMS = 2 * I_WINc + 2 * I_WOUTc + 9 * I_W13c + 9 * I_W2c + 4 * I_QBc;
    for (int it = gw; it < NITEMS; it += NGW) {
        int r = it;
        if (r < 9 * I_W13c) { const int e = r / I_W13c; r %= I_W13c; const int kb = r / 88, nb = r % 88; const int which = (nb >> 1) & 1;
            const float* W = e == 0 ? (which ? A.in[I_FW3] : A.in[I_FW1]) : ((which ? A.in[I_MW3] : A.in[I_MW1]) + (size_t)(e - 1) * 1024 * FF);
            bf16* WT = e == 0 ? (bf16*)(F.ws + WS_W13) : (bf16*)(F.ws + WS_MW13 + (size_t)(e - 1) * (MOE_FP8 ? W13_BYTES / 2 : W13_BYTES));
            tr_item(W, FF, 1024, nullptr, SrcHalf(), WT, 1024, kb * 64, nb * 64, scr, F.lane, (MOE_FP8 && e > 0) ? 32.f : 0.f, MOE_FP8 && e > 0); continue; } r -= 9 * I_W13c;
        if (r < 9 * I_W2c) { const int e = r / I_W2c; r %= I_W2c; const int kb = r / 16, nb = r % 16;
            const float* W = e == 0 ? A.in[I_FW2] : A.in[I_MW2] + (size_t)(e - 1) * FF * 1024;
            bf16* WT = e == 0 ? (bf16*)(F.ws + WS_W2) : (bf16*)(F.ws + WS_MW2 + (size_t)(e - 1) * (MOE_FP8 ? W2_BYTES / 2 : W2_BYTES));
            tr_item(W, 1024, FF, nullptr, SrcId(), WT, FF, kb * 64, nb * 64, scr, F.lane, (MOE_FP8 && e > 0) ? 128.f : 0.f, MOE_FP8 && e > 0); continue; } r -= 9 * I_W2c;
        if (r < 2 * I_WINc) { const int l = r / I_WINc; r %= I_WINc; const int kb = r / 36, nb = r % 36;
            tr_item(A.in[I_WIN] + (size_t)l * 1024 * DIN, DIN, 1024, nullptr, SrcWin(), (bf16*)(F.ws + WS_WIN + l * WIN_BYTES), 1024, kb * 64, nb * 64, scr, F.lane); continue; } r -= 2 * I_WINc;
        if (r < 2 * I_WOUTc) { const int l = r / I_WOUTc; r %= I_WOUTc; const int kb = r / 16, nb = r % 16;
            tr_item(A.in[I_WOUT] + (size_t)l * 1024 * 1024, 1024, 1024, nullptr, SrcId(), (bf16*)(F.ws + WS_WOUT + l * WOUT_BYTES), 1024, kb * 64, nb * 64, scr, F.lane); continue; } r -= 2 * I_WOUTc;
        { const int l = (r / I_QBc) & 1, isk = r / (2 * I_QBc); r %= I_QBc; const int kb = r / 8, nb = r % 8;
          if (!isk) tr_item(A.in[I_WQB] + (size_t)l * 256 * 384, 384, 256, A.in[I_QNORM] + l * 256, SrcQB(), (bf16*)(F.ws + WS_WQB + l * WQB_BYTES), 256, kb * 64, nb * 64, scr, F.lane);
          else      tr_item(A.in[I_WKVB] + (size_t)l * 128 * 512, 512, 128, A.in[I_KVNORM] + l * 128, SrcKVB(), (bf16*)(F.ws + WS_WKVB + l * WQB_BYTES), 256, kb * 64, nb * 64, scr, F.lane); }
    }
    __syncthreads();
}
__device__ __forceinline__ void ln_row(const float* vin, const float* g, const float* bt, f32x4 (&x)[4], int lane) {
    const GAS f32x4* xr = (const GAS f32x4*)vin + lane; float s = 0.f;
#pragma unroll
    for (int j = 0; j < 4; ++j) { x[j] = xr[64 * j]; s += (x[j].x + x[j].y) + (x[j].z + x[j].w); }
    const float mean = wave_sum(s) * (1.f / 1024.f); float s2 = 0.f;
#pragma unroll
    for (int j = 0; j < 4; ++j) { x[j] = x[j] - mean; s2 += (x[j].x * x[j].x + x[j].y * x[j].y) + (x[j].z * x[j].z + x[j].w * x[j].w); }
    const float rstd = 1.f / sqrtf(wave_sum(s2) * (1.f / 1024.f) + LN_EPS);
#pragma unroll
    for (int j = 0; j < 4; ++j) { const f32x4 gg = ((const GAS f32x4*)g)[lane + 64 * j], bb = ((const GAS f32x4*)bt)[lane + 64 * j]; x[j] = x[j] * rstd * gg + bb; }
}
__device__ __forceinline__ void ln_rows2_loaded(const float* g, const float* bt, f32x4 (&x)[2][4], int lane) {
    float s[2], s2[2];
#pragma unroll
    for (int i = 0; i < 2; ++i) { s[i] = 0.f;
#pragma unroll
        for (int j = 0; j < 4; ++j) s[i] += (x[i][j].x + x[i][j].y) + (x[i][j].z + x[i][j].w); }
#pragma unroll
    for (int o = 1; o < 64; o <<= 1) { s[0] += __shfl_xor(s[0], o); s[1] += __shfl_xor(s[1], o); }
#pragma unroll
    for (int i = 0; i < 2; ++i) { const float mean = s[i] * (1.f / 1024.f); s2[i] = 0.f;
#pragma unroll
        for (int j = 0; j < 4; ++j) { x[i][j] = x[i][j] - mean; s2[i] += (x[i][j].x * x[i][j].x + x[i][j].y * x[i][j].y) + (x[i][j].z * x[i][j].z + x[i][j].w * x[i][j].w); } }
#pragma unroll
    for (int o = 1; o < 64; o <<= 1) { s2[0] += __shfl_xor(s2[0], o); s2[1] += __shfl_xor(s2[1], o); }
#pragma unroll
    for (int j = 0; j < 4; ++j) { const f32x4 gg = ((const GAS f32x4*)g)[lane + 64 * j], bb = ((const GAS f32x4*)bt)[lane + 64 * j];
#pragma unroll
        for (int i = 0; i < 2; ++i) { const float rstd = 1.f / sqrtf(s2[i] * (1.f / 1024.f) + LN_EPS); x[i][j] = x[i][j] * rstd * gg + bb; } }
}
__device__ __forceinline__ void store_x_h(f32x4 (&x)[4], float* xout, bf16* hout, const float* modp, int lane) {
    if (xout) { GAS f32x4* o = (GAS f32x4*)xout + lane;
#pragma unroll
        for (int j = 0; j < 4; ++j) o[64 * j] = x[j]; }
    if (hout) { GAS v2u* o = (GAS v2u*)hout + lane;
#pragma unroll
        for (int j = 0; j < 4; ++j) { const f32x4 sh = ((const GAS f32x4*)modp)[lane + 64 * j], sc = ((const GAS f32x4*)(modp + 1024))[lane + 64 * j];
            x[j] = x[j] * (sc + 1.f) + sh; v2u w; w.x = pk2(x[j].x, x[j].y); w.y = pk2(x[j].z, x[j].w); o[64 * j] = w; } }
}
__device__ __forceinline__ void ln_phase(Frame& F, const Args& A, const float* vin, const float* g, const float* bt, int ls, bool route, bool dry) {
    const int gwv = F.bid * NWAVES + F.wave, NGW = F.G * NWAVES;
    const float* mod = (const float*)(F.ws + WS_MOD);
    bf16* hb = (bf16*)(F.ws + WS_A);
    if (!route) {
        f32x4 nx[2][4];
        if (gwv * 2 < M_) {
#pragma unroll
            for (int i = 0; i < 2; ++i)
#pragma unroll
                for (int j = 0; j < 4; ++j) nx[i][j] = ((const GAS f32x4*)(vin + (size_t)(gwv * 2 + i) * 1024) + F.lane)[64 * j]; }
        for (int m = gwv * 2; m < M_; m += NGW * 2) { f32x4 x[2][4];
#pragma unroll
            for (int i = 0; i < 2; ++i)
#pragma unroll
                for (int j = 0; j < 4; ++j) x[i][j] = nx[i][j];
            const int mn = m + NGW * 2;
            if (mn < M_) {
#pragma unroll
                for (int i = 0; i < 2; ++i)
#pragma unroll
                    for (int j = 0; j < 4; ++j) nx[i][j] = ((const GAS f32x4*)(vin + (size_t)(mn + i) * 1024) + F.lane)[64 * j]; }
            ln_rows2_loaded(g, bt, x, F.lane);
#pragma unroll
            for (int i = 0; i < 2; ++i) store_x_h(x[i], (dry ? (float*)(F.ws + WS_PROJ) : F.out) + (size_t)(m + i) * 1024, ls >= 0 ? (dry ? (bf16*)(F.ws + WS_Q) : hb) + (size_t)(m + i) * 1024 : nullptr, mod + ((size_t)(ls < 0 ? 0 : ls) * 8 + (m >> 12)) * 3072, F.lane); }
    } else {
        f32x4 wr[4][4][2];
        const float* R = A.in[I_ROUTER];
#pragma unroll
        for (int j = 0; j < 4; ++j)
#pragma unroll
            for (int i = 0; i < 4; ++i) { const float* rp = R + (size_t)(4 * F.lane + i + 256 * j) * 8; wr[j][i][0] = *(const f32x4*)rp; wr[j][i][1] = *(const f32x4*)(rp + 4); }
        int* re = (int*)(F.ws + WS_ROUTE); int* rs = re + 2 * M_; float* rg = (float*)(rs + 2 * M_);
        int it = 0, myE0 = -1, myE1 = -1, myM = 0; float myG0 = 0.f;
        for (int m = gwv; m < M_; m += NGW) { f32x4 x[4]; ln_row(vin + (size_t)m * 1024, g, bt, x, F.lane);
            store_x_h(x, (dry ? (float*)(F.ws + WS_PROJ) : F.out) + (size_t)m * 1024, (dry ? (bf16*)(F.ws + WS_Q) : hb) + (size_t)m * 1024, mod + ((size_t)ls * 8 + (m >> 12)) * 3072, F.lane);
            f32x4 p0 = {0.f, 0.f, 0.f, 0.f}, p1 = {0.f, 0.f, 0.f, 0.f};
#pragma unroll
            for (int j = 0; j < 4; ++j) { p0 += wr[j][0][0] * x[j].x + wr[j][1][0] * x[j].y + wr[j][2][0] * x[j].z + wr[j][3][0] * x[j].w;
                                           p1 += wr[j][0][1] * x[j].x + wr[j][1][1] * x[j].y + wr[j][2][1] * x[j].z + wr[j][3][1] * x[j].w; }
            float lg[8] = {wave_sum(p0.x), wave_sum(p0.y), wave_sum(p0.z), wave_sum(p0.w), wave_sum(p1.x), wave_sum(p1.y), wave_sum(p1.z), wave_sum(p1.w)};
            int i0 = 0; float v0 = lg[0];
#pragma unroll
            for (int e = 1; e < 8; ++e) if (lg[e] > v0) { v0 = lg[e]; i0 = e; }
            int i1 = -1; float v1 = -INFINITY;
#pragma unroll
            for (int e = 0; e < 8; ++e) if (e != i0 && lg[e] > v1) { v1 = lg[e]; i1 = e; }
            if (F.lane == it) { myE0 = i0; myE1 = i1; myG0 = 1.f / (1.f + __expf(v1 - v0)); myM = m; }
            ++it;
            if (it == 16 || m + NGW >= M_) {
                const bool act = F.lane < it && !dry; unsigned base0[8], base1[8]; unsigned long long b0[8], b1[8];
#pragma unroll
                for (int e = 0; e < 8; ++e) { b0[e] = __ballot(act && myE0 == e); b1[e] = __ballot(act && myE1 == e); }
#pragma unroll
                for (int e = 0; e < 8; ++e) { base0[e] = 0u; base1[e] = 0u;
                    if (F.lane == 0 && b0[e]) base0[e] = atomicAdd((unsigned*)(F.ctl + CW_CNT + (0 * 8 + e) * 64), (unsigned)__popcll(b0[e]));
                    if (F.lane == 0 && b1[e]) base1[e] = atomicAdd((unsigned*)(F.ctl + CW_CNT + (1 * 8 + e) * 64), (unsigned)__popcll(b1[e])); }
                int s0 = 0, s1 = 0; const unsigned long long lt = (1ull << F.lane) - 1ull;
#pragma unroll
                for (int e = 0; e < 8; ++e) { const unsigned bb0 = __builtin_amdgcn_readfirstlane(base0[e]), bb1 = __builtin_amdgcn_readfirstlane(base1[e]);
                    if (myE0 == e) s0 = (int)bb0 + __popcll(b0[e] & lt); if (myE1 == e) s1 = (int)bb1 + __popcll(b1[e] & lt); }
                if (act) { re[myM] = myE0; re[M_ + myM] = myE1; rs[myM] = s0; rs[M_ + myM] = s1; rg[myM] = myG0; rg[M_ + myM] = 1.f - myG0; }
                it = 0; }
        }
    }
}
__device__ __forceinline__ float conv_silu(const bf16* proj, const float* cw, const float* cb, int b, int t, int ch, int pcol) {
    float a = cb[ch];
#pragma unroll
    for (int k = 0; k < 4; ++k) { const int tt = t - 3 + k; if (tt >= 0) a += cw[k * 768 + ch] * bf2f(proj[((size_t)b * T_ + tt) * NPROJ + pcol]); }
    return silu(a);
}
__device__ __forceinline__ void ssd_chunk_naive(Frame& F, const Args& A, int l, int unit) {
    const int h = unit & 7, c = (unit >> 3) & 31, b = unit >> 8, g = h >> 2;
    const int row0 = b * T_ + c * 128;
    const bf16* proj = (const bf16*)(F.ws + WS_PROJ);
    const float* cw = A.in[I_CONVW] + l * 4 * 768; const float* cb = A.in[I_CONVB] + l * 768;
    LAS float* xs = (LAS float*)(F.lds);
    LAS float* Bs = (LAS float*)(F.lds + 32768);
    LAS float* Cs = (LAS float*)(F.lds + 65536);
    LAS float* dts = (LAS float*)(F.lds + 98304);
    LAS float* acs = dts + 128;
    for (int idx = F.tid; idx < 128 * 64; idx += NTHR) { const int t = idx >> 6, p = idx & 63;
        xs[idx] = conv_silu(proj, cw, cb, b, c * 128 + t, 64 * h + p, PX + 64 * h + p);
        Bs[idx] = conv_silu(proj, cw, cb, b, c * 128 + t, 512 + 64 * g + p, PB + 64 * g + p);
        Cs[idx] = conv_silu(proj, cw, cb, b, c * 128 + t, 640 + 64 * g + p, PC + 64 * g + p); }
    const float* dtv = (const float*)(F.ws + WS_DTV); float* ACS = (float*)(F.ws + WS_ACS);
    if (F.tid < 128) { const float xv = dtv[(size_t)(row0 + F.tid) * 8 + h] + A.in[I_DTB][l * 8 + h]; const float ev = __expf(xv); dts[F.tid] = xv > 20.f ? xv : (ev < 0.01f ? ev * (1.f - ev * (0.5f - ev * 0.33333333f)) : __logf(1.f + ev)); }
    __syncthreads();
    if (F.tid == 0) { const float Ah = -__expf(A.in[I_ALOG][l * 8 + h]); float s = 0.f; for (int t = 0; t < 128; ++t) { s += dts[t] * Ah; acs[t] = s; } }
    __syncthreads();
    if (F.tid < 128) ACS[(size_t)(row0 + F.tid) * 8 + h] = acs[F.tid];
    { float* ST = (float*)(F.ws + WS_ST) + (size_t)((b * NCH + c) * 8 + h) * 4096; const float alast = acs[127];
      for (int idx = F.tid; idx < 4096; idx += NTHR) { const int p = idx >> 6, n = idx & 63; float a = 0.f;
          for (int s = 0; s < 128; ++s) a += xs[s * 64 + p] * Bs[s * 64 + n] * (dts[s] * __expf(alast - acs[s]));
          ST[idx] = a; } }
    { const int lq = F.tid >> 2, pq = (F.tid & 3) * 16; float y[16];
#pragma unroll
      for (int i = 0; i < 16; ++i) y[i] = 0.f;
      const float al = acs[lq];
      for (int s = 0; s <= lq; ++s) { float cbv = 0.f;
#pragma unroll 8
          for (int n = 0; n < 64; ++n) cbv += Cs[lq * 64 + n] * Bs[s * 64 + n];
          const float gg = cbv * __expf(al - acs[s]) * dts[s];
#pragma unroll
          for (int i = 0; i < 16; ++i) y[i] += gg * xs[s * 64 + pq + i]; }
      const float Dh = A.in[I_SSDD][l * 8 + h];
      bf16* yc = (bf16*)(F.ws + WS_A) + (size_t)(row0 + lq) * 1024 + 64 * h + pq;
#pragma unroll
      for (int i = 0; i < 16; i += 2) *(unsigned*)(yc + i) = pk2(y[i] + Dh * xs[lq * 64 + pq + i], y[i + 1] + Dh * xs[lq * 64 + pq + i + 1]); }
    __syncthreads();
}
__device__ __forceinline__ void gmlp_naive(Frame& F, const Args& A, int l, int unit) {
    const int row0 = unit * 128;
    const bf16* proj = (const bf16*)(F.ws + WS_PROJ);
    LAS float* vs = (LAS float*)(F.lds);
    for (int r = F.wave * 16; r < F.wave * 16 + 16; ++r) { const bf16* gp = proj + (size_t)(row0 + r) * NPROJ + PGV + 4 * F.lane; const v2u w = *(const v2u*)gp;
        float v[4] = {gelu_erf(bflo(w.x)), gelu_erf(bfhi(w.x)), gelu_erf(bflo(w.y)), gelu_erf(bfhi(w.y))};
        const float mean = wave_sum((v[0] + v[1]) + (v[2] + v[3])) * (1.f / 256.f); float s2 = 0.f;
#pragma unroll
        for (int i = 0; i < 4; ++i) { v[i] -= mean; s2 += v[i] * v[i]; }
        const float rstd = 1.f / sqrtf(wave_sum(s2) * (1.f / 256.f) + LN_EPS);
#pragma unroll
        for (int i = 0; i < 4; ++i) vs[r * 256 + 4 * F.lane + i] = v[i] * rstd * A.in[I_GMLNG][l * 256 + 4 * F.lane + i] + A.in[I_GMLNB][l * 256 + 4 * F.lane + i]; }
    __syncthreads();
    { const int t = F.tid >> 2, g = F.tid & 3; const float* W = A.in[I_GMWS] + ((size_t)(l * 4 + g) * 128 + t) * 128; float a[64];
#pragma unroll
      for (int i = 0; i < 64; ++i) a[i] = 0.f;
      for (int s = 0; s <= t; ++s) { const float w = W[s];
#pragma unroll
          for (int i = 0; i < 64; ++i) a[i] += w * vs[s * 256 + 64 * g + i]; }
      const float bs = A.in[I_GMBS][(l * 4 + g) * 128 + t];
      const bf16* gu = proj + (size_t)(row0 + t) * NPROJ + PGU + 64 * g; bf16* yc = (bf16*)(F.ws + WS_A) + (size_t)(row0 + t) * 1024 + 768 + 64 * g;
#pragma unroll
      for (int i = 0; i < 64; i += 2) { const unsigned w = *(const unsigned*)(gu + i); *(unsigned*)(yc + i) = pk2(gelu_erf(bflo(w)) * (a[i] + bs), gelu_erf(bfhi(w)) * (a[i + 1] + bs)); } }
    __syncthreads();
}
__device__ __forceinline__ void token_local(Frame& F) {
    const int gwv = F.bid * NWAVES + F.wave, NGW = F.G * NWAVES;
    const bf16* proj = (const bf16*)(F.ws + WS_PROJ); float* rq = (float*)(F.ws + WS_RSTD); float* rkv = rq + M_; bf16* kpe = (bf16*)(F.ws + WS_KPE);
    const float* rc = (const float*)(F.ws + WS_ROPE); const float* rsn = rc + 4096 * 16;
    const int g = (F.lane & 15) >> 2, w = F.lane & 3, ri = 4 * g + w;
    for (int m0 = gwv * 4; m0 < M_; m0 += NGW * 4) {
        v2u wq[4]; unsigned wk[4]; float x1[4], x2[4], cs[4], sn[4];
#pragma unroll
        for (int i = 0; i < 4; ++i) { const bf16* pr = proj + (size_t)(m0 + i) * NPROJ; wq[i] = *(const v2u*)(pr + PQ + 4 * F.lane); wk[i] = *(const unsigned*)(pr + PKV + 2 * F.lane);
            x1[i] = bf2f(pr[PKPE + 8 * g + w]); x2[i] = bf2f(pr[PKPE + 8 * g + 4 + w]); const int t = (m0 + i) & 4095; cs[i] = rc[t * 16 + ri]; sn[i] = rsn[t * 16 + ri]; }
        float sq[4], sk[4];
#pragma unroll
        for (int i = 0; i < 4; ++i) { sq[i] = bflo(wq[i].x) * bflo(wq[i].x) + bfhi(wq[i].x) * bfhi(wq[i].x) + bflo(wq[i].y) * bflo(wq[i].y) + bfhi(wq[i].y) * bfhi(wq[i].y); sk[i] = bflo(wk[i]) * bflo(wk[i]) + bfhi(wk[i]) * bfhi(wk[i]); }
#pragma unroll
        for (int o = 1; o < 64; o <<= 1) {
#pragma unroll
            for (int i = 0; i < 4; ++i) { sq[i] += __shfl_xor(sq[i], o); sk[i] += __shfl_xor(sk[i], o); } }
#pragma unroll
        for (int i = 0; i < 4; ++i) { const int m = m0 + i;
            if (F.lane == 0) { rq[m] = 1.f / sqrtf(sq[i] * (1.f / 256.f) + RMS_EPS); rkv[m] = 1.f / sqrtf(sk[i] * (1.f / 128.f) + RMS_EPS); }
            if (F.lane < 16) { kpe[(size_t)m * 32 + 8 * g + w] = (bf16)f2bf(x1[i] * cs[i] - x2[i] * sn[i]); kpe[(size_t)m * 32 + 8 * g + 4 + w] = (bf16)f2bf(x1[i] * sn[i] + x2[i] * cs[i]); } }
    }
}
__device__ __forceinline__ void state_scan(Frame& F) {
    float* ST = (float*)(F.ws + WS_ST); const float* ACS = (const float*)(F.ws + WS_ACS);
    for (int idx = F.bid * NTHR + F.tid; idx < NB * 8 * 4096; idx += F.G * NTHR) { const int pn = idx & 4095, h = (idx >> 12) & 7, b = idx >> 15; float cur = 0.f;
        for (int c = 0; c < NCH; ++c) { const size_t a = (size_t)((b * NCH + c) * 8 + h) * 4096 + pn; const float s = ST[a]; ST[a] = cur;
            cur = cur * __expf(ACS[(size_t)(b * T_ + c * 128 + 127) * 8 + h]) + s; } }
}
__device__ __forceinline__ void ssd_finish_naive(Frame& F, const Args& A, int l, int unit) {
    const int g = unit & 1, c = (unit >> 1) & 31, b = unit >> 6; const int row0 = b * T_ + c * 128;
    const bf16* proj = (const bf16*)(F.ws + WS_PROJ);
    const float* cw = A.in[I_CONVW] + l * 4 * 768; const float* cb = A.in[I_CONVB] + l * 768;
    LAS float* Sin = (LAS float*)(F.lds);
    LAS float* Cs = (LAS float*)(F.lds + 4 * 64 * 65 * 4);
    const float* ST = (const float*)(F.ws + WS_ST) + (size_t)((b * NCH + c) * 8 + 4 * g) * 4096;
    for (int idx = F.tid; idx < 4 * 4096; idx += NTHR) { const int r = idx >> 12, p = (idx >> 6) & 63, n = idx & 63; Sin[(r * 64 + p) * 65 + n] = ST[idx]; }
    for (int idx = F.tid; idx < 128 * 64; idx += NTHR) { const int t = idx >> 6, n = idx & 63; Cs[t * 65 + n] = conv_silu(proj, cw, cb, b, c * 128 + t, 640 + 64 * g + n, PC + 64 * g + n); }
    __syncthreads();
    const int lq = F.tid >> 2, r = F.tid & 3, h = 4 * g + r;
    float cv[64];
#pragma unroll
    for (int n = 0; n < 64; ++n) cv[n] = Cs[lq * 65 + n];
    const float ea = __expf(((const float*)(F.ws + WS_ACS))[(size_t)(row0 + lq) * 8 + h]);
    bf16* yc = (bf16*)(F.ws + WS_A) + (size_t)(row0 + lq) * 1024 + 64 * h; const bf16* zp = proj + (size_t)(row0 + lq) * NPROJ + PZ + 64 * h;
    float ss = 0.f;
#pragma unroll 1
    for (int p = 0; p < 64; ++p) { float a = 0.f;
#pragma unroll
        for (int n = 0; n < 64; ++n) a += cv[n] * Sin[(r * 64 + p) * 65 + n];
        const float y = bf2f(yc[p]) + ea * a, gy = y * silu(bf2f(zp[p])); ss += gy * gy; }
    ss += __shfl_xor(ss, 1); ss += __shfl_xor(ss, 2);
    const float rs = 1.f / sqrtf(ss * (1.f / 256.f) + RMS_EPS); const float* nw = A.in[I_SSDNW] + l * 512 + 64 * h;
#pragma unroll 1
    for (int p = 0; p < 64; ++p) { float a = 0.f;
#pragma unroll
        for (int n = 0; n < 64; ++n) a += cv[n] * Sin[(r * 64 + p) * 65 + n];
        const float y = bf2f(yc[p]) + ea * a, gy = y * silu(bf2f(zp[p])); yc[p] = (bf16)f2bf(gy * rs * nw[p]); }
    __syncthreads();
}
__device__ __forceinline__ void attn_naive(Frame& F, int unit) {
    const int qb = unit & 63, h = (unit >> 6) & 3, b = unit >> 8;
    const bf16* Q = (const bf16*)(F.ws + WS_Q); const bf16* KN = (const bf16*)(F.ws + WS_KN); const bf16* V = (const bf16*)(F.ws + WS_V); const bf16* KPE = (const bf16*)(F.ws + WS_KPE);
    LAS float* Kt = (LAS float*)(F.lds);
    LAS float* Vt = (LAS float*)(F.lds + 64 * 97 * 4);
    LAS float* Qs = Vt + 64 * 64;
    LAS float* Pw = Qs + 64 * 96 + F.wave * 64;
    for (int idx = F.tid; idx < 64 * 96; idx += NTHR) { const int r = idx / 96, d = idx % 96; Qs[idx] = bf2f(Q[(size_t)(b * T_ + qb * 64 + r) * 384 + h * 96 + d]); }
    float mx[8], ls[8], o[8];
#pragma unroll
    for (int i = 0; i < 8; ++i) { mx[i] = -INFINITY; ls[i] = 0.f; o[i] = 0.f; }
    for (int kt = 0; kt <= qb; ++kt) {
        __syncthreads();
        for (int idx = F.tid; idx < 64 * 96; idx += NTHR) { const int j = idx / 96, d = idx % 96; const size_t row = (size_t)(b * T_ + kt * 64 + j);
            Kt[j * 97 + d] = d < 64 ? bf2f(KN[row * 256 + h * 64 + d]) : bf2f(KPE[row * 32 + d - 64]); }
        for (int idx = F.tid; idx < 64 * 64; idx += NTHR) { const int j = idx >> 6, d = idx & 63; Vt[idx] = bf2f(V[(size_t)(b * T_ + kt * 64 + j) * 256 + h * 64 + d]); }
        __syncthreads();
#pragma unroll
        for (int i = 0; i < 8; ++i) { const int qr = F.wave * 8 + i; float s = 0.f;
#pragma unroll 8
            for (int d = 0; d < 96; ++d) s += Qs[qr * 96 + d] * Kt[F.lane * 97 + d];
            if (kt * 64 + F.lane > qb * 64 + qr) s = -INFINITY;
            const float mn = fmaxf(mx[i], wave_max(s)), p = exp2f(s - mn), corr = exp2f(mx[i] - mn);
            ls[i] = ls[i] * corr + wave_sum(p); mx[i] = mn;
            Pw[F.lane] = p; LDS_WAIT(); asm volatile("" ::: "memory");
            float a = 0.f;
#pragma unroll 8
            for (int j = 0; j < 64; ++j) a += Pw[j] * Vt[j * 64 + F.lane];
            o[i] = o[i] * corr + a; LDS_WAIT(); asm volatile("" ::: "memory"); }
    }
    bf16* yc = (bf16*)(F.ws + WS_A);
#pragma unroll
    for (int i = 0; i < 8; ++i) yc[(size_t)(b * T_ + qb * 64 + F.wave * 8 + i) * 1024 + 512 + h * 64 + F.lane] = (bf16)f2bf(o[i] / ls[i]);
    __syncthreads();
}
namespace att {
typedef short bf16x8 __attribute__((ext_vector_type(8)));
typedef short s16x4 __attribute__((ext_vector_type(4)));
typedef float f32x16 __attribute__((ext_vector_type(16)));
typedef unsigned u32x4 __attribute__((ext_vector_type(4)));
constexpr int KSLOT = 12288, VSLOT = 8192, NSLOT = 3, LDS_K = 0, LDS_V = NSLOT * KSLOT, LDS_TOTAL = NSLOT * (KSLOT + VSLOT);
__device__ __forceinline__ int crow(int r, int hi) { return (r & 3) + 8 * (r >> 2) + 4 * hi; }
__device__ __forceinline__ s16x4 vtr(const LAS unsigned char* p) { return __builtin_bit_cast(s16x4, __builtin_amdgcn_ds_read_tr16_b64_v4i16((LAS s16x4*)p)); }
__device__ __forceinline__ float xhalf(float v) { return __shfl_xor(v, 32); }
__device__ __forceinline__ unsigned pk(float lo, float hi) { typedef float f2 __attribute__((ext_vector_type(2))); typedef __bf16 b2 __attribute__((ext_vector_type(2))); f2 v = {lo, hi}; b2 b = __builtin_convertvector(v, b2); return __builtin_bit_cast(unsigned, b); }
__device__ __forceinline__ bf16x8 pack8r(const f32x16& x, int s) { u32x4 w; w.x = pk(x[8 * s], x[8 * s + 1]); w.y = pk(x[8 * s + 2], x[8 * s + 3]); w.z = pk(x[8 * s + 4], x[8 * s + 5]); w.w = pk(x[8 * s + 6], x[8 * s + 7]); return __builtin_bit_cast(bf16x8, w); }
#define ATT_MFMA(a, b, c) __builtin_amdgcn_mfma_f32_32x32x16_bf16((a), (b), (c), 0, 0, 0)
__device__ __forceinline__ void attn_unit(Frame& F, int b, int h, int qb) {
    const int lane = F.lane, r32 = lane & 31, hi = lane >> 5, wid = F.wave;
    const size_t rowbase = (size_t)b * T_; const int q0 = qb * 256, qrow = q0 + 32 * wid + r32;
    const bf16* Q = (const bf16*)(F.ws + WS_Q); const bf16* KN = (const bf16*)(F.ws + WS_KN); const bf16* V = (const bf16*)(F.ws + WS_V); const bf16* KPE = (const bf16*)(F.ws + WS_KPE);
    LAS unsigned char* lds = F.lds;
    const int NT = (q0 + 256) / 64;
    const bf16* srcA = KN + (rowbase + lane) * 256 + h * 64 + 8 * wid; const int dstA = LDS_K + wid * 1024;
    const bf16* srcB; int dstB; size_t strB;
    if (wid < 4) { srcB = KPE + (rowbase + lane) * 32 + 8 * wid; dstB = LDS_K + (8 + wid) * 1024; strB = 64 * 32; }
    else { srcB = V + (rowbase + 16 * (wid - 4) + (lane >> 2)) * 256 + h * 64 + 8 * (lane & 3); dstB = LDS_V + (wid - 4) * 1024; strB = 64 * 256; }
    const bf16* srcC = V + (rowbase + 16 * (wid & 3) + (lane >> 2)) * 256 + h * 64 + 32 + 8 * (lane & 3); const int dstC = LDS_V + (4 + (wid & 3)) * 1024;
    const int slotB = wid < 4 ? KSLOT : VSLOT;
#define ATT_DMA(t, s) do { \
        __builtin_amdgcn_global_load_lds((const unsigned*)(srcA + (size_t)(t) * 64 * 256), (LAS unsigned*)(lds + dstA + (s) * KSLOT), 16, 0, 0); \
        __builtin_amdgcn_global_load_lds((const unsigned*)(srcB + (size_t)(t) * strB), (LAS unsigned*)(lds + dstB + (s) * slotB), 16, 0, 0); \
        __builtin_amdgcn_global_load_lds((const unsigned*)(srcC + (size_t)(t) * 64 * 256), (LAS unsigned*)(lds + dstC + (s) * VSLOT), 16, 0, 0); } while (0)
    bf16x8 qr[6];
#pragma unroll
    for (int d0 = 0; d0 < 6; ++d0) qr[d0] = *(const bf16x8*)(Q + (rowbase + qrow) * 384 + h * 96 + 16 * d0 + 8 * hi);
    asm volatile("s_waitcnt vmcnt(0)" ::: "memory");
    ATT_DMA(0, 0); ATT_DMA(1, 1);
    f32x16 o0, o1;
#pragma unroll
    for (int i = 0; i < 16; ++i) { o0[i] = 0.f; o1[i] = 0.f; }
    float m = -INFINITY, l = 0.f;
    const int voff = ((lane >> 4) & 1) * 32 + (lane & 3) * 8 + (4 * hi + ((lane & 15) >> 2)) * 64;
    int slot = 0;
    for (int t = 0; t < NT; ++t) {
        if (t + 1 < NT) asm volatile("s_waitcnt vmcnt(3)" ::: "memory"); else asm volatile("s_waitcnt vmcnt(0)" ::: "memory");
        __builtin_amdgcn_s_barrier(); asm volatile("" ::: "memory");
        if (t + 2 < NT) { const int s2 = slot == 0 ? 2 : slot - 1; ATT_DMA(t + 2, s2); }
        if (64 * t <= q0 + 32 * wid + 31) {
            const LAS unsigned char* kb = lds + LDS_K + slot * KSLOT + hi * 1024 + r32 * 16;
            f32x16 p0, p1;
#pragma unroll
            for (int i = 0; i < 16; ++i) { p0[i] = 0.f; p1[i] = 0.f; }
#pragma unroll
            for (int d0 = 0; d0 < 6; ++d0) { const bf16x8 k0 = *(const LAS bf16x8*)(kb + d0 * 2048), k1 = *(const LAS bf16x8*)(kb + d0 * 2048 + 512);
                p0 = ATT_MFMA(k0, qr[d0], p0); p1 = ATT_MFMA(k1, qr[d0], p1); }
            if (64 * t + 63 > q0 + 32 * wid) {
#pragma unroll
                for (int r = 0; r < 16; ++r) { const int kv = 64 * t + crow(r, hi); if (kv > qrow) p0[r] = -INFINITY; if (kv + 32 > qrow) p1[r] = -INFINITY; }
            }
            float mx = fmaxf(p0[0], p1[0]);
#pragma unroll
            for (int r = 1; r < 16; ++r) mx = fmaxf(mx, fmaxf(p0[r], p1[r]));
            mx = fmaxf(mx, xhalf(mx));
            const float mn = fmaxf(m, mx);
            if (__any(mn > m)) { const float corr = __builtin_amdgcn_exp2f(m - mn); l *= corr;
#pragma unroll
                for (int i = 0; i < 16; ++i) { o0[i] *= corr; o1[i] *= corr; }
                m = mn; }
            float sum = 0.f;
#pragma unroll
            for (int r = 0; r < 16; ++r) { p0[r] = __builtin_amdgcn_exp2f(p0[r] - m); p1[r] = __builtin_amdgcn_exp2f(p1[r] - m); sum += p0[r] + p1[r]; }
            l += sum;
            const bf16x8 pa0 = pack8r(p0, 0), pa1 = pack8r(p0, 1), pa2 = pack8r(p1, 0), pa3 = pack8r(p1, 1);
            const LAS unsigned char* vb = lds + LDS_V + slot * VSLOT + voff;
#define ATT_VF(dh, ks) ({ const s16x4 lo_ = vtr(vb + (dh) * 4096 + (ks) * 1024), hi_ = vtr(vb + (dh) * 4096 + (ks) * 1024 + 512); (bf16x8){lo_[0], lo_[1], lo_[2], lo_[3], hi_[0], hi_[1], hi_[2], hi_[3]}; })
            o0 = ATT_MFMA(ATT_VF(0, 0), pa0, o0); o1 = ATT_MFMA(ATT_VF(1, 0), pa0, o1);
            o0 = ATT_MFMA(ATT_VF(0, 1), pa1, o0); o1 = ATT_MFMA(ATT_VF(1, 1), pa1, o1);
            o0 = ATT_MFMA(ATT_VF(0, 2), pa2, o0); o1 = ATT_MFMA(ATT_VF(1, 2), pa2, o1);
            o0 = ATT_MFMA(ATT_VF(0, 3), pa3, o0); o1 = ATT_MFMA(ATT_VF(1, 3), pa3, o1);
#undef ATT_VF
        }
        slot = slot == 2 ? 0 : slot + 1;
    }
    l += xhalf(l);
    const float rl = 1.f / l;
    bf16* yc = (bf16*)(F.ws + WS_A) + (rowbase + qrow) * 1024 + 512 + h * 64;
#pragma unroll
    for (int g = 0; g < 4; ++g) { v2u w0, w1; w0.x = pk(o0[4 * g] * rl, o0[4 * g + 1] * rl); w0.y = pk(o0[4 * g + 2] * rl, o0[4 * g + 3] * rl); w1.x = pk(o1[4 * g] * rl, o1[4 * g + 1] * rl); w1.y = pk(o1[4 * g + 2] * rl, o1[4 * g + 3] * rl);
        *(v2u*)(yc + 8 * g + 4 * hi) = w0; *(v2u*)(yc + 32 + 8 * g + 4 * hi) = w1; }
    asm volatile("s_waitcnt lgkmcnt(0)" ::: "memory"); __builtin_amdgcn_s_barrier(); asm volatile("" ::: "memory");
#undef ATT_DMA
}
#undef ATT_MFMA
}
namespace mix {
typedef short bf16x8 __attribute__((ext_vector_type(8)));
typedef short s16x4 __attribute__((ext_vector_type(4)));
typedef float f32x2 __attribute__((ext_vector_type(2)));
#define MIX_MFMA(a, b, c) __builtin_amdgcn_mfma_f32_16x16x32_bf16((a), (b), (c), 0, 0, 0)
constexpr int BS_STR = 72, XT_STR = 136;
constexpr int LBS = 0, LCS = LBS + 128 * BS_STR * 2, LBT = LCS + 128 * BS_STR * 2, LXT = LBT + 64 * XT_STR * 2, LDT = LXT + 4 * 64 * XT_STR * 2, LACS = LDT + 4 * 128 * 4, LEND = LACS + 4 * 128 * 4;
static_assert(LEND <= RING_BYTES, "SSD LDS map");
__device__ __forceinline__ float softplus(float xv) { const float ev = __expf(xv); return xv > 20.f ? xv : (ev < 0.01f ? ev * (1.f - ev * (0.5f - ev * 0.33333333f)) : __logf(1.f + ev)); }
__device__ __forceinline__ f32x2 gelu_pk(f32x2 v) {
    const f32x2 av = __builtin_elementwise_abs(v), d = av * 0.2316418882f + 1.0f;
    f32x2 t; t.x = __builtin_amdgcn_rcpf(d.x); t.y = __builtin_amdgcn_rcpf(d.y);
    f32x2 q = t * 0.5307027145f + (-0.7265760135f); q = q * t + 0.7107068705f; q = q * t + (-0.142248368f); q = q * t + 0.127414796f; q = q * t;
    const f32x2 s = (v * v) * (-0.72134752044f);
    f32x2 e; e.x = __builtin_amdgcn_exp2f(s.x); e.y = __builtin_amdgcn_exp2f(s.y);
    const f32x2 m = v * (q * e), r = v - m;
    f32x2 o; o.x = v.x < 0.f ? m.x : r.x; o.y = v.y < 0.f ? m.y : r.y; return o;
}
__device__ __forceinline__ void ssd_chunk(Frame& F, const Args& A, int l, int unit) {
    const int g = unit & 1, c = (unit >> 1) & 31, b = unit >> 6; const int row0 = b * T_ + c * 128, tq0 = c * 128;
    const int tid = F.tid, lane = F.lane, w = F.wave, fr = lane & 15, fq = lane >> 4;
    const bf16* proj = (const bf16*)(F.ws + WS_PROJ);
    const float* cw = A.in[I_CONVW] + l * 4 * 768; const float* cb = A.in[I_CONVB] + l * 768;
    LAS unsigned char* lds = F.lds;
    { const int chp = tid & 127, tseg = tid >> 7, cg = 2 * chp, ch = 256 * g + cg;
      float wk[4][2];
#pragma unroll
      for (int k = 0; k < 4; ++k) { wk[k][0] = cw[k * 768 + ch]; wk[k][1] = cw[k * 768 + ch + 1]; }
      const float b0 = cb[ch], b1 = cb[ch + 1];
      unsigned xin[35];
#pragma unroll
      for (int i = 0; i < 35; ++i) { const int tt = tq0 + 32 * tseg - 3 + i; xin[i] = tt >= 0 ? *(const unsigned*)(proj + (size_t)(b * T_ + tt) * NPROJ + PX + ch) : 0u; }
      LAS unsigned char* x0p = lds + LXT + ((cg >> 6) * 64 + (cg & 63)) * XT_STR * 2 + 32 * tseg * 2;
#pragma unroll
      for (int i = 0; i < 32; i += 2) { float y[2][2];
#pragma unroll
          for (int u = 0; u < 2; ++u) { float a0 = b0, a1 = b1;
#pragma unroll
              for (int k = 0; k < 4; ++k) { a0 += wk[k][0] * bflo(xin[i + u + k]); a1 += wk[k][1] * bfhi(xin[i + u + k]); }
              y[u][0] = silu(a0); y[u][1] = silu(a1); }
          *(LAS unsigned*)(x0p + i * 2) = pk2(y[0][0], y[1][0]); *(LAS unsigned*)(x0p + XT_STR * 2 + i * 2) = pk2(y[0][1], y[1][1]); } }
    { const int which = tid >> 8, chp = tid & 31, tseg = (tid >> 5) & 7, n0 = 2 * chp, ch = 512 + which * 128 + 64 * g + n0, pcol = (which ? PC : PB) + 64 * g + n0;
      float wk[4][2];
#pragma unroll
      for (int k = 0; k < 4; ++k) { wk[k][0] = cw[k * 768 + ch]; wk[k][1] = cw[k * 768 + ch + 1]; }
      const float b0 = cb[ch], b1 = cb[ch + 1];
      unsigned xin[19];
#pragma unroll
      for (int i = 0; i < 19; ++i) { const int tt = tq0 + 16 * tseg - 3 + i; xin[i] = tt >= 0 ? *(const unsigned*)(proj + (size_t)(b * T_ + tt) * NPROJ + pcol) : 0u; }
      bf16* CC = (bf16*)(F.ws + WS_CC);
#pragma unroll
      for (int i = 0; i < 16; i += 2) { float y[2][2];
#pragma unroll
          for (int u = 0; u < 2; ++u) { float a0 = b0, a1 = b1;
#pragma unroll
              for (int k = 0; k < 4; ++k) { a0 += wk[k][0] * bflo(xin[i + u + k]); a1 += wk[k][1] * bfhi(xin[i + u + k]); }
              y[u][0] = silu(a0); y[u][1] = silu(a1); }
          const int s = 16 * tseg + i;
          const unsigned r0 = pk2(y[0][0], y[0][1]), r1 = pk2(y[1][0], y[1][1]);
          if (which == 0) { *(LAS unsigned*)(lds + LBS + (s * BS_STR + n0) * 2) = r0; *(LAS unsigned*)(lds + LBS + ((s + 1) * BS_STR + n0) * 2) = r1;
              *(LAS unsigned*)(lds + LBT + (n0 * XT_STR + s) * 2) = pk2(y[0][0], y[1][0]); *(LAS unsigned*)(lds + LBT + ((n0 + 1) * XT_STR + s) * 2) = pk2(y[0][1], y[1][1]); }
          else { *(LAS unsigned*)(lds + LCS + (s * BS_STR + n0) * 2) = r0; *(LAS unsigned*)(lds + LCS + ((s + 1) * BS_STR + n0) * 2) = r1;
              *(unsigned*)(CC + (size_t)(row0 + s) * 128 + 64 * g + n0) = r0; *(unsigned*)(CC + (size_t)(row0 + s + 1) * 128 + 64 * g + n0) = r1; } } }
    if (w < 4) { const int h = 4 * g + w; const float* dtv = (const float*)(F.ws + WS_DTV); const float bias = A.in[I_DTB][l * 8 + h], Ah = -__expf(A.in[I_ALOG][l * 8 + h]);
        const float d0 = softplus(dtv[(size_t)(row0 + 2 * lane) * 8 + h] + bias), d1 = softplus(dtv[(size_t)(row0 + 2 * lane + 1) * 8 + h] + bias);
        const float a0 = d0 * Ah, a1 = d1 * Ah; float s = a0 + a1;
#pragma unroll
        for (int o = 1; o < 64; o <<= 1) { const float v = __shfl_up(s, o); if (lane >= o) s += v; }
        const float c1 = s, c0 = s - a1;
        LAS float* dts = (LAS float*)(lds + LDT) + w * 128; LAS float* acs = (LAS float*)(lds + LACS) + w * 128;
        dts[2 * lane] = d0; dts[2 * lane + 1] = d1; acs[2 * lane] = c0; acs[2 * lane + 1] = c1;
        float* ACS = (float*)(F.ws + WS_ACS); ACS[(size_t)(row0 + 2 * lane) * 8 + h] = c0; ACS[(size_t)(row0 + 2 * lane + 1) * 8 + h] = c1; }
    __syncthreads();
    f32x4 cbT[8];
    { bf16x8 cf[2];
#pragma unroll
      for (int ks = 0; ks < 2; ++ks) cf[ks] = *(const LAS bf16x8*)(lds + LCS + ((16 * w + fr) * BS_STR + 32 * ks + 8 * fq) * 2);
#pragma unroll
      for (int st = 0; st < 8; ++st) { cbT[st] = (f32x4){0.f, 0.f, 0.f, 0.f};
          if (st <= w) {
#pragma unroll
              for (int ks = 0; ks < 2; ++ks) { const bf16x8 bfg = *(const LAS bf16x8*)(lds + LBS + ((16 * st + fr) * BS_STR + 32 * ks + 8 * fq) * 2); cbT[st] = MIX_MFMA(bfg, cf[ks], cbT[st]); } } } }
    const int lrow = 16 * w + fr;
#pragma unroll 1
    for (int r = 0; r < 4; ++r) { const int h = 4 * g + r;
        const LAS float* dts = (const LAS float*)(lds + LDT) + r * 128; const LAS float* acs = (const LAS float*)(lds + LACS) + r * 128;
        const float al = acs[lrow];
        bf16x8 gf[4];
#pragma unroll
        for (int i = 0; i < 4; ++i) { float gv[8];
#pragma unroll
            for (int hf = 0; hf < 2; ++hf) { const int st = 2 * i + hf; const f32x4 a4 = *(const LAS f32x4*)(acs + 16 * st + 4 * fq), d4 = *(const LAS f32x4*)(dts + 16 * st + 4 * fq);
#pragma unroll
                for (int j = 0; j < 4; ++j) { const int s = 16 * st + 4 * fq + j; gv[4 * hf + j] = s <= lrow ? cbT[st][j] * __expf(al - a4[j]) * d4[j] : 0.f; } }
            v4u pw; pw.x = pk2(gv[0], gv[1]); pw.y = pk2(gv[2], gv[3]); pw.z = pk2(gv[4], gv[5]); pw.w = pk2(gv[6], gv[7]); gf[i] = __builtin_bit_cast(bf16x8, pw); }
        const float Dh = A.in[I_SSDD][l * 8 + h];
        const LAS unsigned char* xt = lds + LXT + r * 64 * XT_STR * 2;
        bf16* yc = (bf16*)(F.ws + WS_A) + (size_t)(row0 + lrow) * 1024 + 64 * h;
#pragma unroll
        for (int pt = 0; pt < 4; ++pt) { f32x4 acc = {0.f, 0.f, 0.f, 0.f};
#pragma unroll
            for (int i = 0; i < 4; ++i) if (2 * i <= w) { const LAS unsigned char* xp = xt + ((16 * pt + fr) * XT_STR + 32 * i + 4 * fq) * 2;
                const s16x4 x0 = *(const LAS s16x4*)xp, x1 = *(const LAS s16x4*)(xp + 32);
                acc = MIX_MFMA(((bf16x8){x0[0], x0[1], x0[2], x0[3], x1[0], x1[1], x1[2], x1[3]}), gf[i], acc); }
            float xl[4];
#pragma unroll
            for (int j = 0; j < 4; ++j) xl[j] = bf2f(*(const LAS bf16*)(xt + ((16 * pt + 4 * fq + j) * XT_STR + lrow) * 2));
            v2u o; o.x = pk2(acc[0] + Dh * xl[0], acc[1] + Dh * xl[1]); o.y = pk2(acc[2] + Dh * xl[2], acc[3] + Dh * xl[3]);
            *(v2u*)(yc + 16 * pt + 4 * fq) = o; }
        { const float alast = acs[127]; const int pt = w >> 1; f32x4 s0 = {0.f, 0.f, 0.f, 0.f}, s1 = {0.f, 0.f, 0.f, 0.f};
#pragma unroll
          for (int ks = 0; ks < 4; ++ks) { const v4u xw = *(const LAS v4u*)(xt + ((16 * pt + fr) * XT_STR + 32 * ks + 8 * fq) * 2);
              const f32x4 a0 = *(const LAS f32x4*)(acs + 32 * ks + 8 * fq), a1 = *(const LAS f32x4*)(acs + 32 * ks + 8 * fq + 4), d0 = *(const LAS f32x4*)(dts + 32 * ks + 8 * fq), d1 = *(const LAS f32x4*)(dts + 32 * ks + 8 * fq + 4);
              v4u sw; sw.x = pk2(bflo(xw.x) * d0[0] * __expf(alast - a0[0]), bfhi(xw.x) * d0[1] * __expf(alast - a0[1])); sw.y = pk2(bflo(xw.y) * d0[2] * __expf(alast - a0[2]), bfhi(xw.y) * d0[3] * __expf(alast - a0[3]));
              sw.z = pk2(bflo(xw.z) * d1[0] * __expf(alast - a1[0]), bfhi(xw.z) * d1[1] * __expf(alast - a1[1])); sw.w = pk2(bflo(xw.w) * d1[2] * __expf(alast - a1[2]), bfhi(xw.w) * d1[3] * __expf(alast - a1[3]));
              const bf16x8 xa = __builtin_bit_cast(bf16x8, sw);
              const bf16x8 bt0 = *(const LAS bf16x8*)(lds + LBT + ((16 * (2 * (w & 1)) + fr) * XT_STR + 32 * ks + 8 * fq) * 2), bt1 = *(const LAS bf16x8*)(lds + LBT + ((16 * (2 * (w & 1) + 1) + fr) * XT_STR + 32 * ks + 8 * fq) * 2);
              s0 = MIX_MFMA(xa, bt0, s0); s1 = MIX_MFMA(xa, bt1, s1); }
          float* ST = (float*)(F.ws + WS_ST) + (size_t)((b * NCH + c) * 8 + h) * 4096 + (16 * pt + 4 * fq) * 64 + 32 * (w & 1) + fr;
#pragma unroll
          for (int j = 0; j < 4; ++j) { ST[j * 64] = s0[j]; ST[j * 64 + 16] = s1[j]; } }
    }
    __syncthreads();
}
__device__ __forceinline__ void state_scan2(Frame& F) {
    const float* ST = (const float*)(F.ws + WS_ST); const float* ACS = (const float*)(F.ws + WS_ACS); bf16* SB = (bf16*)(F.ws + WS_SB);
    for (int idx = F.bid * NTHR + F.tid; idx < NB * 8 * 4096; idx += F.G * NTHR) { const int pn = idx & 4095, h = (idx >> 12) & 7, b = idx >> 15; float cur = 0.f;
#pragma unroll 4
        for (int c = 0; c < NCH; ++c) { const size_t a = (size_t)((b * NCH + c) * 8 + h) * 4096 + pn; const float s = ST[a]; SB[a] = (bf16)f2bf(cur);
            cur = cur * __expf(ACS[(size_t)(b * T_ + c * 128 + 127) * 8 + h]) + s; } }
}
__device__ __forceinline__ void ssd_finish(Frame& F, const Args& A, int l, int unit) {
    const int g = unit & 1, c = (unit >> 1) & 31, b = unit >> 6; const int row0 = b * T_ + c * 128;
    const int lane = F.lane, w = F.wave, fr = lane & 15, fq = lane >> 4, lrow = row0 + 16 * w + fr;
    const bf16* proj = (const bf16*)(F.ws + WS_PROJ); const bf16* CC = (const bf16*)(F.ws + WS_CC); const bf16* SB = (const bf16*)(F.ws + WS_SB) + (size_t)((b * NCH + c) * 8 + 4 * g) * 4096;
    bf16x8 cf[2];
#pragma unroll
    for (int ks = 0; ks < 2; ++ks) cf[ks] = *(const bf16x8*)(CC + (size_t)lrow * 128 + 64 * g + 32 * ks + 8 * fq);
    const f32x4 acs4 = *(const f32x4*)((const float*)(F.ws + WS_ACS) + (size_t)lrow * 8 + 4 * g);
    bf16* yc = (bf16*)(F.ws + WS_A) + (size_t)lrow * 1024 + 256 * g + 4 * fq; const bf16* zp = proj + (size_t)lrow * NPROJ + PZ + 256 * g + 4 * fq;
    float gy[4][4][4]; float ss = 0.f;
    bf16x8 sf[2][4][2]; v2u yd[2][4], zz[2][4];
#define SSDF_LOAD(buf, r) do { _Pragma("unroll") for (int pt = 0; pt < 4; ++pt) { _Pragma("unroll") for (int ks = 0; ks < 2; ++ks) sf[buf][pt][ks] = *(const bf16x8*)(SB + (size_t)(r) * 4096 + (16 * pt + fr) * 64 + 32 * ks + 8 * fq); \
        yd[buf][pt] = *(const v2u*)(yc + 64 * (r) + 16 * pt); zz[buf][pt] = *(const v2u*)(zp + 64 * (r) + 16 * pt); } } while (0)
    SSDF_LOAD(0, 0);
#pragma unroll
    for (int r = 0; r < 4; ++r) { const float ea = __expf(acs4[r]); const int cur = r & 1;
        if (r < 3) SSDF_LOAD(cur ^ 1, r + 1);
#pragma unroll
        for (int pt = 0; pt < 4; ++pt) { f32x4 acc = {0.f, 0.f, 0.f, 0.f};
#pragma unroll
            for (int ks = 0; ks < 2; ++ks) acc = MIX_MFMA(sf[cur][pt][ks], cf[ks], acc);
            const float y0 = bflo(yd[cur][pt].x) + ea * acc[0], y1 = bfhi(yd[cur][pt].x) + ea * acc[1], y2 = bflo(yd[cur][pt].y) + ea * acc[2], y3 = bfhi(yd[cur][pt].y) + ea * acc[3];
            gy[r][pt][0] = y0 * silu(bflo(zz[cur][pt].x)); gy[r][pt][1] = y1 * silu(bfhi(zz[cur][pt].x)); gy[r][pt][2] = y2 * silu(bflo(zz[cur][pt].y)); gy[r][pt][3] = y3 * silu(bfhi(zz[cur][pt].y));
            ss += (gy[r][pt][0] * gy[r][pt][0] + gy[r][pt][1] * gy[r][pt][1]) + (gy[r][pt][2] * gy[r][pt][2] + gy[r][pt][3] * gy[r][pt][3]); } }
#undef SSDF_LOAD
    ss += __shfl_xor(ss, 16); ss += __shfl_xor(ss, 32);
    const float rs = 1.f / sqrtf(ss * (1.f / 256.f) + RMS_EPS); const float* nw = A.in[I_SSDNW] + l * 512 + 256 * g + 4 * fq;
#pragma unroll
    for (int r = 0; r < 4; ++r)
#pragma unroll
        for (int pt = 0; pt < 4; ++pt) { const f32x4 n4 = *(const f32x4*)(nw + 64 * r + 16 * pt); v2u o; o.x = pk2(gy[r][pt][0] * rs * n4[0], gy[r][pt][1] * rs * n4[1]); o.y = pk2(gy[r][pt][2] * rs * n4[2], gy[r][pt][3] * rs * n4[3]);
            *(v2u*)(yc + 64 * r + 16 * pt) = o; }
}
__device__ __forceinline__ void gmlp(Frame& F, const Args& A, int l, int unit) {
    const int row0 = unit * 128; const int lane = F.lane, w = F.wave, fr = lane & 15, fq = lane >> 4;
    const bf16* proj = (const bf16*)(F.ws + WS_PROJ); LAS unsigned char* lds = F.lds;
    { const f32x4 lg = *(const f32x4*)(A.in[I_GMLNG] + l * 256 + 4 * lane), lb = *(const f32x4*)(A.in[I_GMLNB] + l * 256 + 4 * lane);
      v2u wv[16];
#pragma unroll
      for (int i = 0; i < 16; ++i) wv[i] = *(const v2u*)(proj + (size_t)(row0 + 16 * w + i) * NPROJ + PGV + 4 * lane);
#pragma unroll
      for (int i0 = 0; i0 < 16; i0 += 4) { float v[4][4], sm[4], s2[4];
#pragma unroll
          for (int i = 0; i < 4; ++i) { const f32x2 g0 = gelu_pk((f32x2){bflo(wv[i0 + i].x), bfhi(wv[i0 + i].x)}), g1 = gelu_pk((f32x2){bflo(wv[i0 + i].y), bfhi(wv[i0 + i].y)});
              v[i][0] = g0.x; v[i][1] = g0.y; v[i][2] = g1.x; v[i][3] = g1.y; sm[i] = (v[i][0] + v[i][1]) + (v[i][2] + v[i][3]); }
#pragma unroll
          for (int o = 1; o < 64; o <<= 1) {
#pragma unroll
              for (int i = 0; i < 4; ++i) sm[i] += __shfl_xor(sm[i], o); }
#pragma unroll
          for (int i = 0; i < 4; ++i) { const float mean = sm[i] * (1.f / 256.f); s2[i] = 0.f;
#pragma unroll
              for (int k = 0; k < 4; ++k) { v[i][k] -= mean; s2[i] += v[i][k] * v[i][k]; } }
#pragma unroll
          for (int o = 1; o < 64; o <<= 1) {
#pragma unroll
              for (int i = 0; i < 4; ++i) s2[i] += __shfl_xor(s2[i], o); }
#pragma unroll
          for (int i = 0; i < 4; ++i) { const float rstd = 1.f / sqrtf(s2[i] * (1.f / 256.f) + LN_EPS); const int sr = 16 * w + i0 + i;
#pragma unroll
              for (int k = 0; k < 4; ++k) *(LAS bf16*)(lds + ((4 * lane + k) * XT_STR + sr) * 2) = (bf16)f2bf(v[i][k] * rstd * lg[k] + lb[k]); } } }
    __syncthreads();
    const int trow = row0 + 16 * w + fr; const bf16* GMW = (const bf16*)(F.ws + WS_GMW) + (size_t)l * 4 * 128 * 128;
    bf16* yc = (bf16*)(F.ws + WS_A) + (size_t)trow * 1024 + 768 + 4 * fq; const bf16* gu = proj + (size_t)trow * NPROJ + PGU + 4 * fq;
#pragma unroll 1
    for (int gi = 0; gi < 4; ++gi) { bf16x8 wf[4];
#pragma unroll
        for (int ks = 0; ks < 4; ++ks) wf[ks] = *(const bf16x8*)(GMW + ((size_t)gi * 128 + 16 * w + fr) * 128 + 32 * ks + 8 * fq);
        const float bs = A.in[I_GMBS][(l * 4 + gi) * 128 + 16 * w + fr];
#pragma unroll
        for (int c4 = 0; c4 < 4; ++c4) { const int ct = 4 * gi + c4; f32x4 acc = {0.f, 0.f, 0.f, 0.f};
#pragma unroll
            for (int ks = 0; ks < 4; ++ks) if (2 * ks <= w) { const bf16x8 vf = *(const LAS bf16x8*)(lds + ((16 * ct + fr) * XT_STR + 32 * ks + 8 * fq) * 2); acc = MIX_MFMA(vf, wf[ks], acc); }
            const v2u gw = *(const v2u*)(gu + 16 * ct); const f32x2 g0 = gelu_pk((f32x2){bflo(gw.x), bfhi(gw.x)}), g1 = gelu_pk((f32x2){bflo(gw.y), bfhi(gw.y)});
            v2u o; o.x = pk2(g0.x * (acc[0] + bs), g0.y * (acc[1] + bs)); o.y = pk2(g1.x * (acc[2] + bs), g1.y * (acc[3] + bs)); *(v2u*)(yc + 16 * ct) = o; } }
    __syncthreads();
}
#undef MIX_MFMA
}
__device__ __forceinline__ void moe_offsets(Frame& F, int k, int (&poff)[9], int (&cnt)[8]) {
    int acc = 0;
#pragma unroll
    for (int e = 0; e < 8; ++e) { cnt[e] = (int)__hip_atomic_load(F.ctl + CW_CNT + (k * 8 + e) * 64, RLX_AGENT); poff[e] = acc; acc += (cnt[e] + 255) >> 8; }
    poff[8] = acc;
}
__device__ __forceinline__ void moe_permute(Frame& F, int k) {
    int poff[9], cnt[8]; moe_offsets(F, k, poff, cnt);
    const int* re = (const int*)(F.ws + WS_ROUTE) + k * M_; const int* rs = (const int*)(F.ws + WS_ROUTE) + 2 * M_ + k * M_; const float* rg = (const float*)(F.ws + WS_ROUTE) + 4 * M_ + k * M_;
    int* tok = (int*)(F.ws + WS_TOK); float* gwt = (float*)(tok + MOE_MAXP * 256);
    const bf16* hb = (const bf16*)(F.ws + WS_A); bf16* hp = (bf16*)(F.ws + WS_HP);
    const int gwv = F.bid * NWAVES + F.wave, NGW = F.G * NWAVES;
    for (int m = gwv; m < M_; m += NGW) { const int e = re[m], s = rs[m]; int po = 0;
#pragma unroll
        for (int q = 0; q < 8; ++q) po = (e == q) ? poff[q] : po;
        const int prow = po * 256 + s;
        const GAS v4u* src = (const GAS v4u*)(hb + (size_t)m * 1024);
#if MOE_FP8
        { const v4u c0 = src[2 * F.lane], c1 = src[2 * F.lane + 1]; v4u o;
          o.x = pg8::fp8x4((f32x4){bflo(c0.x), bfhi(c0.x), bflo(c0.y), bfhi(c0.y)}); o.y = pg8::fp8x4((f32x4){bflo(c0.z), bfhi(c0.z), bflo(c0.w), bfhi(c0.w)});
          o.z = pg8::fp8x4((f32x4){bflo(c1.x), bfhi(c1.x), bflo(c1.y), bfhi(c1.y)}); o.w = pg8::fp8x4((f32x4){bflo(c1.z), bfhi(c1.z), bflo(c1.w), bfhi(c1.w)});
          ((GAS v4u*)((unsigned char*)hp + (size_t)prow * 1024))[F.lane] = o; }
#else
        { GAS v4u* dst = (GAS v4u*)(hp + (size_t)prow * 1024); dst[F.lane] = src[F.lane]; dst[64 + F.lane] = src[64 + F.lane]; }
#endif
        if (F.lane == 0) { tok[prow] = m; gwt[prow] = rg[m]; } }
    for (int pr = F.bid * NTHR + F.tid; pr < poff[8] * 256; pr += F.G * NTHR) { const int pm = pr >> 8; int e = 0;
#pragma unroll
        for (int q = 1; q < 8; ++q) e += (pm >= poff[q]) ? 1 : 0;
        int pe = 0, ce = 0;
#pragma unroll
        for (int q = 0; q < 8; ++q) { pe = (e == q) ? poff[q] : pe; ce = (e == q) ? cnt[q] : ce; }
        if (pr - pe * 256 >= ce) tok[pr] = -1; }
}
constexpr int N_PHASES = 25;
#define MODP ((const float*)(F.ws + WS_MOD))
#define HA ((bf16*)(F.ws + WS_A))
#define PROJ ((bf16*)(F.ws + WS_PROJ))
#ifndef PHMASK
#define PHMASK 0xFFF
#endif
#define EN(k) (((PHMASK) >> (k)) & 1)
#ifndef PROBE_SITE
#define PROBE_SITE -1
#endif
#define NREP(k) ((PROBE_SITE) == (k) ? 2 : 1)
__global__ void __launch_bounds__(NTHR, 2) fwd_kernel(Args args) {
    extern __shared__ __attribute__((aligned(16))) unsigned char lds[];
    Frame F0;
    F0.lds = (LAS unsigned char*)lds; F0.tid = threadIdx.x; F0.lane = F0.tid & 63; F0.wave = __builtin_amdgcn_readfirstlane(F0.tid >> 6);
    F0.G = gridDim.x; F0.bid = blockIdx.x; F0.ws = args.ws; F0.ctl = (gu32*)(args.ws + WS_CTL); F0.out = args.out;
    for (int u = F0.tid; u < (LDS_BYTES - LDSCTL_OFF) / 4; u += NTHR) ((LAS unsigned*)(F0.lds + LDSCTL_OFF))[u] = 0u;
    __syncthreads();
#if N_LAUNCH_MODE == 0
    XcdBarrier bar = xcd_barrier_post((unsigned*)(F0.ctl + CW_BAR), (volatile LAS unsigned*)(F0.lds + MISC_OFF) + 8);
#define GRID_BAR() do { const Frame Fb = phase_frame(F0); xcd_barrier(bar, Fb.tid == 0); } while (0)
#else
#define GRID_BAR() do {} while (0)
#endif
    const int lo = args.ph_lo, hi = args.ph_hi;
#define IN(k) (lo <= (k) && (k) < hi)
#define SEAM(k) do { if (IN(k) && IN((k) + 1)) GRID_BAR(); } while (0)

    if (EN(0) && IN(0)) for (int rep = 0; rep < NREP(0); ++rep) { Frame F = phase_frame(F0); const bool dry = rep > 0; (void)dry; p0a(F, args); } SEAM(0);
    if (EN(1) && IN(1)) for (int rep = 0; rep < NREP(1); ++rep) { Frame F = phase_frame(F0); const bool dry = rep > 0; (void)dry; ln_phase(F, args, args.in[I_X], args.in[I_LN0G], args.in[I_LN0B], 0, false, false); } SEAM(1);

    for (int l = 0; l < 2; ++l) {
        const int base = l == 0 ? 2 : 12;
        if (EN(2) && IN(base + 0)) for (int rep = 0; rep < NREP(2); ++rep) { Frame F = phase_frame(F0); const bool dry = rep > 0; (void)dry;
            pg8::Gemm g{HA, (const bf16*)(F.ws + WS_WIN + l * WIN_BYTES), M_, NPROJ, 1024, 1024, 0, 0}; pg8::StaticOrder S; S.init(M_, NPROJ, F.G, F.bid);
            pg8::EpiProj E{PROJ, (float*)(F.ws + WS_DTV)};
            pg8::gemm_phase<pg8::EpiProj, pg8::StaticOrder, true, true>(F.lds + RING_OFF, g, S, E, F.tid);
        } SEAM(base + 0);
#if PROBE_SITE == 100
        for (int xb = 0; xb < 8; ++xb) GRID_BAR();
#endif
        if (EN(3) && IN(base + 1)) for (int rep = 0; rep < NREP(3); ++rep) { Frame F = phase_frame(F0); const bool dry = rep > 0; (void)dry;
            token_local(F);
#ifdef MIX_NAIVE
            for (int u = F.bid; u < NB * NCH * 8; u += F.G) ssd_chunk_naive(F, args, l, u);
            for (int u = F.bid; u < NB * NCH; u += F.G) gmlp_naive(F, args, l, u);
#else
            for (int u = F.bid; u < NB * NCH * 2; u += F.G) mix::ssd_chunk(F, args, l, u);
            for (int u = F.bid; u < NB * NCH; u += F.G) mix::gmlp(F, args, l, u);
#endif
        } SEAM(base + 1);
        if (EN(4) && IN(base + 2)) for (int rep = 0; rep < NREP(4); ++rep) { Frame F = phase_frame(F0); const bool dry = rep > 0; (void)dry;
#ifdef MIX_NAIVE
            state_scan(F);
#else
            mix::state_scan2(F);
#endif
            { pg8::Gemm g{PROJ + PQ, (const bf16*)(F.ws + WS_WQB + l * WQB_BYTES), M_, 1024, 256, NPROJ, WS_WKVB - WS_WQB, (size_t)(PKV - PQ) * 2}; pg8::QkvOrder S; S.init(M_, 1024, F.G, F.bid);
              pg8::EpiQKV E{{(bf16*)(F.ws + WS_Q), (const float*)(F.ws + WS_RSTD), (const float*)(F.ws + WS_ROPE), (const float*)(F.ws + WS_ROPE) + 4096 * 16, QSCALE},
                            {(bf16*)(F.ws + WS_KN), (bf16*)(F.ws + WS_V), (const float*)(F.ws + WS_RSTD) + M_}};
              pg8::gemm_phase<pg8::EpiQKV, pg8::QkvOrder, true, true>(F.lds + RING_OFF, g, S, E, F.tid); }
        } SEAM(base + 2);
        if (EN(5) && IN(base + 3)) for (int rep = 0; rep < NREP(5); ++rep) { Frame F = phase_frame(F0); const bool dry = rep > 0; (void)dry;
#ifdef MIX_NAIVE
            for (int u = F.bid; u < NB * NCH * 2; u += F.G) ssd_finish_naive(F, args, l, u);
#else
            if (!dry) for (int u = F.bid; u < NB * NCH * 2; u += F.G) mix::ssd_finish(F, args, l, u);
#endif
#ifdef ATTN_NAIVE
            for (int u = F.bid; u < NB * 4 * 64; u += F.G) attn_naive(F, u);
#else
            for (int v = F.bid; v < NB * 4 * 8; v += F.G) { const int bh = v >> 3, s = v & 7; att::attn_unit(F, bh >> 2, bh & 3, s); att::attn_unit(F, bh >> 2, bh & 3, 15 - s); }
#endif
        } SEAM(base + 3);
        if (EN(6) && IN(base + 4)) for (int rep = 0; rep < NREP(6); ++rep) { Frame F = phase_frame(F0); const bool dry = rep > 0; (void)dry;
            pg8::Gemm g{HA, (const bf16*)(F.ws + WS_WOUT + l * WOUT_BYTES), M_, 1024, 1024, 1024, 0, 0}; pg8::StaticOrder S; S.init(M_, 1024, F.G, F.bid);
            pg8::EpiResid E{F.out, MODP + (size_t)((l * 2 + 0) * 8) * 3072 + 2048, nullptr, nullptr, DN_ALPHA, dry, 1.f};
            pg8::gemm_phase<pg8::EpiResid, pg8::StaticOrder, true, true>(F.lds + RING_OFF, g, S, E, F.tid);
        } SEAM(base + 4);
        if (EN(7) && IN(base + 5)) for (int rep = 0; rep < NREP(7); ++rep) { Frame F = phase_frame(F0); const bool dry = rep > 0; (void)dry; ln_phase(F, args, F.out, args.in[I_PLG] + (l * 2 + 0) * 1024, args.in[I_PLB] + (l * 2 + 0) * 1024, l * 2 + 1, l == 1, dry); } SEAM(base + 5);
        const int npass = l == 0 ? 1 : 2;
        for (int k = 0; k < npass; ++k) {
            const int pb = base + 6 + 3 * k;
            if (EN(8) && IN(pb + 0)) for (int rep = 0; rep < NREP(8); ++rep) { Frame F = phase_frame(F0); const bool dry = rep > 0; (void)dry; if (l == 1) moe_permute(F, k); } if (l == 1) SEAM(pb + 0);
            Frame F = phase_frame(F0);
            pg8::MoeOrder S; int cnt[8]; int npan = M_ / 256;
            if (l == 1) { moe_offsets(F, k, S.poff, cnt); npan = S.poff[8]; }
            else {
#pragma unroll
                for (int e = 0; e < 9; ++e) S.poff[e] = e == 0 ? 0 : npan; }
            if (EN(9) && IN(pb + 1)) for (int rep = 0; rep < NREP(9); ++rep) { Frame F = phase_frame(F0); const bool dry = rep > 0; (void)dry;
                S.init(npan * 256, 5632, F.G, F.bid);
                if (l == 0 || !MOE_FP8) {
                    pg8::Gemm g{l == 0 ? HA : (const bf16*)(F.ws + WS_HP), (const bf16*)(F.ws + (l == 0 ? WS_W13 : WS_MW13)), npan * 256, 5632, 1024, 1024, l == 0 ? 0 : W13_BYTES, 0};
                    pg8::EpiSwiGLU E{(void*)(F.ws + (l == 0 ? WS_ACT : WS_ACTM)), FF, 1.f, 0.f};
                    pg8::gemm_phase<pg8::EpiSwiGLU, pg8::MoeOrder, true, true, 2>(F.lds + RING_OFF, g, S, E, F.tid);
                } else {
                    pg8::Gemm g{(const bf16*)(F.ws + WS_HP), (const bf16*)(F.ws + WS_MW13), npan * 256, 5632, 1024, 1024, W13_BYTES / 2, 0};
                    pg8::EpiSwiGLU E{(void*)(F.ws + WS_ACTM), FF, 1.f / 32.f, 8.f};
                    pg8::gemm_phase<pg8::EpiSwiGLU, pg8::MoeOrder, true, true, 1>(F.lds + RING_OFF, g, S, E, F.tid);
                }
            } SEAM(pb + 1);
            if (EN(10) && IN(pb + 2)) for (int rep = 0; rep < NREP(10); ++rep) { Frame F = phase_frame(F0); const bool dry = rep > 0; (void)dry;
                S.init(npan * 256, 1024, F.G, F.bid);
                const int* tok = l == 0 ? nullptr : (const int*)(F.ws + WS_TOK);
                if (l == 0 || !MOE_FP8) {
                    pg8::Gemm g{(const bf16*)(F.ws + (l == 0 ? WS_ACT : WS_ACTM)), (const bf16*)(F.ws + (l == 0 ? WS_W2 : WS_MW2)), npan * 256, 1024, FF, FF, l == 0 ? 0 : W2_BYTES, 0};
                    pg8::EpiResid E{F.out, MODP + (size_t)((l * 2 + 1) * 8) * 3072 + 2048, tok, l == 0 ? nullptr : (const float*)(tok + MOE_MAXP * 256), k == 0 ? DN_ALPHA : 1.f, dry, 1.f};
                    pg8::gemm_phase<pg8::EpiResid, pg8::MoeOrder, true, true, 2>(F.lds + RING_OFF, g, S, E, F.tid);
                } else {
                    pg8::Gemm g{(const bf16*)(F.ws + WS_ACTM), (const bf16*)(F.ws + WS_MW2), npan * 256, 1024, FF, FF, W2_BYTES / 2, 0};
                    pg8::EpiResid E{F.out, MODP + (size_t)((l * 2 + 1) * 8) * 3072 + 2048, tok, (const float*)(tok + MOE_MAXP * 256), k == 0 ? DN_ALPHA : 1.f, dry, 1.f / 1024.f};
                    pg8::gemm_phase<pg8::EpiResid, pg8::MoeOrder, true, true, 1>(F.lds + RING_OFF, g, S, E, F.tid);
                }
            } SEAM(pb + 2);
        }
        const int pl = base + 6 + 3 * npass;
        if (EN(11) && IN(pl)) for (int rep = 0; rep < NREP(11); ++rep) { Frame F = phase_frame(F0); const bool dry = rep > 0; (void)dry; ln_phase(F, args, F.out, args.in[I_PLG] + (l * 2 + 1) * 1024, args.in[I_PLB] + (l * 2 + 1) * 1024, l == 0 ? 2 : -1, false, dry); } SEAM(pl);
    }
}

extern "C" void kernel_launch(void* const* d_in, const int* in_sizes, int n_in, void* d_out, int out_size, void* d_ws, size_t ws_size, hipStream_t stream) {
    static int grid = 0;
    if (grid == 0) {
        if (n_in != 31 || out_size != M_ * D_ || ws_size < WS_END) { fprintf(stderr, "kernel_launch: unexpected shapes (n_in %d, out %d, ws %zu)\n", n_in, out_size, ws_size); grid = -1; return; }
        int dev = 0, cus = 0;
        if (hipGetDevice(&dev) != hipSuccess || hipDeviceGetAttribute(&cus, hipDeviceAttributeMultiprocessorCount, dev) != hipSuccess) { grid = -1; return; }
        if (hipFuncSetAttribute((const void*)fwd_kernel, hipFuncAttributeMaxDynamicSharedMemorySize, LDS_BYTES) != hipSuccess) { fprintf(stderr, "kernel_launch: hipFuncSetAttribute failed\n"); grid = -1; return; }
        int per_cu = 0;
        if (hipOccupancyMaxActiveBlocksPerMultiprocessor(&per_cu, (const void*)fwd_kernel, NTHR, LDS_BYTES) != hipSuccess || per_cu < 1) fprintf(stderr, "kernel_launch: occupancy query reports %d\n", per_cu);
        (void)hipGetLastError();
        grid = cus;
    }
    if (grid < 0) return;
    (void)hipMemsetAsync((char*)d_ws + WS_CTL, 0, CTL_ZERO_BYTES, stream);
    Args a{};
    for (int i = 0; i < 31; ++i) a.in[i] = (const float*)d_in[i];
    a.out = (float*)d_out; a.ws = (unsigned char*)d_ws;
#if N_LAUNCH_MODE == 0
    a.ph_lo = 0; a.ph_hi = N_PHASES;
    hipLaunchKernelGGL(fwd_kernel, dim3(grid), dim3(NTHR), LDS_BYTES, stream, a);
#else
    for (int p = 0; p < N_PHASES; ++p) { a.ph_lo = p; a.ph_hi = p + 1; hipLaunchKernelGGL(fwd_kernel, dim3(grid), dim3(NTHR), LDS_BYTES, stream, a); }
#endif
}
```

```cpp
#include <hip/hip_runtime.h>
#include <cstdio>
#include <cstdint>
#ifndef MOE_FP8
#define MOE_FP8 1
#endif
#define DENSE_FP8 0
#ifndef N_LAUNCH_MODE
#define N_LAUNCH_MODE 0
#endif
namespace pg8 {
#define PG8_LAS __attribute__((address_space(3)))
typedef unsigned short bf16_t;
typedef short bf16x8 __attribute__((ext_vector_type(8)));
typedef float f32x4 __attribute__((ext_vector_type(4)));
typedef unsigned u32x4 __attribute__((ext_vector_type(4)));
typedef int i32x4 __attribute__((ext_vector_type(4)));
typedef int i32x8 __attribute__((ext_vector_type(8)));
constexpr int BM = 256, BK = 64, HALF = 128, HTB = HALF * BK * 2  , STAGE_BYTES = 8 * HTB, NXCD = 8, WGM = 8;

__host__ __device__ __forceinline__ int lds_byte(int r, int c) { const int st = (r >> 4) * 2 + (c >> 5), rr = r & 15, cc = c & 31, ob = rr * 64 + cc * 2; return st * 1024 + (ob ^ (((ob >> 9) & 1) << 5)); }
__host__ __device__ __forceinline__ void stage_rc(int b, int& R, int& C) { const int st = b / 1024, sb = b % 1024, swz = sb ^ (((sb >> 9) & 1) << 5); R = (st >> 1) * 16 + swz / 64; C = (st & 1) * 32 + (swz % 64) / 2; }
__host__ __device__ __forceinline__ int perm32(int rho) { const int n = rho >> 4, i = rho & 15; return 8 * (i >> 2) + 4 * n + (i & 3); }

struct Unit { int pm, pn, e; };
struct Gemm { const bf16_t* A; const bf16_t* Bt; int M, N, K, lda; size_t estride, aestride; };

struct StaticOrder {
    int nM, nN, nwg, G, c;
    __host__ __device__ void init(int M, int N, int G_, int c_) { nM = M / BM; nN = N / BM; nwg = nM * nN; G = G_; c = c_; }
    __host__ __device__ bool next(int i, Unit& u) const {
        const long L = (long)i * G + c; if (L >= nwg) return false;
        int wgid = (int)L; { const int q = nwg / NXCD, r = nwg % NXCD, xcd = wgid % NXCD, off = wgid / NXCD; wgid = (xcd < r ? xcd * (q + 1) : r * (q + 1) + (xcd - r) * q) + off; }
        const int nig = WGM * nN, gid = wgid / nig, fm = gid * WGM, gsz = (nM - fm) < WGM ? (nM - fm) : WGM;
        u.pm = fm + ((wgid % nig) % gsz); u.pn = (wgid % nig) / gsz; u.e = 0; return true;
    }
    __device__ __forceinline__ void a_ready(const Unit&) const {}
    __device__ __forceinline__ void done(const Unit&) const {}
};
struct MoeOrder : StaticOrder {
    int poff[9];
    __device__ bool next(int i, Unit& u) const {
        if (!StaticOrder::next(i, u)) return false;
        int e = 0;
#pragma unroll
        for (int k = 1; k < 8; ++k) e += (u.pm >= poff[k]) ? 1 : 0;
        u.e = e; return true;
    }
};
struct QkvOrder : StaticOrder {
    __device__ bool next(int i, Unit& u) const { if (!StaticOrder::next(i, u)) return false; u.e = u.pn >> 1; u.pn &= 1; return true; }
};
__device__ __forceinline__ unsigned cvt_pk_bf16(float lo, float hi) { unsigned r; asm volatile("v_cvt_pk_bf16_f32 %0, %1, %2" : "=v"(r) : "v"(lo), "v"(hi)); return r; }
typedef float f32x2 __attribute__((ext_vector_type(2)));
__device__ __forceinline__ u32x4 pack8(const f32x4 v0, const f32x4 v1) { u32x4 w; w.x = cvt_pk_bf16(v0[0], v0[1]); w.y = cvt_pk_bf16(v0[2], v0[3]); w.z = cvt_pk_bf16(v1[0], v1[1]); w.w = cvt_pk_bf16(v1[2], v1[3]); return w; }
__device__ __forceinline__ float silu_f(float a) { return a * __builtin_amdgcn_rcpf(1.f + __expf(-a)); }
__device__ __forceinline__ float q8(float x) { x = fminf(fmaxf(x, -448.f), 448.f); const int p = __builtin_amdgcn_cvt_pk_fp8_f32(x, x, 0, false); return __builtin_amdgcn_cvt_f32_fp8(p, 0); }
__device__ __forceinline__ float clamp8(float x) { return fminf(fmaxf(x, -448.f), 448.f); }
__device__ __forceinline__ unsigned fp8x4(const f32x4 v) { int p = __builtin_amdgcn_cvt_pk_fp8_f32(clamp8(v[0]), clamp8(v[1]), 0, false); p = __builtin_amdgcn_cvt_pk_fp8_f32(clamp8(v[2]), clamp8(v[3]), p, true); return (unsigned)p; }

struct EpiProj {
    static constexpr bool PERM = true, AFTER_DRAIN = false;
    bf16_t* O; float* dtv;
    __device__ __forceinline__ void operator()(const f32x4 (&acc)[2][2][4][2], const Unit& u, int wr, int wc, int fr, int fq) const {
        const int row0 = u.pm * BM + wr * 64 + fr, col0 = u.pn * BM + wc * 32 + 8 * fq;
#pragma unroll
        for (int ai = 0; ai < 2; ++ai)
#pragma unroll
            for (int m = 0; m < 4; ++m) { bf16_t* rowp = O + (size_t)(row0 + ai * HALF + m * 16) * 2304 + col0;
#pragma unroll
                for (int bj = 0; bj < 2; ++bj) *(u32x4*)(rowp + bj * HALF) = pack8(acc[ai][bj][m][0], acc[ai][bj][m][1]); }
        if (u.pn == 6 && wc == 1 && fq == 0) {
#pragma unroll
            for (int ai = 0; ai < 2; ++ai)
#pragma unroll
                for (int m = 0; m < 4; ++m) { float* dp = dtv + (size_t)(row0 + ai * HALF + m * 16) * 8; *(f32x4*)dp = acc[ai][1][m][0]; *(f32x4*)(dp + 4) = acc[ai][1][m][1]; }
        }
    }
};
struct EpiQ {
    static constexpr bool PERM = true, AFTER_DRAIN = false;
    bf16_t* Q; const float* rstd; const float* ropec; const float* ropes; float qscale;
    __device__ __forceinline__ void operator()(const f32x4 (&acc)[2][2][4][2], const Unit& u, int wr, int wc, int fr, int fq) const {
        const int row0 = u.pm * BM + wr * 64 + fr;
#pragma unroll
        for (int bj = 0; bj < 2; ++bj) { const int lc = bj * HALF + wc * 32 + 8 * fq; if (lc >= 192) continue;
            const int hc = lc % 96, g = (hc - 64) >> 3;
#pragma unroll
            for (int ai = 0; ai < 2; ++ai)
#pragma unroll
                for (int m = 0; m < 4; ++m) { const int row = row0 + ai * HALF + m * 16; const float s = rstd[row] * qscale; f32x4 v0 = acc[ai][bj][m][0] * s, v1 = acc[ai][bj][m][1] * s;
                    if (hc >= 64) { const int t = row & 4095; const f32x4 c4 = *(const f32x4*)(ropec + t * 16 + 4 * g), s4 = *(const f32x4*)(ropes + t * 16 + 4 * g);
                        const f32x4 o0 = v0 * c4 - v1 * s4, o1 = v0 * s4 + v1 * c4; v0 = o0; v1 = o1; }
                    *(u32x4*)(Q + (size_t)row * 384 + u.pn * 192 + lc) = pack8(v0, v1); asm volatile("" ::: "memory"); } }
    }
};
struct EpiKV {
    static constexpr bool PERM = true, AFTER_DRAIN = false;
    bf16_t* KN; bf16_t* V; const float* rstd;
    __device__ __forceinline__ void operator()(const f32x4 (&acc)[2][2][4][2], const Unit& u, int wr, int wc, int fr, int fq) const {
        const int row0 = u.pm * BM + wr * 64 + fr, col0 = wc * 32 + 8 * fq; bf16_t* base = u.pn == 0 ? KN : V;
#pragma unroll
        for (int ai = 0; ai < 2; ++ai)
#pragma unroll
            for (int m = 0; m < 4; ++m) { const int row = row0 + ai * HALF + m * 16; const float s = rstd[row];
#pragma unroll
                for (int bj = 0; bj < 2; ++bj) *(u32x4*)(base + (size_t)row * 256 + col0 + bj * HALF) = pack8(acc[ai][bj][m][0] * s, acc[ai][bj][m][1] * s); }
    }
};
struct EpiQKV {
    static constexpr bool PERM = true, AFTER_DRAIN = false;
    EpiQ q; EpiKV kv;
    __device__ __forceinline__ void operator()(const f32x4 (&acc)[2][2][4][2], const Unit& u, int wr, int wc, int fr, int fq) const { if (u.e == 0) q(acc, u, wr, wc, fr, fq); else kv(acc, u, wr, wc, fr, fq); }
};
struct EpiSwiGLU {
    static constexpr bool PERM = true, AFTER_DRAIN = false;
    void* O; int ldo; float ain, qs;
    __device__ __forceinline__ void operator()(const f32x4 (&acc)[2][2][4][2], const Unit& u, int wr, int wc, int fr, int fq) const {
        const int row0 = u.pm * BM + wr * 64 + fr, col0 = u.pn * HALF + wc * 32 + 8 * fq;
#pragma unroll
        for (int ai = 0; ai < 2; ++ai)
#pragma unroll
            for (int m = 0; m < 4; ++m) { const f32x4 a0 = acc[ai][0][m][0] * ain, a1 = acc[ai][0][m][1] * ain, g0 = acc[ai][1][m][0] * ain, g1 = acc[ai][1][m][1] * ain;
                const f32x4 r0 = {silu_f(a0[0]) * g0[0], silu_f(a0[1]) * g0[1], silu_f(a0[2]) * g0[2], silu_f(a0[3]) * g0[3]}, r1 = {silu_f(a1[0]) * g1[0], silu_f(a1[1]) * g1[1], silu_f(a1[2]) * g1[2], silu_f(a1[3]) * g1[3]};
                const size_t off = (size_t)(row0 + ai * HALF + m * 16) * ldo + col0;
                if (qs == 0.f) *(u32x4*)((bf16_t*)O + off) = pack8(r0, r1);
                else { typedef unsigned u32x2 __attribute__((ext_vector_type(2))); u32x2 w; w.x = fp8x4(r0 * qs); w.y = fp8x4(r1 * qs); *(u32x2*)((unsigned char*)O + off) = w; } }
    }
};
struct EpiY {
    static constexpr bool PERM = true, AFTER_DRAIN = false;
    bf16_t* O; int ldo; float ascale;
    __device__ __forceinline__ void operator()(const f32x4 (&acc)[2][2][4][2], const Unit& u, int wr, int wc, int fr, int fq) const {
        const int row0 = u.pm * BM + wr * 64 + fr, col0 = u.pn * BM + wc * 32 + 8 * fq;
#pragma unroll
        for (int ai = 0; ai < 2; ++ai)
#pragma unroll
            for (int m = 0; m < 4; ++m) { bf16_t* rowp = O + (size_t)(row0 + ai * HALF + m * 16) * ldo + col0;
#pragma unroll
                for (int bj = 0; bj < 2; ++bj) *(u32x4*)(rowp + bj * HALF) = pack8(acc[ai][bj][m][0] * ascale, acc[ai][bj][m][1] * ascale); }
    }
};
struct EpiResid {
    static constexpr bool PERM = false, AFTER_DRAIN = false;
    float* X; const float* gate; const int* tok; const float* gw; float xscale; bool dry; float ascale;
    __device__ __forceinline__ void operator()(const f32x4 (&acc)[2][2][4][2], const Unit& u, int wr, int wc, int fr, int fq) const {
        const int row0 = u.pm * BM + wr * 64 + fr, col0 = u.pn * BM + wc * 32 + 4 * fq;
#pragma unroll
        for (int ai = 0; ai < 2; ++ai)
#pragma unroll
            for (int m = 0; m < 4; ++m) { const int prow = row0 + ai * HALF + m * 16; const int token = tok ? tok[prow] : prow; if (token < 0) continue;
                const float w = (gw ? gw[prow] : 1.f) * ascale; const float* gp = gate + (size_t)(token >> 12) * 3072 + col0; float* xp = X + (size_t)token * 1024 + col0;
#pragma unroll
                for (int bj = 0; bj < 2; ++bj)
#pragma unroll
                    for (int n = 0; n < 2; ++n) { const f32x4 gv = *(const f32x4*)(gp + bj * HALF + n * 16), old = *(const f32x4*)(xp + bj * HALF + n * 16);
                        if (!dry) *(f32x4*)(xp + bj * HALF + n * 16) = old * xscale + (gv + 1.f) * (acc[ai][bj][m][n] * w); } }
    }
};
template <class Epi, class Sched, bool ALIGN_EPI = false, bool SP2 = false, int ES = 2  >
__device__ __forceinline__ void gemm_phase(PG8_LAS unsigned char* lds, const Gemm g, const Sched& S, const Epi& E, int tid) {
    const int wid = __builtin_amdgcn_readfirstlane(tid >> 6), lane = tid & 63, wr = wid >> 2, wc = wid & 3, fr = lane & 15, fq = lane >> 4;
    int K = g.K; asm volatile("" : "+s"(K));
    const int nt = (K * ES) / (BK * 2);
    unsigned voffA[2], voffB[2];
#pragma unroll
    for (int i = 0; i < 2; ++i) { int R, C; stage_rc(tid * 16 + i * 8192, R, C); const int Rb = Epi::PERM ? ((R & ~31) + perm32(R & 31)) : R;
        voffA[i] = (unsigned)(R * g.lda * ES + C * 2); voffB[i] = (unsigned)(Rb * K * ES + C * 2); }
    const size_t kstep = (size_t)(BK * 2);
    const size_t hstepA = (size_t)HALF * g.lda * ES, hstepB = (size_t)HALF * K * ES;
    const size_t tstepA = 2 * hstepA, tstepB = 2 * hstepB;
    const unsigned ldsw = (unsigned)wid * 1024u;
    const int aoff = lds_byte(wr * 64 + fr, fq * 8), boff = lds_byte(wc * 32 + fr, fq * 8);
#define PG8_SA(b, h) (((b) * 2 + (h)) * HTB)
#define PG8_SB(b, h) ((4 + (b) * 2 + (h)) * HTB)
#define PG8_STAGE(bufoff, gbase, voff) do { _Pragma("unroll") for (int _i = 0; _i < 2; ++_i) \
        __builtin_amdgcn_global_load_lds((const unsigned*)((const char*)(gbase) + (voff)[_i]), (PG8_LAS unsigned*)(lds + (bufoff) + ldsw + _i * 8192), 16, 0, 0); } while (0)
#define PG8_LDA(dst, b, h) do { _Pragma("unroll") for (int m = 0; m < 4; ++m) _Pragma("unroll") for (int k = 0; k < 2; ++k) dst[m][k] = *(const PG8_LAS bf16x8*)(lds + PG8_SA(b, h) + aoff + m * 2048 + k * 1024); } while (0)
#define PG8_LDB(dst, b, h) do { _Pragma("unroll") for (int n = 0; n < 2; ++n) _Pragma("unroll") for (int k = 0; k < 2; ++k) dst[n][k] = *(const PG8_LAS bf16x8*)(lds + PG8_SB(b, h) + boff + n * 2048 + k * 1024); } while (0)
#define PG8_CAT(x) __builtin_shufflevector(__builtin_bit_cast(i32x4, (x)[0]), __builtin_bit_cast(i32x4, (x)[1]), 0, 1, 2, 3, 4, 5, 6, 7)
#define PG8_MMA(ai, bj, At, Bt) do { __builtin_amdgcn_s_setprio(1); if constexpr (ES == 2) { _Pragma("unroll") for (int m = 0; m < 4; ++m) _Pragma("unroll") for (int n = 0; n < 2; ++n) _Pragma("unroll") for (int k = 0; k < 2; ++k) \
        acc[ai][bj][m][n] = __builtin_amdgcn_mfma_f32_16x16x32_bf16(Bt[n][k], At[m][k], acc[ai][bj][m][n], 0, 0, 0); } else { _Pragma("unroll") for (int m = 0; m < 4; ++m) _Pragma("unroll") for (int n = 0; n < 2; ++n) \
        asm volatile("v_mfma_scale_f32_16x16x128_f8f6f4 %0, %1, %2, %0, %3, %3 op_sel_hi:[0,0,0]" : "+v"(acc[ai][bj][m][n]) : "v"(PG8_CAT(Bt[n])), "v"(PG8_CAT(At[m])), "v"(sc1)); } __builtin_amdgcn_s_setprio(0); } while (0)
#define PG8_WAIT_V(n) asm volatile("s_waitcnt vmcnt(" #n ")" ::: "memory")
#define PG8_WAIT_L(n) asm volatile("s_waitcnt lgkmcnt(" #n ")" ::: "memory")
#define PG8_BAR __builtin_amdgcn_s_barrier()
#define PG8_SCHED __builtin_amdgcn_sched_barrier(0)
    Unit cur, nxt; int ui = 0;
    if (!S.next(0, cur)) return;
    const int sc1 = 0x7f7f7f7f; (void)sc1;
    f32x4 acc[2][2][4][2];
#pragma unroll
    for (int a = 0; a < 2; ++a)
#pragma unroll
        for (int b = 0; b < 2; ++b)
#pragma unroll
            for (int m = 0; m < 4; ++m)
#pragma unroll
                for (int n = 0; n < 2; ++n) acc[a][b][m][n] = (f32x4){0.f, 0.f, 0.f, 0.f};
    bf16x8 At[4][2], B0[2][2], B1[2][2];
    const char* cA = (const char*)g.A + (size_t)cur.e * g.aestride + (size_t)cur.pm * tstepA; const char* cB = (const char*)g.Bt + (size_t)cur.e * g.estride + (size_t)cur.pn * tstepB;
    S.a_ready(cur);
    if constexpr (SP2) {
        PG8_STAGE(PG8_SB(0, 0), cB, voffB); PG8_STAGE(PG8_SB(0, 1), cB + hstepB, voffB); PG8_STAGE(PG8_SA(0, 0), cA, voffA); PG8_STAGE(PG8_SA(0, 1), cA + hstepA, voffA);
        if (wr == 1) PG8_BAR;
        PG8_WAIT_V(2); PG8_BAR;
        PG8_STAGE(PG8_SB(1, 0), cB + kstep, voffB); PG8_STAGE(PG8_SA(1, 0), cA + kstep, voffA); PG8_STAGE(PG8_SB(1, 1), cB + hstepB + kstep, voffB);
        PG8_WAIT_V(6); PG8_BAR;
    } else {
        PG8_STAGE(PG8_SB(0, 0), cB, voffB); PG8_STAGE(PG8_SA(0, 0), cA, voffA); PG8_STAGE(PG8_SB(0, 1), cB + hstepB, voffB); PG8_STAGE(PG8_SA(0, 1), cA + hstepA, voffA);
        if (wr == 1) PG8_BAR;
        PG8_WAIT_V(4); PG8_BAR;
        PG8_STAGE(PG8_SB(1, 0), cB + kstep, voffB); PG8_STAGE(PG8_SA(1, 0), cA + kstep, voffA); PG8_STAGE(PG8_SB(1, 1), cB + hstepB + kstep, voffB);
        PG8_WAIT_V(6); PG8_BAR;
    }
    for (;;) {
        const bool has_next = S.next(ui + 1, nxt);
        const char* nA = has_next ? (const char*)g.A + (size_t)nxt.e * g.aestride + (size_t)nxt.pm * tstepA : cA; const char* nB = has_next ? (const char*)g.Bt + (size_t)nxt.e * g.estride + (size_t)nxt.pn * tstepB : cB;
        for (int t = 0; t < nt; t += 2) {
            const bool last = (t == nt - 2);
            const char* a1 = cA + (size_t)(t + 1) * kstep;
            const char* a2 = last ? nA : cA + (size_t)(t + 2) * kstep; const char* b2 = last ? nB : cB + (size_t)(t + 2) * kstep;
            const char* a3 = a2 + kstep; const char* b3 = b2 + kstep;
            if (last && has_next) S.a_ready(nxt);
            if constexpr (SP2) {
            PG8_LDB(B0, 0, 0); PG8_LDB(B1, 0, 1); PG8_SCHED; PG8_LDA(At, 0, 0); PG8_STAGE(PG8_SA(1, 1), a1 + hstepA, voffA);
            PG8_WAIT_V(8); PG8_WAIT_L(0); PG8_BAR; PG8_MMA(0, 0, At, B0); PG8_MMA(0, 1, At, B1); PG8_BAR; PG8_SCHED;
            PG8_LDA(At, 0, 1); PG8_STAGE(PG8_SB(0, 0), b2, voffB); PG8_STAGE(PG8_SB(0, 1), b2 + hstepB, voffB); PG8_STAGE(PG8_SA(0, 0), a2, voffA);
            PG8_WAIT_V(8); PG8_WAIT_L(0); PG8_BAR; PG8_MMA(1, 0, At, B0); PG8_MMA(1, 1, At, B1); PG8_BAR; PG8_SCHED;
            PG8_LDB(B0, 1, 0); PG8_LDB(B1, 1, 1); PG8_SCHED; PG8_LDA(At, 1, 0); PG8_STAGE(PG8_SA(0, 1), a2 + hstepA, voffA);
            PG8_WAIT_V(8); PG8_WAIT_L(0); PG8_BAR; PG8_MMA(0, 0, At, B0); PG8_MMA(0, 1, At, B1); PG8_BAR; PG8_SCHED;
            PG8_LDA(At, 1, 1); PG8_STAGE(PG8_SB(1, 0), b3, voffB); PG8_STAGE(PG8_SB(1, 1), b3 + hstepB, voffB); PG8_STAGE(PG8_SA(1, 0), a3, voffA);
            PG8_WAIT_V(8); PG8_WAIT_L(0); PG8_BAR; PG8_MMA(1, 0, At, B0); PG8_MMA(1, 1, At, B1); PG8_BAR; PG8_SCHED;
            } else {
            PG8_LDB(B0, 0, 0); PG8_SCHED; PG8_LDA(At, 0, 0); PG8_STAGE(PG8_SA(1, 1), a1 + hstepA, voffA);
            PG8_WAIT_L(8); PG8_BAR; PG8_WAIT_L(0); PG8_MMA(0, 0, At, B0); PG8_BAR; PG8_SCHED;
            PG8_LDB(B1, 0, 1); PG8_STAGE(PG8_SB(0, 0), b2, voffB);
            PG8_BAR; PG8_WAIT_L(0); PG8_MMA(0, 1, At, B1); PG8_BAR;
            PG8_LDA(At, 0, 1); PG8_STAGE(PG8_SA(0, 0), a2, voffA);
            PG8_BAR; PG8_WAIT_L(0); PG8_MMA(1, 0, At, B0); PG8_BAR; PG8_SCHED;
            PG8_STAGE(PG8_SB(0, 1), b2 + hstepB, voffB);
            PG8_WAIT_V(6); PG8_BAR; PG8_MMA(1, 1, At, B1); PG8_BAR;
            PG8_LDB(B0, 1, 0); PG8_SCHED; PG8_LDA(At, 1, 0); PG8_STAGE(PG8_SA(0, 1), a2 + hstepA, voffA);
            PG8_WAIT_L(8); PG8_BAR; PG8_WAIT_L(0); PG8_MMA(0, 0, At, B0); PG8_BAR; PG8_SCHED;
            PG8_LDB(B1, 1, 1); PG8_STAGE(PG8_SB(1, 0), b3, voffB);
            PG8_BAR; PG8_WAIT_L(0); PG8_MMA(0, 1, At, B1); PG8_BAR;
            PG8_LDA(At, 1, 1); PG8_STAGE(PG8_SA(1, 0), a3, voffA);
            PG8_BAR; PG8_WAIT_L(0); PG8_MMA(1, 0, At, B0); PG8_BAR; PG8_SCHED;
            PG8_STAGE(PG8_SB(1, 1), b3 + hstepB, voffB);
            PG8_WAIT_V(6); PG8_BAR; PG8_MMA(1, 1, At, B1); PG8_BAR;
            }
        }
        if constexpr (ES == 1) asm volatile("s_nop 15\n\ts_nop 15" ::: "memory");
        if constexpr (ALIGN_EPI) { if (wr == 0) PG8_BAR; }
        if constexpr (!Epi::AFTER_DRAIN) { E(acc, cur, wr, wc, fr, fq); S.done(cur); }
        if (!has_next) break;
#pragma unroll
        for (int a = 0; a < 2; ++a)
#pragma unroll
            for (int b = 0; b < 2; ++b)
#pragma unroll
                for (int m = 0; m < 4; ++m)
#pragma unroll
                    for (int n = 0; n < 2; ++n) acc[a][b][m][n] = (f32x4){0.f, 0.f, 0.f, 0.f};
        cur = nxt; cA = nA; cB = nB; ++ui;
        if constexpr (ALIGN_EPI) { if (wr == 1) PG8_BAR; }
    }
    PG8_WAIT_V(0);
    if constexpr (!ALIGN_EPI) { if (wr == 0) PG8_BAR; }
    PG8_BAR;
    if constexpr (Epi::AFTER_DRAIN) { E.fused(acc, cur, wr, wc, fr, fq, lds, wid, lane); S.done(cur); }
#undef PG8_SA
#undef PG8_SB
#undef PG8_STAGE
#undef PG8_LDA
#undef PG8_LDB
#undef PG8_MMA
#undef PG8_CAT
#undef PG8_WAIT_V
#undef PG8_WAIT_L
#undef PG8_BAR
#undef PG8_SCHED
}
}
constexpr int NWAVES = 8, NTHR = 512;
constexpr int NB = 8, T_ = 4096, D_ = 1024, M_ = NB * T_, DIN = 2216, NPROJ = 2304, FF = 2816, NE = 8, NCH = 32  ;
constexpr int PZ = 0, PX = 512, PB = 1024, PC = 1152, PQ = 1280, PKV = 1536, PKPE = 1664, PDT = 1696, PGU = 1792, PGV = 2048;
constexpr float LN_EPS = 1e-5f, RMS_EPS = 1e-6f, DN_ALPHA = 1.41421356237f;
constexpr float QSCALE = 0.10206207261596575f * 1.4426950408889634f;
constexpr int MOE_MAXP = 272;
constexpr size_t MiB = 1u << 20;
constexpr size_t WS_CTL = 0, CTL_ZERO_BYTES = 1 * MiB;
constexpr size_t WS_MOD = 1 * MiB, WS_ROPE = 2 * MiB, WS_WQB = 3 * MiB, WS_WKVB = 4 * MiB, WS_ROUTE = 5 * MiB, WS_RSTD = 6 * MiB, WS_DTV = 7 * MiB, WS_ACS = 8 * MiB, WS_GMW = 10 * MiB;
constexpr size_t WS_WIN = 16 * MiB, WS_WOUT = 25 * MiB, WS_W13 = 29 * MiB, WS_W2 = 40 * MiB, WS_MW13 = 46 * MiB  , WS_MW2 = 90 * MiB  ;
constexpr size_t WS_A = 112 * MiB, WS_PROJ = 176 * MiB, WS_Q = 320 * MiB, WS_KN = 344 * MiB, WS_V = 360 * MiB, WS_KPE = 376 * MiB, WS_ST = 378 * MiB;
constexpr size_t WS_CC = 410 * MiB, WS_SB = 418 * MiB;
constexpr size_t WS_ACT = 176 * MiB;
constexpr size_t WS_HP = 176 * MiB, WS_ACTM = 248 * MiB, WS_YP = 112 * MiB, WS_END = 512 * MiB;
static_assert(WS_ACTM + (size_t)MOE_MAXP * 256 * 2816 <= WS_END && WS_ACT + (size_t)M_ * FF * 2 <= WS_END && WS_HP + (size_t)MOE_MAXP * 256 * 1024 <= WS_ACTM && WS_YP + (size_t)MOE_MAXP * 256 * 2048 <= WS_ACTM && WS_SB + 16 * MiB <= WS_END, "d_ws map");
constexpr size_t W13_BYTES = (size_t)5632 * 1024 * 2, W2_BYTES = (size_t)1024 * 2816 * 2, WIN_BYTES = (size_t)NPROJ * 1024 * 2, WOUT_BYTES = (size_t)1024 * 1024 * 2, WQB_BYTES = (size_t)512 * 256 * 2;
constexpr int CW_TMO = 0, CW_CODE = 1, CW_BAR = 4096, CW_CNT = 8192;
constexpr int RING_OFF = 0, RING_BYTES = 131072, LDSCTL_OFF = RING_BYTES, MISC_OFF = LDSCTL_OFF + 320, LDS_BYTES = 147456;

#define GAS __attribute__((address_space(1)))
#define LAS __attribute__((address_space(3)))
typedef unsigned short bf16;
typedef unsigned v4u __attribute__((ext_vector_type(4)));
typedef unsigned v2u __attribute__((ext_vector_type(2)));
typedef float f32x4 __attribute__((ext_vector_type(4)));
typedef GAS unsigned gu32;
#define RLX_AGENT __ATOMIC_RELAXED, __HIP_MEMORY_SCOPE_AGENT
#define LDS_WAIT() asm volatile("s_waitcnt lgkmcnt(0)" ::: "memory")
__device__ __forceinline__ unsigned f2bf(float f) { unsigned u = __builtin_bit_cast(unsigned, f); return (u + 0x7fffu + ((u >> 16) & 1u)) >> 16; }
__device__ __forceinline__ unsigned pk2(float lo, float hi) { return f2bf(lo) | (f2bf(hi) << 16); }
__device__ __forceinline__ float bf2f(bf16 v) { return __uint_as_float((unsigned)v << 16); }
__device__ __forceinline__ float bflo(unsigned w) { return __uint_as_float(w << 16); }
__device__ __forceinline__ float bfhi(unsigned w) { return __uint_as_float(w & 0xffff0000u); }
__device__ __forceinline__ float silu(float a) { return a / (1.f + __expf(-a)); }
__device__ __forceinline__ float gelu_erf(float v) { return 0.5f * v * (1.f + erff(v * 0.70710678118654752f)); }

#define XB_TMO      128
#define XB_XCNT(j)  (256  + 64 * (j))
#define XB_XSUB(j)  (1280 + 64 * (j))
#define XB_XGEN(j)  (2304 + 64 * (j))
#define XB_TOP      3328
#define XB_TOPGEN   3392
#define XCD_BAR_WORDS 3456
#define XB_SPIN_CAP (1u << 22)
__device__ __forceinline__ unsigned xb_ld(unsigned* p)              { return __hip_atomic_load(p, __ATOMIC_RELAXED, __HIP_MEMORY_SCOPE_AGENT); }
__device__ __forceinline__ unsigned xb_add(unsigned* p, unsigned v) { return __hip_atomic_fetch_add(p, v, __ATOMIC_RELAXED, __HIP_MEMORY_SCOPE_AGENT); }
__device__ __forceinline__ unsigned xb_xcc_id() { return (unsigned)__builtin_amdgcn_s_getreg((3 << 11) | 20) & 0xFu; }
#define XB_SPIN(cond, bar) do { unsigned _sp = 0; while (cond) { __builtin_amdgcn_s_sleep(1); \
    if ((++_sp & 255u) == 0u) { if (xb_ld(&(bar)[XB_TMO])) break; if (_sp > XB_SPIN_CAP) { atomicAdd(&(bar)[XB_TMO], 1u); break; } } } } while (0)
struct XcdBarrier { unsigned* bar; unsigned x; volatile LAS unsigned* st; };
__device__ __forceinline__ XcdBarrier xcd_barrier_post(unsigned* bar, volatile LAS unsigned* st) {
    XcdBarrier b; b.bar = bar; b.x = xb_xcc_id(); b.st = st;
    if (threadIdx.x == 0) (void)xb_add(&bar[XB_XCNT(b.x)], 1u);
    return b;
}
__device__ __forceinline__ void xcd_barrier_complete(unsigned* bar, unsigned x, unsigned& nloc, unsigned& nx) {
    const unsigned G = gridDim.x * gridDim.y * gridDim.z;
    unsigned sum, cnt, mine, sp = 0u;
    for (;;) {
        sum = 0u; cnt = 0u; mine = 0u;
#pragma unroll
        for (unsigned j = 0; j < 16; ++j) { const unsigned c = xb_ld(&bar[XB_XCNT(j)]); sum += c; cnt += (c > 0u) ? 1u : 0u; mine = (j == x) ? c : mine; }
        if (sum == G) break;
        __builtin_amdgcn_s_sleep(1);
        if ((++sp & 255u) == 0u) { if (xb_ld(&bar[XB_TMO])) break; if (sp > XB_SPIN_CAP) { atomicAdd(&bar[XB_TMO], 1u); break; } }
    }
    nloc = mine > 0u ? mine : 1u; nx = cnt > 0u ? cnt : 1u;
}
__device__ __forceinline__ void xcd_barrier(const XcdBarrier& b, bool leader) {
    asm volatile("s_waitcnt vmcnt(0)" ::: "memory");
    __syncthreads();
    if (leader) {
        unsigned* bar = b.bar;
        __builtin_amdgcn_s_waitcnt(0);
        unsigned nloc = b.st[0], nx = b.st[1];
        if (nloc == 0u) { xcd_barrier_complete(bar, b.x, nloc, nx); b.st[0] = nloc; b.st[1] = nx; }
        const unsigned old = xb_add(&bar[XB_XSUB(b.x)], 1u);
        const unsigned gen = old / nloc;
        if (old + 1u == (gen + 1u) * nloc) {
            __builtin_amdgcn_fence(__ATOMIC_RELEASE, "agent");
            asm volatile("s_waitcnt vmcnt(0)" ::: "memory");
            const unsigned og = xb_add(&bar[XB_TOP], 1u);
            const unsigned tg = og / nx;
            if (og + 1u == (tg + 1u) * nx) xb_add(&bar[XB_TOPGEN], 1u);
            else XB_SPIN(xb_ld(&bar[XB_TOPGEN]) == tg, bar);
            __builtin_amdgcn_fence(__ATOMIC_ACQUIRE, "agent");
            xb_add(&bar[XB_XGEN(b.x)], 1u);
            asm volatile("s_waitcnt vmcnt(0)" ::: "memory");
        } else {
            XB_SPIN(xb_ld(&bar[XB_XGEN(b.x)]) == gen, bar);
            __builtin_amdgcn_fence(__ATOMIC_ACQUIRE, "agent");
            asm volatile("s_waitcnt vmcnt(0)" ::: "memory");
        }
    }
    __syncthreads();
}

struct Args { const float* in[31]; float* out; unsigned char* ws; int ph_lo, ph_hi; };
enum { I_X = 0, I_C, I_LN0G, I_LN0B, I_ADAW, I_ADAB, I_PLG, I_PLB, I_WIN, I_CONVW, I_CONVB, I_DTB, I_ALOG, I_SSDD, I_SSDNW, I_QNORM, I_WQB, I_KVNORM, I_WKVB,
       I_GMLNG, I_GMLNB, I_GMWS, I_GMBS, I_WOUT, I_FW1, I_FW3, I_FW2, I_ROUTER, I_MW1, I_MW3, I_MW2 };
struct Frame {
    LAS unsigned char* lds; gu32* ctl; unsigned char* ws; float* out;
    int tid, lane, wave, G, bid;
};
__device__ __forceinline__ Frame phase_frame(const Frame& F0) {
    Frame P = F0; asm volatile("" : "+s"(P.wave)); asm volatile("" : "+s"(P.ws)); asm volatile("" : "+s"(P.out)); asm volatile("" : "+s"(P.G)); asm volatile("" : "+s"(P.bid));
    P.lane = (int)__builtin_amdgcn_mbcnt_hi(~0u, __builtin_amdgcn_mbcnt_lo(~0u, 0u)); asm volatile("" : "+v"(P.lane));
    P.tid = P.wave * 64 + P.lane; P.ctl = (gu32*)(P.ws + WS_CTL); return P;
}
__device__ __forceinline__ float wave_sum(float v) {
#pragma unroll
    for (int o = 1; o < 64; o <<= 1) v += __shfl_xor(v, o);
    return v;
}
__device__ __forceinline__ float wave_max(float v) {
#pragma unroll
    for (int o = 1; o < 64; o <<= 1) v = fmaxf(v, __shfl_xor(v, o));
    return v;
}

struct SrcId   { __device__ __forceinline__ int operator()(int n) const { return n; } };
struct SrcWin  { __device__ __forceinline__ int operator()(int n) const {
    if (n < 1280) return n;
    if (n < 1536) return 1288 + (n - 1280);
    if (n < 1664) return 1544 + (n - 1536);
    if (n < 1696) { const int d = n - 1664, g = d >> 3, w = d & 7; return 1672 + ((w < 4) ? 4 * g + w : 16 + 4 * g + (w - 4)); }
    if (n < 1704) return 1280 + (n - 1696);
    if (n < 1792) return -1;
    if (n < 2048) return 1704 + (n - 1792);
    return 1960 + (n - 2048); } };
struct SrcHalf { __device__ __forceinline__ int operator()(int n) const { return 128 * (n >> 8) + (n & 127); } };
struct SrcQB   { __device__ __forceinline__ int operator()(int n) const { const int pn = n >> 8, lc = n & 255; if (lc >= 192) return -1; const int h = 2 * pn + lc / 96, hc = lc % 96; if (hc < 64) return h * 96 + hc;
    const int d = hc - 64, g = d >> 3, w = d & 7; return h * 96 + 64 + ((w < 4) ? 4 * g + w : 16 + 4 * g + (w - 4)); } };
struct SrcKVB  { __device__ __forceinline__ int operator()(int n) const { const int t = n >> 8, r = n & 255, h = r >> 6, d = r & 63; return h * 128 + t * 64 + d; } };
template <class SrcFn>
__device__ __forceinline__ void tr_item(const float* W, int ldw, int Ksrc, const float* kscale, SrcFn src, bf16* WT, int Kdst, int k0, int n0, LAS unsigned char* scr, int lane, float qs = 0.f, bool out8 = false) {
    const int n4 = (lane & 15) * 4, kr = lane >> 4, sc = src(n0 + n4);
    f32x4 v[16];
#pragma unroll
    for (int i = 0; i < 16; ++i) { const int k = k0 + 4 * i + kr; v[i] = (sc >= 0 && k < Ksrc) ? *(const GAS f32x4*)(W + (size_t)k * ldw + sc) : (f32x4){0.f, 0.f, 0.f, 0.f}; }
    if (kscale) {
#pragma unroll
        for (int i = 0; i < 16; ++i) { const int k = k0 + 4 * i + kr; if (k < Ksrc) v[i] = v[i] * kscale[k]; } }
    if (qs != 0.f) { const float iq = out8 ? 1.f : 1.f / qs;
#pragma unroll
        for (int i = 0; i < 16; ++i) { v[i].x = pg8::q8(v[i].x * qs) * iq; v[i].y = pg8::q8(v[i].y * qs) * iq; v[i].z = pg8::q8(v[i].z * qs) * iq; v[i].w = pg8::q8(v[i].w * qs) * iq; } }
#pragma unroll
    for (int i = 0; i < 16; ++i) { LAS unsigned char* p = scr + (4 * i + kr) * 132 + n4 * 2; *(LAS unsigned*)p = pk2(v[i].x, v[i].y); *(LAS unsigned*)(p + 4) = pk2(v[i].z, v[i].w); }
    LDS_WAIT(); asm volatile("" ::: "memory");
    const int c = lane & 7;
#pragma unroll
    for (int j = 0; j < 8; ++j) { const int n = (lane >> 3) + 8 * j; const LAS unsigned char* p = scr + (8 * c) * 132 + n * 2;
        v4u o; o.x = (unsigned)*(const LAS bf16*)(p) | ((unsigned)*(const LAS bf16*)(p + 132) << 16); o.y = (unsigned)*(const LAS bf16*)(p + 264) | ((unsigned)*(const LAS bf16*)(p + 396) << 16);
        o.z = (unsigned)*(const LAS bf16*)(p + 528) | ((unsigned)*(const LAS bf16*)(p + 660) << 16); o.w = (unsigned)*(const LAS bf16*)(p + 792) | ((unsigned)*(const LAS bf16*)(p + 924) << 16);
        if (!out8) *(GAS v4u*)(WT + (size_t)(n0 + n) * Kdst + k0 + 8 * c) = o;
        else { v2u o8; o8.x = pg8::fp8x4((f32x4){bflo(o.x), bfhi(o.x), bflo(o.y), bfhi(o.y)}); o8.y = pg8::fp8x4((f32x4){bflo(o.z), bfhi(o.z), bflo(o.w), bfhi(o.w)});
            *(GAS v2u*)((unsigned char*)WT + (size_t)(n0 + n) * Kdst + k0 + 8 * c) = o8; } }
    LDS_WAIT(); asm volatile("" ::: "memory");
}
__device__ __forceinline__ void p0a(Frame& F, const Args& A) {
    if (F.bid < 192) {
        const int ls = F.bid / 48, col0 = (F.bid % 48) * 64;
        LAS float* sc = (LAS float*)(F.lds);
        LAS float* red = (LAS float*)(F.lds + 32768);
        const float* c = A.in[I_C];
        for (int i = F.tid; i < 8 * 1024; i += NTHR) sc[i] = silu(c[i]);
        __syncthreads();
        const float* w = A.in[I_ADAW] + (size_t)ls * 1024 * 3072 + col0 + F.lane;
        float acc[8];
#pragma unroll
        for (int b = 0; b < 8; ++b) acc[b] = 0.f;
        const int kb = F.wave * 128;
#pragma unroll 16
        for (int k = 0; k < 128; ++k) { const float wv = w[(size_t)(kb + k) * 3072];
#pragma unroll
            for (int b = 0; b < 8; ++b) acc[b] += sc[b * 1024 + kb + k] * wv; }
#pragma unroll
        for (int b = 0; b < 8; ++b) red[(F.wave * 8 + b) * 64 + F.lane] = acc[b];
        __syncthreads();
        { const int b = F.tid >> 6, l = F.tid & 63; float s = 0.f;
#pragma unroll
          for (int wv = 0; wv < 8; ++wv) s += red[(wv * 8 + b) * 64 + l];
          float* mod = (float*)(F.ws + WS_MOD);
          mod[((size_t)ls * 8 + b) * 3072 + col0 + l] = s + A.in[I_ADAB][ls * 3072 + col0 + l]; }
        __syncthreads();
    }
    {
        const double inv[16] = {1.0, 0.5623413251903491, 0.31622776601683794, 0.1778279410038923, 0.1, 0.05623413251903491, 0.03162277660168379, 0.01778279410038923,
                                0.01, 0.005623413251903491, 0.0031622776601683794, 0.0017782794100389228, 0.001, 0.0005623413251903491, 0.00031622776601683794, 0.00017782794100389227};
        float* rc = (float*)(F.ws + WS_ROPE); float* rs = rc + 4096 * 16;
        for (int idx = F.bid * NTHR + F.tid; idx < 4096 * 16; idx += F.G * NTHR) { const int t = idx >> 4, i = idx & 15;
            double iv = inv[0];
#pragma unroll
            for (int q = 1; q < 16; ++q) iv = (i == q) ? inv[q] : iv;
            const double rev = (double)t * iv * 0.15915494309189535; const float fr = (float)(rev - floor(rev));
            rc[idx] = __builtin_amdgcn_cosf(fr); rs[idx] = __builtin_amdgcn_sinf(fr); }
    }
    { const float* W = A.in[I_GMWS]; bf16* o = (bf16*)(F.ws + WS_GMW);
      for (int idx = F.bid * NTHR + F.tid; idx < 2 * 4 * 128 * 128; idx += F.G * NTHR) { const int s = idx & 127, t = (idx >> 7) & 127; o[idx] = (bf16)(s <= t ? f2bf(W[idx]) : 0u); } }
    LAS unsigned char* scr = F.lds + RING_OFF + F.wave * 16384;
    const int gw = F.bid * NWAVES + F.wave, NGW = F.G * NWAVES;
    constexpr int I_WINc = 16 * 36, I_WOUTc = 16 * 16, I_W13c = 16 * 88, I_W2c = 44 * 16, I_QBc = 4 * 8;
    constexpr int NITEMS = 2 * I_WINc + 2 * I_WOUTc + 9 * I_W13c + 9 * I_W2c + 4 * I_QBc;
    for (int it = gw; it < NITEMS; it += NGW) {
        int r = it;
        if (r < 9 * I_W13c) { const int e = r / I_W13c; r %= I_W13c; const int kb = r / 88, nb = r % 88; const int which = (nb >> 1) & 1;
            const float* W = e == 0 ? (which ? A.in[I_FW3] : A.in[I_FW1]) : ((which ? A.in[I_MW3] : A.in[I_MW1]) + (size_t)(e - 1) * 1024 * FF);
            bf16* WT = e == 0 ? (bf16*)(F.ws + WS_W13) : (bf16*)(F.ws + WS_MW13 + (size_t)(e - 1) * (W13_BYTES / 2));
            tr_item(W, FF, 1024, nullptr, SrcHalf(), WT, 1024, kb * 64, nb * 64, scr, F.lane, e > 0 ? 32.f : 0.f, e > 0); continue; } r -= 9 * I_W13c;
        if (r < 9 * I_W2c) { const int e = r / I_W2c; r %= I_W2c; const int kb = r / 16, nb = r % 16;
            const float* W = e == 0 ? A.in[I_FW2] : A.in[I_MW2] + (size_t)(e - 1) * FF * 1024;
            bf16* WT = e == 0 ? (bf16*)(F.ws + WS_W2) : (bf16*)(F.ws + WS_MW2 + (size_t)(e - 1) * (W2_BYTES / 2));
            tr_item(W, 1024, FF, nullptr, SrcId(), WT, FF, kb * 64, nb * 64, scr, F.lane, e > 0 ? 128.f : 0.f, e > 0); continue; } r -= 9 * I_W2c;
        if (r < 2 * I_WINc) { const int l = r / I_WINc; r %= I_WINc; const int kb = r / 36, nb = r % 36;
            tr_item(A.in[I_WIN] + (size_t)l * 1024 * DIN, DIN, 1024, nullptr, SrcWin(), (bf16*)(F.ws + WS_WIN + l * WIN_BYTES), 1024, kb * 64, nb * 64, scr, F.lane); continue; } r -= 2 * I_WINc;
        if (r < 2 * I_WOUTc) { const int l = r / I_WOUTc; r %= I_WOUTc; const int kb = r / 16, nb = r % 16;
            tr_item(A.in[I_WOUT] + (size_t)l * 1024 * 1024, 1024, 1024, nullptr, SrcId(), (bf16*)(F.ws + WS_WOUT + l * WOUT_BYTES), 1024, kb * 64, nb * 64, scr, F.lane); continue; } r -= 2 * I_WOUTc;
        { const int l = (r / I_QBc) & 1, isk = r / (2 * I_QBc); r %= I_QBc; const int kb = r / 8, nb = r % 8;
          if (!isk) tr_item(A.in[I_WQB] + (size_t)l * 256 * 384, 384, 256, A.in[I_QNORM] + l * 256, SrcQB(), (bf16*)(F.ws + WS_WQB + l * WQB_BYTES), 256, kb * 64, nb * 64, scr, F.lane);
          else      tr_item(A.in[I_WKVB] + (size_t)l * 128 * 512, 512, 128, A.in[I_KVNORM] + l * 128, SrcKVB(), (bf16*)(F.ws + WS_WKVB + l * WQB_BYTES), 256, kb * 64, nb * 64, scr, F.lane); }
    }
    __syncthreads();
}
__device__ __forceinline__ void ln_row(const float* vin, const float* g, const float* bt, f32x4 (&x)[4], int lane) {
    const GAS f32x4* xr = (const GAS f32x4*)vin + lane; float s = 0.f;
#pragma unroll
    for (int j = 0; j < 4; ++j) { x[j] = xr[64 * j]; s += (x[j].x + x[j].y) + (x[j].z + x[j].w); }
    const float mean = wave_sum(s) * (1.f / 1024.f); float s2 = 0.f;
#pragma unroll
    for (int j = 0; j < 4; ++j) { x[j] = x[j] - mean; s2 += (x[j].x * x[j].x + x[j].y * x[j].y) + (x[j].z * x[j].z + x[j].w * x[j].w); }
    const float rstd = 1.f / sqrtf(wave_sum(s2) * (1.f / 1024.f) + LN_EPS);
#pragma unroll
    for (int j = 0; j < 4; ++j) { const f32x4 gg = ((const GAS f32x4*)g)[lane + 64 * j], bb = ((const GAS f32x4*)bt)[lane + 64 * j]; x[j] = x[j] * rstd * gg + bb; }
}
__device__ __forceinline__ void ln_rows2_loaded(const float* g, const float* bt, f32x4 (&x)[2][4], int lane) {
    float s[2], s2[2];
#pragma unroll
    for (int i = 0; i < 2; ++i) { s[i] = 0.f;
#pragma unroll
        for (int j = 0; j < 4; ++j) s[i] += (x[i][j].x + x[i][j].y) + (x[i][j].z + x[i][j].w); }
#pragma unroll
    for (int o = 1; o < 64; o <<= 1) { s[0] += __shfl_xor(s[0], o); s[1] += __shfl_xor(s[1], o); }
#pragma unroll
    for (int i = 0; i < 2; ++i) { const float mean = s[i] * (1.f / 1024.f); s2[i] = 0.f;
#pragma unroll
        for (int j = 0; j < 4; ++j) { x[i][j] = x[i][j] - mean; s2[i] += (x[i][j].x * x[i][j].x + x[i][j].y * x[i][j].y) + (x[i][j].z * x[i][j].z + x[i][j].w * x[i][j].w); } }
#pragma unroll
    for (int o = 1; o < 64; o <<= 1) { s2[0] += __shfl_xor(s2[0], o); s2[1] += __shfl_xor(s2[1], o); }
#pragma unroll
    for (int j = 0; j < 4; ++j) { const f32x4 gg = ((const GAS f32x4*)g)[lane + 64 * j], bb = ((const GAS f32x4*)bt)[lane + 64 * j];
#pragma unroll
        for (int i = 0; i < 2; ++i) { const float rstd = 1.f / sqrtf(s2[i] * (1.f / 1024.f) + LN_EPS); x[i][j] = x[i][j] * rstd * gg + bb; } }
}
__device__ __forceinline__ void store_x_h(f32x4 (&x)[4], float* xout, bf16* hout, const float* modp, int lane, bool h8 = false) {
    if (xout) { GAS f32x4* o = (GAS f32x4*)xout + lane;
#pragma unroll
        for (int j = 0; j < 4; ++j) o[64 * j] = x[j]; }
    if (hout) { GAS v2u* o = (GAS v2u*)hout + lane; GAS unsigned* o8 = (GAS unsigned*)hout + lane;
#pragma unroll
        for (int j = 0; j < 4; ++j) { const f32x4 sh = ((const GAS f32x4*)modp)[lane + 64 * j], sc = ((const GAS f32x4*)(modp + 1024))[lane + 64 * j];
            x[j] = x[j] * (sc + 1.f) + sh; if (h8) o8[64 * j] = pg8::fp8x4(x[j]); else { v2u w; w.x = pk2(x[j].x, x[j].y); w.y = pk2(x[j].z, x[j].w); o[64 * j] = w; } } }
}
__device__ __forceinline__ void ln_phase(Frame& F, const Args& A, const float* vin, const float* g, const float* bt, int ls, bool route, bool dry, bool h8 = false) {
    const int gwv = F.bid * NWAVES + F.wave, NGW = F.G * NWAVES;
    const float* mod = (const float*)(F.ws + WS_MOD);
    bf16* hb = (bf16*)(F.ws + WS_A);
    if (!route) {
        f32x4 nx[2][4];
        if (gwv * 2 < M_) {
#pragma unroll
            for (int i = 0; i < 2; ++i)
#pragma unroll
                for (int j = 0; j < 4; ++j) nx[i][j] = ((const GAS f32x4*)(vin + (size_t)(gwv * 2 + i) * 1024) + F.lane)[64 * j]; }
        for (int m = gwv * 2; m < M_; m += NGW * 2) { f32x4 x[2][4];
#pragma unroll
            for (int i = 0; i < 2; ++i)
#pragma unroll
                for (int j = 0; j < 4; ++j) x[i][j] = nx[i][j];
            const int mn = m + NGW * 2;
            if (mn < M_) {
#pragma unroll
                for (int i = 0; i < 2; ++i)
#pragma unroll
                    for (int j = 0; j < 4; ++j) nx[i][j] = ((const GAS f32x4*)(vin + (size_t)(mn + i) * 1024) + F.lane)[64 * j]; }
            ln_rows2_loaded(g, bt, x, F.lane);
#pragma unroll
            for (int i = 0; i < 2; ++i) store_x_h(x[i], (dry ? (float*)(F.ws + WS_PROJ) : F.out) + (size_t)(m + i) * 1024, ls >= 0 ? (dry ? (bf16*)(F.ws + WS_Q) : hb) + (size_t)(m + i) * (h8 ? 512 : 1024) : nullptr, mod + ((size_t)(ls < 0 ? 0 : ls) * 8 + (m >> 12)) * 3072, F.lane, h8); }
    } else {
        f32x4 wr[4][4][2];
        const float* R = A.in[I_ROUTER];
#pragma unroll
        for (int j = 0; j < 4; ++j)
#pragma unroll
            for (int i = 0; i < 4; ++i) { const float* rp = R + (size_t)(4 * F.lane + i + 256 * j) * 8; wr[j][i][0] = *(const f32x4*)rp; wr[j][i][1] = *(const f32x4*)(rp + 4); }
        int* re = (int*)(F.ws + WS_ROUTE); int* rs = re + 2 * M_; float* rg = (float*)(rs + 2 * M_);
        int it = 0, myE0 = -1, myE1 = -1, myM = 0; float myG0 = 0.f;
        for (int m = gwv; m < M_; m += NGW) { f32x4 x[4]; ln_row(vin + (size_t)m * 1024, g, bt, x, F.lane);
            store_x_h(x, (dry ? (float*)(F.ws + WS_PROJ) : F.out) + (size_t)m * 1024, (dry ? (bf16*)(F.ws + WS_Q) : hb) + (size_t)m * 1024, mod + ((size_t)ls * 8 + (m >> 12)) * 3072, F.lane);
            f32x4 p0 = {0.f, 0.f, 0.f, 0.f}, p1 = {0.f, 0.f, 0.f, 0.f};
#pragma unroll
            for (int j = 0; j < 4; ++j) { p0 += wr[j][0][0] * x[j].x + wr[j][1][0] * x[j].y + wr[j][2][0] * x[j].z + wr[j][3][0] * x[j].w;
                                           p1 += wr[j][0][1] * x[j].x + wr[j][1][1] * x[j].y + wr[j][2][1] * x[j].z + wr[j][3][1] * x[j].w; }
            float lg[8] = {wave_sum(p0.x), wave_sum(p0.y), wave_sum(p0.z), wave_sum(p0.w), wave_sum(p1.x), wave_sum(p1.y), wave_sum(p1.z), wave_sum(p1.w)};
            int i0 = 0; float v0 = lg[0];
#pragma unroll
            for (int e = 1; e < 8; ++e) if (lg[e] > v0) { v0 = lg[e]; i0 = e; }
            int i1 = -1; float v1 = -INFINITY;
#pragma unroll
            for (int e = 0; e < 8; ++e) if (e != i0 && lg[e] > v1) { v1 = lg[e]; i1 = e; }
            if (F.lane == it) { myE0 = i0; myE1 = i1; myG0 = 1.f / (1.f + __expf(v1 - v0)); myM = m; }
            ++it;
            if (it == 16 || m + NGW >= M_) {
                const bool act = F.lane < it && !dry; unsigned base[8]; unsigned long long b0[8], b1[8];
#pragma unroll
                for (int e = 0; e < 8; ++e) { b0[e] = __ballot(act && myE0 == e); b1[e] = __ballot(act && myE1 == e); }
#pragma unroll
                for (int e = 0; e < 8; ++e) { base[e] = 0u;
                    if (F.lane == 0 && (b0[e] | b1[e])) base[e] = atomicAdd((unsigned*)(F.ctl + CW_CNT + e * 64), (unsigned)(__popcll(b0[e]) + __popcll(b1[e]))); }
                int s0 = 0, s1 = 0; const unsigned long long lt = (1ull << F.lane) - 1ull;
#pragma unroll
                for (int e = 0; e < 8; ++e) { const unsigned bb = __builtin_amdgcn_readfirstlane(base[e]);
                    if (myE0 == e) s0 = (int)bb + __popcll(b0[e] & lt); if (myE1 == e) s1 = (int)bb + __popcll(b0[e]) + __popcll(b1[e] & lt); }
                if (act) { re[myM] = myE0; re[M_ + myM] = myE1; rs[myM] = s0; rs[M_ + myM] = s1; rg[myM] = myG0; rg[M_ + myM] = 1.f - myG0; }
                it = 0; }
        }
    }
}
__device__ __forceinline__ float conv_silu(const bf16* proj, const float* cw, const float* cb, int b, int t, int ch, int pcol) {
    float a = cb[ch];
#pragma unroll
    for (int k = 0; k < 4; ++k) { const int tt = t - 3 + k; if (tt >= 0) a += cw[k * 768 + ch] * bf2f(proj[((size_t)b * T_ + tt) * NPROJ + pcol]); }
    return silu(a);
}
__device__ __forceinline__ void ssd_chunk_naive(Frame& F, const Args& A, int l, int unit) {
    const int h = unit & 7, c = (unit >> 3) & 31, b = unit >> 8, g = h >> 2;
    const int row0 = b * T_ + c * 128;
    const bf16* proj = (const bf16*)(F.ws + WS_PROJ);
    const float* cw = A.in[I_CONVW] + l * 4 * 768; const float* cb = A.in[I_CONVB] + l * 768;
    LAS float* xs = (LAS float*)(F.lds);
    LAS float* Bs = (LAS float*)(F.lds + 32768);
    LAS float* Cs = (LAS float*)(F.lds + 65536);
    LAS float* dts = (LAS float*)(F.lds + 98304);
    LAS float* acs = dts + 128;
    for (int idx = F.tid; idx < 128 * 64; idx += NTHR) { const int t = idx >> 6, p = idx & 63;
        xs[idx] = conv_silu(proj, cw, cb, b, c * 128 + t, 64 * h + p, PX + 64 * h + p);
        Bs[idx] = conv_silu(proj, cw, cb, b, c * 128 + t, 512 + 64 * g + p, PB + 64 * g + p);
        Cs[idx] = conv_silu(proj, cw, cb, b, c * 128 + t, 640 + 64 * g + p, PC + 64 * g + p); }
    const float* dtv = (const float*)(F.ws + WS_DTV); float* ACS = (float*)(F.ws + WS_ACS);
    if (F.tid < 128) { const float xv = dtv[(size_t)(row0 + F.tid) * 8 + h] + A.in[I_DTB][l * 8 + h]; const float ev = __expf(xv); dts[F.tid] = xv > 20.f ? xv : (ev < 0.01f ? ev * (1.f - ev * (0.5f - ev * 0.33333333f)) : __logf(1.f + ev)); }
    __syncthreads();
    if (F.tid == 0) { const float Ah = -__expf(A.in[I_ALOG][l * 8 + h]); float s = 0.f; for (int t = 0; t < 128; ++t) { s += dts[t] * Ah; acs[t] = s; } }
    __syncthreads();
    if (F.tid < 128) ACS[(size_t)(row0 + F.tid) * 8 + h] = acs[F.tid];
    { float* ST = (float*)(F.ws + WS_ST) + (size_t)((b * NCH + c) * 8 + h) * 4096; const float alast = acs[127];
      for (int idx = F.tid; idx < 4096; idx += NTHR) { const int p = idx >> 6, n = idx & 63; float a = 0.f;
          for (int s = 0; s < 128; ++s) a += xs[s * 64 + p] * Bs[s * 64 + n] * (dts[s] * __expf(alast - acs[s]));
          ST[idx] = a; } }
    { const int lq = F.tid >> 2, pq = (F.tid & 3) * 16; float y[16];
#pragma unroll
      for (int i = 0; i < 16; ++i) y[i] = 0.f;
      const float al = acs[lq];
      for (int s = 0; s <= lq; ++s) { float cbv = 0.f;
#pragma unroll 8
          for (int n = 0; n < 64; ++n) cbv += Cs[lq * 64 + n] * Bs[s * 64 + n];
          const float gg = cbv * __expf(al - acs[s]) * dts[s];
#pragma unroll
          for (int i = 0; i < 16; ++i) y[i] += gg * xs[s * 64 + pq + i]; }
      const float Dh = A.in[I_SSDD][l * 8 + h];
      bf16* yc = (bf16*)(F.ws + WS_A) + (size_t)(row0 + lq) * 1024 + 64 * h + pq;
#pragma unroll
      for (int i = 0; i < 16; i += 2) *(unsigned*)(yc + i) = pk2(y[i] + Dh * xs[lq * 64 + pq + i], y[i + 1] + Dh * xs[lq * 64 + pq + i + 1]); }
    __syncthreads();
}
__device__ __forceinline__ void gmlp_naive(Frame& F, const Args& A, int l, int unit) {
    const int row0 = unit * 128;
    const bf16* proj = (const bf16*)(F.ws + WS_PROJ);
    LAS float* vs = (LAS float*)(F.lds);
    for (int r = F.wave * 16; r < F.wave * 16 + 16; ++r) { const bf16* gp = proj + (size_t)(row0 + r) * NPROJ + PGV + 4 * F.lane; const v2u w = *(const v2u*)gp;
        float v[4] = {gelu_erf(bflo(w.x)), gelu_erf(bfhi(w.x)), gelu_erf(bflo(w.y)), gelu_erf(bfhi(w.y))};
        const float mean = wave_sum((v[0] + v[1]) + (v[2] + v[3])) * (1.f / 256.f); float s2 = 0.f;
#pragma unroll
        for (int i = 0; i < 4; ++i) { v[i] -= mean; s2 += v[i] * v[i]; }
        const float rstd = 1.f / sqrtf(wave_sum(s2) * (1.f / 256.f) + LN_EPS);
#pragma unroll
        for (int i = 0; i < 4; ++i) vs[r * 256 + 4 * F.lane + i] = v[i] * rstd * A.in[I_GMLNG][l * 256 + 4 * F.lane + i] + A.in[I_GMLNB][l * 256 + 4 * F.lane + i]; }
    __syncthreads();
    { const int t = F.tid >> 2, g = F.tid & 3; const float* W = A.in[I_GMWS] + ((size_t)(l * 4 + g) * 128 + t) * 128; float a[64];
#pragma unroll
      for (int i = 0; i < 64; ++i) a[i] = 0.f;
      for (int s = 0; s <= t; ++s) { const float w = W[s];
#pragma unroll
          for (int i = 0; i < 64; ++i) a[i] += w * vs[s * 256 + 64 * g + i]; }
      const float bs = A.in[I_GMBS][(l * 4 + g) * 128 + t];
      const bf16* gu = proj + (size_t)(row0 + t) * NPROJ + PGU + 64 * g; bf16* yc = (bf16*)(F.ws + WS_A) + (size_t)(row0 + t) * 1024 + 768 + 64 * g;
#pragma unroll
      for (int i = 0; i < 64; i += 2) { const unsigned w = *(const unsigned*)(gu + i); *(unsigned*)(yc + i) = pk2(gelu_erf(bflo(w)) * (a[i] + bs), gelu_erf(bfhi(w)) * (a[i + 1] + bs)); } }
    __syncthreads();
}
__device__ __forceinline__ void token_local(Frame& F) {
    const int gwv = F.bid * NWAVES + F.wave, NGW = F.G * NWAVES;
    const bf16* proj = (const bf16*)(F.ws + WS_PROJ); float* rq = (float*)(F.ws + WS_RSTD); float* rkv = rq + M_; bf16* kpe = (bf16*)(F.ws + WS_KPE);
    const float* rc = (const float*)(F.ws + WS_ROPE); const float* rsn = rc + 4096 * 16;
    const int g = (F.lane & 15) >> 2, w = F.lane & 3, ri = 4 * g + w;
    for (int m0 = gwv * 4; m0 < M_; m0 += NGW * 4) {
        v2u wq[4]; unsigned wk[4]; float x1[4], x2[4], cs[4], sn[4];
#pragma unroll
        for (int i = 0; i < 4; ++i) { const bf16* pr = proj + (size_t)(m0 + i) * NPROJ; wq[i] = *(const v2u*)(pr + PQ + 4 * F.lane); wk[i] = *(const unsigned*)(pr + PKV + 2 * F.lane);
            x1[i] = bf2f(pr[PKPE + 8 * g + w]); x2[i] = bf2f(pr[PKPE + 8 * g + 4 + w]); const int t = (m0 + i) & 4095; cs[i] = rc[t * 16 + ri]; sn[i] = rsn[t * 16 + ri]; }
        float sq[4], sk[4];
#pragma unroll
        for (int i = 0; i < 4; ++i) { sq[i] = bflo(wq[i].x) * bflo(wq[i].x) + bfhi(wq[i].x) * bfhi(wq[i].x) + bflo(wq[i].y) * bflo(wq[i].y) + bfhi(wq[i].y) * bfhi(wq[i].y); sk[i] = bflo(wk[i]) * bflo(wk[i]) + bfhi(wk[i]) * bfhi(wk[i]); }
#pragma unroll
        for (int o = 1; o < 64; o <<= 1) {
#pragma unroll
            for (int i = 0; i < 4; ++i) { sq[i] += __shfl_xor(sq[i], o); sk[i] += __shfl_xor(sk[i], o); } }
#pragma unroll
        for (int i = 0; i < 4; ++i) { const int m = m0 + i;
            if (F.lane == 0) { rq[m] = 1.f / sqrtf(sq[i] * (1.f / 256.f) + RMS_EPS); rkv[m] = 1.f / sqrtf(sk[i] * (1.f / 128.f) + RMS_EPS); }
            if (F.lane < 16) { kpe[(size_t)m * 32 + 8 * g + w] = (bf16)f2bf(x1[i] * cs[i] - x2[i] * sn[i]); kpe[(size_t)m * 32 + 8 * g + 4 + w] = (bf16)f2bf(x1[i] * sn[i] + x2[i] * cs[i]); } }
    }
}
__device__ __forceinline__ void state_scan(Frame& F) {
    float* ST = (float*)(F.ws + WS_ST); const float* ACS = (const float*)(F.ws + WS_ACS);
    for (int idx = F.bid * NTHR + F.tid; idx < NB * 8 * 4096; idx += F.G * NTHR) { const int pn = idx & 4095, h = (idx >> 12) & 7, b = idx >> 15; float cur = 0.f;
        for (int c = 0; c < NCH; ++c) { const size_t a = (size_t)((b * NCH + c) * 8 + h) * 4096 + pn; const float s = ST[a]; ST[a] = cur;
            cur = cur * __expf(ACS[(size_t)(b * T_ + c * 128 + 127) * 8 + h]) + s; } }
}
__device__ __forceinline__ void ssd_finish_naive(Frame& F, const Args& A, int l, int unit) {
    const int g = unit & 1, c = (unit >> 1) & 31, b = unit >> 6; const int row0 = b * T_ + c * 128;
    const bf16* proj = (const bf16*)(F.ws + WS_PROJ);
    const float* cw = A.in[I_CONVW] + l * 4 * 768; const float* cb = A.in[I_CONVB] + l * 768;
    LAS float* Sin = (LAS float*)(F.lds);
    LAS float* Cs = (LAS float*)(F.lds + 4 * 64 * 65 * 4);
    const float* ST = (const float*)(F.ws + WS_ST) + (size_t)((b * NCH + c) * 8 + 4 * g) * 4096;
    for (int idx = F.tid; idx < 4 * 4096; idx += NTHR) { const int r = idx >> 12, p = (idx >> 6) & 63, n = idx & 63; Sin[(r * 64 + p) * 65 + n] = ST[idx]; }
    for (int idx = F.tid; idx < 128 * 64; idx += NTHR) { const int t = idx >> 6, n = idx & 63; Cs[t * 65 + n] = conv_silu(proj, cw, cb, b, c * 128 + t, 640 + 64 * g + n, PC + 64 * g + n); }
    __syncthreads();
    const int lq = F.tid >> 2, r = F.tid & 3, h = 4 * g + r;
    float cv[64];
#pragma unroll
    for (int n = 0; n < 64; ++n) cv[n] = Cs[lq * 65 + n];
    const float ea = __expf(((const float*)(F.ws + WS_ACS))[(size_t)(row0 + lq) * 8 + h]);
    bf16* yc = (bf16*)(F.ws + WS_A) + (size_t)(row0 + lq) * 1024 + 64 * h; const bf16* zp = proj + (size_t)(row0 + lq) * NPROJ + PZ + 64 * h;
    float ss = 0.f;
#pragma unroll 1
    for (int p = 0; p < 64; ++p) { float a = 0.f;
#pragma unroll
        for (int n = 0; n < 64; ++n) a += cv[n] * Sin[(r * 64 + p) * 65 + n];
        const float y = bf2f(yc[p]) + ea * a, gy = y * silu(bf2f(zp[p])); ss += gy * gy; }
    ss += __shfl_xor(ss, 1); ss += __shfl_xor(ss, 2);
    const float rs = 1.f / sqrtf(ss * (1.f / 256.f) + RMS_EPS); const float* nw = A.in[I_SSDNW] + l * 512 + 64 * h;
#pragma unroll 1
    for (int p = 0; p < 64; ++p) { float a = 0.f;
#pragma unroll
        for (int n = 0; n < 64; ++n) a += cv[n] * Sin[(r * 64 + p) * 65 + n];
        const float y = bf2f(yc[p]) + ea * a, gy = y * silu(bf2f(zp[p])); yc[p] = (bf16)f2bf(gy * rs * nw[p]); }
    __syncthreads();
}
__device__ __forceinline__ void attn_naive(Frame& F, int unit) {
    const int qb = unit & 63, h = (unit >> 6) & 3, b = unit >> 8;
    const bf16* Q = (const bf16*)(F.ws + WS_Q); const bf16* KN = (const bf16*)(F.ws + WS_KN); const bf16* V = (const bf16*)(F.ws + WS_V); const bf16* KPE = (const bf16*)(F.ws + WS_KPE);
    LAS float* Kt = (LAS float*)(F.lds);
    LAS float* Vt = (LAS float*)(F.lds + 64 * 97 * 4);
    LAS float* Qs = Vt + 64 * 64;
    LAS float* Pw = Qs + 64 * 96 + F.wave * 64;
    for (int idx = F.tid; idx < 64 * 96; idx += NTHR) { const int r = idx / 96, d = idx % 96; Qs[idx] = bf2f(Q[(size_t)(b * T_ + qb * 64 + r) * 384 + h * 96 + d]); }
    float mx[8], ls[8], o[8];
#pragma unroll
    for (int i = 0; i < 8; ++i) { mx[i] = -INFINITY; ls[i] = 0.f; o[i] = 0.f; }
    for (int kt = 0; kt <= qb; ++kt) {
        __syncthreads();
        for (int idx = F.tid; idx < 64 * 96; idx += NTHR) { const int j = idx / 96, d = idx % 96; const size_t row = (size_t)(b * T_ + kt * 64 + j);
            Kt[j * 97 + d] = d < 64 ? bf2f(KN[row * 256 + h * 64 + d]) : bf2f(KPE[row * 32 + d - 64]); }
        for (int idx = F.tid; idx < 64 * 64; idx += NTHR) { const int j = idx >> 6, d = idx & 63; Vt[idx] = bf2f(V[(size_t)(b * T_ + kt * 64 + j) * 256 + h * 64 + d]); }
        __syncthreads();
#pragma unroll
        for (int i = 0; i < 8; ++i) { const int qr = F.wave * 8 + i; float s = 0.f;
#pragma unroll 8
            for (int d = 0; d < 96; ++d) s += Qs[qr * 96 + d] * Kt[F.lane * 97 + d];
            if (kt * 64 + F.lane > qb * 64 + qr) s = -INFINITY;
            const float mn = fmaxf(mx[i], wave_max(s)), p = exp2f(s - mn), corr = exp2f(mx[i] - mn);
            ls[i] = ls[i] * corr + wave_sum(p); mx[i] = mn;
            Pw[F.lane] = p; LDS_WAIT(); asm volatile("" ::: "memory");
            float a = 0.f;
#pragma unroll 8
            for (int j = 0; j < 64; ++j) a += Pw[j] * Vt[j * 64 + F.lane];
            o[i] = o[i] * corr + a; LDS_WAIT(); asm volatile("" ::: "memory"); }
    }
    bf16* yc = (bf16*)(F.ws + WS_A);
#pragma unroll
    for (int i = 0; i < 8; ++i) yc[(size_t)(b * T_ + qb * 64 + F.wave * 8 + i) * 1024 + 512 + h * 64 + F.lane] = (bf16)f2bf(o[i] / ls[i]);
    __syncthreads();
}
namespace att {
typedef short bf16x8 __attribute__((ext_vector_type(8)));
typedef short s16x4 __attribute__((ext_vector_type(4)));
typedef float f32x16 __attribute__((ext_vector_type(16)));
typedef unsigned u32x4 __attribute__((ext_vector_type(4)));
constexpr int KSLOT = 12288, VSLOT = 8192, NSLOT = 3, LDS_K = 0, LDS_V = NSLOT * KSLOT, LDS_TOTAL = NSLOT * (KSLOT + VSLOT);
__device__ __forceinline__ int crow(int r, int hi) { return (r & 3) + 8 * (r >> 2) + 4 * hi; }
__device__ __forceinline__ s16x4 vtr(const LAS unsigned char* p) { return __builtin_bit_cast(s16x4, __builtin_amdgcn_ds_read_tr16_b64_v4i16((LAS s16x4*)p)); }
__device__ __forceinline__ float xhalf(float v) { return __shfl_xor(v, 32); }
__device__ __forceinline__ unsigned pk(float lo, float hi) { typedef float f2 __attribute__((ext_vector_type(2))); typedef __bf16 b2 __attribute__((ext_vector_type(2))); f2 v = {lo, hi}; b2 b = __builtin_convertvector(v, b2); return __builtin_bit_cast(unsigned, b); }
__device__ __forceinline__ bf16x8 pack8r(const f32x16& x, int s) { u32x4 w; w.x = pk(x[8 * s], x[8 * s + 1]); w.y = pk(x[8 * s + 2], x[8 * s + 3]); w.z = pk(x[8 * s + 4], x[8 * s + 5]); w.w = pk(x[8 * s + 6], x[8 * s + 7]); return __builtin_bit_cast(bf16x8, w); }
#define ATT_MFMA(a, b, c) __builtin_amdgcn_mfma_f32_32x32x16_bf16((a), (b), (c), 0, 0, 0)
__device__ __forceinline__ void attn_unit(Frame& F, int b, int h, int qb) {
    const int lane = F.lane, r32 = lane & 31, hi = lane >> 5, wid = F.wave;
    const size_t rowbase = (size_t)b * T_; const int q0 = qb * 256, qrow = q0 + 32 * wid + r32;
    const bf16* Q = (const bf16*)(F.ws + WS_Q); const bf16* KN = (const bf16*)(F.ws + WS_KN); const bf16* V = (const bf16*)(F.ws + WS_V); const bf16* KPE = (const bf16*)(F.ws + WS_KPE);
    LAS unsigned char* lds = F.lds;
    const int NT = (q0 + 256) / 64;
    const bf16* srcA = KN + (rowbase + lane) * 256 + h * 64 + 8 * wid; const int dstA = LDS_K + wid * 1024;
    const bf16* srcB; int dstB; size_t strB;
    if (wid < 4) { srcB = KPE + (rowbase + lane) * 32 + 8 * wid; dstB = LDS_K + (8 + wid) * 1024; strB = 64 * 32; }
    else { srcB = V + (rowbase + 16 * (wid - 4) + (lane >> 2)) * 256 + h * 64 + 8 * (lane & 3); dstB = LDS_V + (wid - 4) * 1024; strB = 64 * 256; }
    const bf16* srcC = V + (rowbase + 16 * (wid & 3) + (lane >> 2)) * 256 + h * 64 + 32 + 8 * (lane & 3); const int dstC = LDS_V + (4 + (wid & 3)) * 1024;
    const int slotB = wid < 4 ? KSLOT : VSLOT;
#define ATT_DMA(t, s) do { \
        __builtin_amdgcn_global_load_lds((const unsigned*)(srcA + (size_t)(t) * 64 * 256), (LAS unsigned*)(lds + dstA + (s) * KSLOT), 16, 0, 0); \
        __builtin_amdgcn_global_load_lds((const unsigned*)(srcB + (size_t)(t) * strB), (LAS unsigned*)(lds + dstB + (s) * slotB), 16, 0, 0); \
        __builtin_amdgcn_global_load_lds((const unsigned*)(srcC + (size_t)(t) * 64 * 256), (LAS unsigned*)(lds + dstC + (s) * VSLOT), 16, 0, 0); } while (0)
    bf16x8 qr[6];
#pragma unroll
    for (int d0 = 0; d0 < 6; ++d0) qr[d0] = *(const bf16x8*)(Q + (rowbase + qrow) * 384 + h * 96 + 16 * d0 + 8 * hi);
    asm volatile("s_waitcnt vmcnt(0)" ::: "memory");
    ATT_DMA(0, 0); ATT_DMA(1, 1);
    f32x16 o0, o1;
#pragma unroll
    for (int i = 0; i < 16; ++i) { o0[i] = 0.f; o1[i] = 0.f; }
    float m = -INFINITY, l = 0.f;
    const int voff = ((lane >> 4) & 1) * 32 + (lane & 3) * 8 + (4 * hi + ((lane & 15) >> 2)) * 64;
    int slot = 0;
    for (int t = 0; t < NT; ++t) {
        if (t + 1 < NT) asm volatile("s_waitcnt vmcnt(3)" ::: "memory"); else asm volatile("s_waitcnt vmcnt(0)" ::: "memory");
        __builtin_amdgcn_s_barrier(); asm volatile("" ::: "memory");
        if (t + 2 < NT) { const int s2 = slot == 0 ? 2 : slot - 1; ATT_DMA(t + 2, s2); }
        if (64 * t <= q0 + 32 * wid + 31) {
            const LAS unsigned char* kb = lds + LDS_K + slot * KSLOT + hi * 1024 + r32 * 16;
            f32x16 p0, p1;
#pragma unroll
            for (int i = 0; i < 16; ++i) { p0[i] = 0.f; p1[i] = 0.f; }
#pragma unroll
            for (int d0 = 0; d0 < 6; ++d0) { const bf16x8 k0 = *(const LAS bf16x8*)(kb + d0 * 2048), k1 = *(const LAS bf16x8*)(kb + d0 * 2048 + 512);
                p0 = ATT_MFMA(k0, qr[d0], p0); p1 = ATT_MFMA(k1, qr[d0], p1); }
            if (64 * t + 63 > q0 + 32 * wid) {
#pragma unroll
                for (int r = 0; r < 16; ++r) { const int kv = 64 * t + crow(r, hi); if (kv > qrow) p0[r] = -INFINITY; if (kv + 32 > qrow) p1[r] = -INFINITY; }
            }
            float mx = fmaxf(p0[0], p1[0]);
#pragma unroll
            for (int r = 1; r < 16; ++r) mx = fmaxf(mx, fmaxf(p0[r], p1[r]));
            mx = fmaxf(mx, xhalf(mx));
            const float mn = fmaxf(m, mx);
            if (__any(mn > m)) { const float corr = __builtin_amdgcn_exp2f(m - mn); l *= corr;
#pragma unroll
                for (int i = 0; i < 16; ++i) { o0[i] *= corr; o1[i] *= corr; }
                m = mn; }
            float sum = 0.f;
#pragma unroll
            for (int r = 0; r < 16; ++r) { p0[r] = __builtin_amdgcn_exp2f(p0[r] - m); p1[r] = __builtin_amdgcn_exp2f(p1[r] - m); sum += p0[r] + p1[r]; }
            l += sum;
            const bf16x8 pa0 = pack8r(p0, 0), pa1 = pack8r(p0, 1), pa2 = pack8r(p1, 0), pa3 = pack8r(p1, 1);
            const LAS unsigned char* vb = lds + LDS_V + slot * VSLOT + voff;
#define ATT_VF(dh, ks) ({ const s16x4 lo_ = vtr(vb + (dh) * 4096 + (ks) * 1024), hi_ = vtr(vb + (dh) * 4096 + (ks) * 1024 + 512); (bf16x8){lo_[0], lo_[1], lo_[2], lo_[3], hi_[0], hi_[1], hi_[2], hi_[3]}; })
            o0 = ATT_MFMA(ATT_VF(0, 0), pa0, o0); o1 = ATT_MFMA(ATT_VF(1, 0), pa0, o1);
            o0 = ATT_MFMA(ATT_VF(0, 1), pa1, o0); o1 = ATT_MFMA(ATT_VF(1, 1), pa1, o1);
            o0 = ATT_MFMA(ATT_VF(0, 2), pa2, o0); o1 = ATT_MFMA(ATT_VF(1, 2), pa2, o1);
            o0 = ATT_MFMA(ATT_VF(0, 3), pa3, o0); o1 = ATT_MFMA(ATT_VF(1, 3), pa3, o1);
#undef ATT_VF
        }
        slot = slot == 2 ? 0 : slot + 1;
    }
    l += xhalf(l);
    const float rl = 1.f / l;
    bf16* yc = (bf16*)(F.ws + WS_A) + (rowbase + qrow) * 1024 + 512 + h * 64;
#pragma unroll
    for (int g = 0; g < 4; ++g) { v2u w0, w1; w0.x = pk(o0[4 * g] * rl, o0[4 * g + 1] * rl); w0.y = pk(o0[4 * g + 2] * rl, o0[4 * g + 3] * rl); w1.x = pk(o1[4 * g] * rl, o1[4 * g + 1] * rl); w1.y = pk(o1[4 * g + 2] * rl, o1[4 * g + 3] * rl);
        *(v2u*)(yc + 8 * g + 4 * hi) = w0; *(v2u*)(yc + 32 + 8 * g + 4 * hi) = w1; }
    asm volatile("s_waitcnt lgkmcnt(0)" ::: "memory"); __builtin_amdgcn_s_barrier(); asm volatile("" ::: "memory");
#undef ATT_DMA
}
#undef ATT_MFMA
}
namespace mix {
typedef short bf16x8 __attribute__((ext_vector_type(8)));
typedef short s16x4 __attribute__((ext_vector_type(4)));
typedef float f32x2 __attribute__((ext_vector_type(2)));
#define MIX_MFMA(a, b, c) __builtin_amdgcn_mfma_f32_16x16x32_bf16((a), (b), (c), 0, 0, 0)
constexpr int BS_STR = 72, XT_STR = 136;
constexpr int LBS = 0, LCS = LBS + 128 * BS_STR * 2, LBT = LCS + 128 * BS_STR * 2, LXT = LBT + 64 * XT_STR * 2, LDT = LXT + 4 * 64 * XT_STR * 2, LACS = LDT + 4 * 128 * 4, LEND = LACS + 4 * 128 * 4;
static_assert(LEND <= RING_BYTES, "SSD LDS map");
__device__ __forceinline__ float softplus(float xv) { const float ev = __expf(xv); return xv > 20.f ? xv : (ev < 0.01f ? ev * (1.f - ev * (0.5f - ev * 0.33333333f)) : __logf(1.f + ev)); }
__device__ __forceinline__ f32x2 gelu_pk(f32x2 v) {
    const f32x2 av = __builtin_elementwise_abs(v), d = av * 0.2316418882f + 1.0f;
    f32x2 t; t.x = __builtin_amdgcn_rcpf(d.x); t.y = __builtin_amdgcn_rcpf(d.y);
    f32x2 q = t * 0.5307027145f + (-0.7265760135f); q = q * t + 0.7107068705f; q = q * t + (-0.142248368f); q = q * t + 0.127414796f; q = q * t;
    const f32x2 s = (v * v) * (-0.72134752044f);
    f32x2 e; e.x = __builtin_amdgcn_exp2f(s.x); e.y = __builtin_amdgcn_exp2f(s.y);
    const f32x2 m = v * (q * e), r = v - m;
    f32x2 o; o.x = v.x < 0.f ? m.x : r.x; o.y = v.y < 0.f ? m.y : r.y; return o;
}
__device__ __forceinline__ void ssd_chunk(Frame& F, const Args& A, int l, int unit) {
    const int g = unit & 1, c = (unit >> 1) & 31, b = unit >> 6; const int row0 = b * T_ + c * 128, tq0 = c * 128;
    const int tid = F.tid, lane = F.lane, w = F.wave, fr = lane & 15, fq = lane >> 4;
    const bf16* proj = (const bf16*)(F.ws + WS_PROJ);
    const float* cw = A.in[I_CONVW] + l * 4 * 768; const float* cb = A.in[I_CONVB] + l * 768;
    LAS unsigned char* lds = F.lds;
    { const int chp = tid & 127, tseg = tid >> 7, cg = 2 * chp, ch = 256 * g + cg;
      float wk[4][2];
#pragma unroll
      for (int k = 0; k < 4; ++k) { wk[k][0] = cw[k * 768 + ch]; wk[k][1] = cw[k * 768 + ch + 1]; }
      const float b0 = cb[ch], b1 = cb[ch + 1];
      unsigned xin[35];
#pragma unroll
      for (int i = 0; i < 35; ++i) { const int tt = tq0 + 32 * tseg - 3 + i; xin[i] = tt >= 0 ? *(const unsigned*)(proj + (size_t)(b * T_ + tt) * NPROJ + PX + ch) : 0u; }
      LAS unsigned char* x0p = lds + LXT + ((cg >> 6) * 64 + (cg & 63)) * XT_STR * 2 + 32 * tseg * 2;
#pragma unroll
      for (int i = 0; i < 32; i += 2) { float y[2][2];
#pragma unroll
          for (int u = 0; u < 2; ++u) { float a0 = b0, a1 = b1;
#pragma unroll
              for (int k = 0; k < 4; ++k) { a0 += wk[k][0] * bflo(xin[i + u + k]); a1 += wk[k][1] * bfhi(xin[i + u + k]); }
              y[u][0] = silu(a0); y[u][1] = silu(a1); }
          *(LAS unsigned*)(x0p + i * 2) = pk2(y[0][0], y[1][0]); *(LAS unsigned*)(x0p + XT_STR * 2 + i * 2) = pk2(y[0][1], y[1][1]); } }
    { const int which = tid >> 8, chp = tid & 31, tseg = (tid >> 5) & 7, n0 = 2 * chp, ch = 512 + which * 128 + 64 * g + n0, pcol = (which ? PC : PB) + 64 * g + n0;
      float wk[4][2];
#pragma unroll
      for (int k = 0; k < 4; ++k) { wk[k][0] = cw[k * 768 + ch]; wk[k][1] = cw[k * 768 + ch + 1]; }
      const float b0 = cb[ch], b1 = cb[ch + 1];
      unsigned xin[19];
#pragma unroll
      for (int i = 0; i < 19; ++i) { const int tt = tq0 + 16 * tseg - 3 + i; xin[i] = tt >= 0 ? *(const unsigned*)(proj + (size_t)(b * T_ + tt) * NPROJ + pcol) : 0u; }
      bf16* CC = (bf16*)(F.ws + WS_CC);
#pragma unroll
      for (int i = 0; i < 16; i += 2) { float y[2][2];
#pragma unroll
          for (int u = 0; u < 2; ++u) { float a0 = b0, a1 = b1;
#pragma unroll
              for (int k = 0; k < 4; ++k) { a0 += wk[k][0] * bflo(xin[i + u + k]); a1 += wk[k][1] * bfhi(xin[i + u + k]); }
              y[u][0] = silu(a0); y[u][1] = silu(a1); }
          const int s = 16 * tseg + i;
          const unsigned r0 = pk2(y[0][0], y[0][1]), r1 = pk2(y[1][0], y[1][1]);
          if (which == 0) { *(LAS unsigned*)(lds + LBS + (s * BS_STR + n0) * 2) = r0; *(LAS unsigned*)(lds + LBS + ((s + 1) * BS_STR + n0) * 2) = r1;
              *(LAS unsigned*)(lds + LBT + (n0 * XT_STR + s) * 2) = pk2(y[0][0], y[1][0]); *(LAS unsigned*)(lds + LBT + ((n0 + 1) * XT_STR + s) * 2) = pk2(y[0][1], y[1][1]); }
          else { *(LAS unsigned*)(lds + LCS + (s * BS_STR + n0) * 2) = r0; *(LAS unsigned*)(lds + LCS + ((s + 1) * BS_STR + n0) * 2) = r1;
              *(unsigned*)(CC + (size_t)(row0 + s) * 128 + 64 * g + n0) = r0; *(unsigned*)(CC + (size_t)(row0 + s + 1) * 128 + 64 * g + n0) = r1; } } }
    if (w < 4) { const int h = 4 * g + w; const float* dtv = (const float*)(F.ws + WS_DTV); const float bias = A.in[I_DTB][l * 8 + h], Ah = -__expf(A.in[I_ALOG][l * 8 + h]);
        const float d0 = softplus(dtv[(size_t)(row0 + 2 * lane) * 8 + h] + bias), d1 = softplus(dtv[(size_t)(row0 + 2 * lane + 1) * 8 + h] + bias);
        const float a0 = d0 * Ah, a1 = d1 * Ah; float s = a0 + a1;
#pragma unroll
        for (int o = 1; o < 64; o <<= 1) { const float v = __shfl_up(s, o); if (lane >= o) s += v; }
        const float c1 = s, c0 = s - a1;
        LAS float* dts = (LAS float*)(lds + LDT) + w * 128; LAS float* acs = (LAS float*)(lds + LACS) + w * 128;
        dts[2 * lane] = d0; dts[2 * lane + 1] = d1; acs[2 * lane] = c0; acs[2 * lane + 1] = c1;
        float* ACS = (float*)(F.ws + WS_ACS); ACS[(size_t)(row0 + 2 * lane) * 8 + h] = c0; ACS[(size_t)(row0 + 2 * lane + 1) * 8 + h] = c1; }
    __syncthreads();
    f32x4 cbT[8];
    { bf16x8 cf[2];
#pragma unroll
      for (int ks = 0; ks < 2; ++ks) cf[ks] = *(const LAS bf16x8*)(lds + LCS + ((16 * w + fr) * BS_STR + 32 * ks + 8 * fq) * 2);
#pragma unroll
      for (int st = 0; st < 8; ++st) { cbT[st] = (f32x4){0.f, 0.f, 0.f, 0.f};
          if (st <= w) {
#pragma unroll
              for (int ks = 0; ks < 2; ++ks) { const bf16x8 bfg = *(const LAS bf16x8*)(lds + LBS + ((16 * st + fr) * BS_STR + 32 * ks + 8 * fq) * 2); cbT[st] = MIX_MFMA(bfg, cf[ks], cbT[st]); } } } }
    const int lrow = 16 * w + fr;
#pragma unroll 1
    for (int r = 0; r < 4; ++r) { const int h = 4 * g + r;
        const LAS float* dts = (const LAS float*)(lds + LDT) + r * 128; const LAS float* acs = (const LAS float*)(lds + LACS) + r * 128;
        const float al = acs[lrow];
        bf16x8 gf[4];
#pragma unroll
        for (int i = 0; i < 4; ++i) { float gv[8];
#pragma unroll
            for (int hf = 0; hf < 2; ++hf) { const int st = 2 * i + hf; const f32x4 a4 = *(const LAS f32x4*)(acs + 16 * st + 4 * fq), d4 = *(const LAS f32x4*)(dts + 16 * st + 4 * fq);
#pragma unroll
                for (int j = 0; j < 4; ++j) { const int s = 16 * st + 4 * fq + j; gv[4 * hf + j] = s <= lrow ? cbT[st][j] * __expf(al - a4[j]) * d4[j] : 0.f; } }
            v4u pw; pw.x = pk2(gv[0], gv[1]); pw.y = pk2(gv[2], gv[3]); pw.z = pk2(gv[4], gv[5]); pw.w = pk2(gv[6], gv[7]); gf[i] = __builtin_bit_cast(bf16x8, pw); }
        const float Dh = A.in[I_SSDD][l * 8 + h];
        const LAS unsigned char* xt = lds + LXT + r * 64 * XT_STR * 2;
        bf16* yc = (bf16*)(F.ws + WS_A) + (size_t)(row0 + lrow) * 1024 + 64 * h;
#pragma unroll
        for (int pt = 0; pt < 4; ++pt) { f32x4 acc = {0.f, 0.f, 0.f, 0.f};
#pragma unroll
            for (int i = 0; i < 4; ++i) if (2 * i <= w) { const LAS unsigned char* xp = xt + ((16 * pt + fr) * XT_STR + 32 * i + 4 * fq) * 2;
                const s16x4 x0 = *(const LAS s16x4*)xp, x1 = *(const LAS s16x4*)(xp + 32);
                acc = MIX_MFMA(((bf16x8){x0[0], x0[1], x0[2], x0[3], x1[0], x1[1], x1[2], x1[3]}), gf[i], acc); }
            float xl[4];
#pragma unroll
            for (int j = 0; j < 4; ++j) xl[j] = bf2f(*(const LAS bf16*)(xt + ((16 * pt + 4 * fq + j) * XT_STR + lrow) * 2));
            v2u o; o.x = pk2(acc[0] + Dh * xl[0], acc[1] + Dh * xl[1]); o.y = pk2(acc[2] + Dh * xl[2], acc[3] + Dh * xl[3]);
            *(v2u*)(yc + 16 * pt + 4 * fq) = o; }
        { const float alast = acs[127]; const int pt = w >> 1; f32x4 s0 = {0.f, 0.f, 0.f, 0.f}, s1 = {0.f, 0.f, 0.f, 0.f};
#pragma unroll
          for (int ks = 0; ks < 4; ++ks) { const v4u xw = *(const LAS v4u*)(xt + ((16 * pt + fr) * XT_STR + 32 * ks + 8 * fq) * 2);
              const f32x4 a0 = *(const LAS f32x4*)(acs + 32 * ks + 8 * fq), a1 = *(const LAS f32x4*)(acs + 32 * ks + 8 * fq + 4), d0 = *(const LAS f32x4*)(dts + 32 * ks + 8 * fq), d1 = *(const LAS f32x4*)(dts + 32 * ks + 8 * fq + 4);
              v4u sw; sw.x = pk2(bflo(xw.x) * d0[0] * __expf(alast - a0[0]), bfhi(xw.x) * d0[1] * __expf(alast - a0[1])); sw.y = pk2(bflo(xw.y) * d0[2] * __expf(alast - a0[2]), bfhi(xw.y) * d0[3] * __expf(alast - a0[3]));
              sw.z = pk2(bflo(xw.z) * d1[0] * __expf(alast - a1[0]), bfhi(xw.z) * d1[1] * __expf(alast - a1[1])); sw.w = pk2(bflo(xw.w) * d1[2] * __expf(alast - a1[2]), bfhi(xw.w) * d1[3] * __expf(alast - a1[3]));
              const bf16x8 xa = __builtin_bit_cast(bf16x8, sw);
              const bf16x8 bt0 = *(const LAS bf16x8*)(lds + LBT + ((16 * (2 * (w & 1)) + fr) * XT_STR + 32 * ks + 8 * fq) * 2), bt1 = *(const LAS bf16x8*)(lds + LBT + ((16 * (2 * (w & 1) + 1) + fr) * XT_STR + 32 * ks + 8 * fq) * 2);
              s0 = MIX_MFMA(xa, bt0, s0); s1 = MIX_MFMA(xa, bt1, s1); }
          float* ST = (float*)(F.ws + WS_ST) + (size_t)((b * NCH + c) * 8 + h) * 4096 + (16 * pt + 4 * fq) * 64 + 32 * (w & 1) + fr;
#pragma unroll
          for (int j = 0; j < 4; ++j) { ST[j * 64] = s0[j]; ST[j * 64 + 16] = s1[j]; } }
    }
    __syncthreads();
}
__device__ __forceinline__ void state_scan2(Frame& F) {
    const float* ST = (const float*)(F.ws + WS_ST); const float* ACS = (const float*)(F.ws + WS_ACS); bf16* SB = (bf16*)(F.ws + WS_SB);
    for (int idx = F.bid * NTHR + F.tid; idx < NB * 8 * 4096; idx += F.G * NTHR) { const int pn = idx & 4095, h = (idx >> 12) & 7, b = idx >> 15; float cur = 0.f;
#pragma unroll 4
        for (int c = 0; c < NCH; ++c) { const size_t a = (size_t)((b * NCH + c) * 8 + h) * 4096 + pn; const float s = ST[a]; SB[a] = (bf16)f2bf(cur);
            cur = cur * __expf(ACS[(size_t)(b * T_ + c * 128 + 127) * 8 + h]) + s; } }
}
__device__ __forceinline__ void ssd_finish(Frame& F, const Args& A, int l, int unit, bool dry = false) {
    const int g = unit & 1, c = (unit >> 1) & 31, b = unit >> 6; const int row0 = b * T_ + c * 128;
    const int lane = F.lane, w = F.wave, fr = lane & 15, fq = lane >> 4, lrow = row0 + 16 * w + fr;
    const bf16* proj = (const bf16*)(F.ws + WS_PROJ); const bf16* CC = (const bf16*)(F.ws + WS_CC); const bf16* SB = (const bf16*)(F.ws + WS_SB) + (size_t)((b * NCH + c) * 8 + 4 * g) * 4096;
    bf16x8 cf[2];
#pragma unroll
    for (int ks = 0; ks < 2; ++ks) cf[ks] = *(const bf16x8*)(CC + (size_t)lrow * 128 + 64 * g + 32 * ks + 8 * fq);
    const f32x4 acs4 = *(const f32x4*)((const float*)(F.ws + WS_ACS) + (size_t)lrow * 8 + 4 * g);
    bf16* yc = (bf16*)(F.ws + WS_A) + (size_t)lrow * 1024 + 256 * g + 4 * fq; const bf16* zp = proj + (size_t)lrow * NPROJ + PZ + 256 * g + 4 * fq;
    float gy[4][4][4]; float ss = 0.f;
    bf16x8 sf[2][4][2]; v2u yd[2][4], zz[2][4];
#define SSDF_LOAD(buf, r) do { _Pragma("unroll") for (int pt = 0; pt < 4; ++pt) { _Pragma("unroll") for (int ks = 0; ks < 2; ++ks) sf[buf][pt][ks] = *(const bf16x8*)(SB + (size_t)(r) * 4096 + (16 * pt + fr) * 64 + 32 * ks + 8 * fq); \
        yd[buf][pt] = *(const v2u*)(yc + 64 * (r) + 16 * pt); zz[buf][pt] = *(const v2u*)(zp + 64 * (r) + 16 * pt); } } while (0)
    SSDF_LOAD(0, 0);
#pragma unroll
    for (int r = 0; r < 4; ++r) { const float ea = __expf(acs4[r]); const int cur = r & 1;
        if (r < 3) SSDF_LOAD(cur ^ 1, r + 1);
#pragma unroll
        for (int pt = 0; pt < 4; ++pt) { f32x4 acc = {0.f, 0.f, 0.f, 0.f};
#pragma unroll
            for (int ks = 0; ks < 2; ++ks) acc = MIX_MFMA(sf[cur][pt][ks], cf[ks], acc);
            const float y0 = bflo(yd[cur][pt].x) + ea * acc[0], y1 = bfhi(yd[cur][pt].x) + ea * acc[1], y2 = bflo(yd[cur][pt].y) + ea * acc[2], y3 = bfhi(yd[cur][pt].y) + ea * acc[3];
            gy[r][pt][0] = y0 * silu(bflo(zz[cur][pt].x)); gy[r][pt][1] = y1 * silu(bfhi(zz[cur][pt].x)); gy[r][pt][2] = y2 * silu(bflo(zz[cur][pt].y)); gy[r][pt][3] = y3 * silu(bfhi(zz[cur][pt].y));
            ss += (gy[r][pt][0] * gy[r][pt][0] + gy[r][pt][1] * gy[r][pt][1]) + (gy[r][pt][2] * gy[r][pt][2] + gy[r][pt][3] * gy[r][pt][3]); } }
#undef SSDF_LOAD
    ss += __shfl_xor(ss, 16); ss += __shfl_xor(ss, 32);
    const float rs = 1.f / sqrtf(ss * (1.f / 256.f) + RMS_EPS); const float* nw = A.in[I_SSDNW] + l * 512 + 256 * g + 4 * fq;
#pragma unroll
    for (int r = 0; r < 4; ++r)
#pragma unroll
        for (int pt = 0; pt < 4; ++pt) { const f32x4 n4 = *(const f32x4*)(nw + 64 * r + 16 * pt); v2u o; o.x = pk2(gy[r][pt][0] * rs * n4[0], gy[r][pt][1] * rs * n4[1]); o.y = pk2(gy[r][pt][2] * rs * n4[2], gy[r][pt][3] * rs * n4[3]);
            *(v2u*)((dry ? (bf16*)(F.ws + WS_ST) + (size_t)lrow * 512 + 256 * g + 4 * fq : yc) + 64 * r + 16 * pt) = o; }
}
__device__ __forceinline__ void gmlp(Frame& F, const Args& A, int l, int unit) {
    const int row0 = unit * 128; const int lane = F.lane, w = F.wave, fr = lane & 15, fq = lane >> 4;
    const bf16* proj = (const bf16*)(F.ws + WS_PROJ); LAS unsigned char* lds = F.lds;
    { const f32x4 lg = *(const f32x4*)(A.in[I_GMLNG] + l * 256 + 4 * lane), lb = *(const f32x4*)(A.in[I_GMLNB] + l * 256 + 4 * lane);
      v2u wv[16];
#pragma unroll
      for (int i = 0; i < 16; ++i) wv[i] = *(const v2u*)(proj + (size_t)(row0 + 16 * w + i) * NPROJ + PGV + 4 * lane);
#pragma unroll
      for (int i0 = 0; i0 < 16; i0 += 4) { float v[4][4], sm[4], s2[4];
#pragma unroll
          for (int i = 0; i < 4; ++i) { const f32x2 g0 = gelu_pk((f32x2){bflo(wv[i0 + i].x), bfhi(wv[i0 + i].x)}), g1 = gelu_pk((f32x2){bflo(wv[i0 + i].y), bfhi(wv[i0 + i].y)});
              v[i][0] = g0.x; v[i][1] = g0.y; v[i][2] = g1.x; v[i][3] = g1.y; sm[i] = (v[i][0] + v[i][1]) + (v[i][2] + v[i][3]); }
#pragma unroll
          for (int o = 1; o < 64; o <<= 1) {
#pragma unroll
              for (int i = 0; i < 4; ++i) sm[i] += __shfl_xor(sm[i], o); }
#pragma unroll
          for (int i = 0; i < 4; ++i) { const float mean = sm[i] * (1.f / 256.f); s2[i] = 0.f;
#pragma unroll
              for (int k = 0; k < 4; ++k) { v[i][k] -= mean; s2[i] += v[i][k] * v[i][k]; } }
#pragma unroll
          for (int o = 1; o < 64; o <<= 1) {
#pragma unroll
              for (int i = 0; i < 4; ++i) s2[i] += __shfl_xor(s2[i], o); }
#pragma unroll
          for (int i = 0; i < 4; ++i) { const float rstd = 1.f / sqrtf(s2[i] * (1.f / 256.f) + LN_EPS); const int sr = 16 * w + i0 + i;
#pragma unroll
              for (int k = 0; k < 4; ++k) *(LAS bf16*)(lds + ((4 * lane + k) * XT_STR + sr) * 2) = (bf16)f2bf(v[i][k] * rstd * lg[k] + lb[k]); } } }
    __syncthreads();
    const int trow = row0 + 16 * w + fr; const bf16* GMW = (const bf16*)(F.ws + WS_GMW) + (size_t)l * 4 * 128 * 128;
    bf16* yc = (bf16*)(F.ws + WS_A) + (size_t)trow * 1024 + 768 + 4 * fq; const bf16* gu = proj + (size_t)trow * NPROJ + PGU + 4 * fq;
#pragma unroll 1
    for (int gi = 0; gi < 4; ++gi) { bf16x8 wf[4];
#pragma unroll
        for (int ks = 0; ks < 4; ++ks) wf[ks] = *(const bf16x8*)(GMW + ((size_t)gi * 128 + 16 * w + fr) * 128 + 32 * ks + 8 * fq);
        const float bs = A.in[I_GMBS][(l * 4 + gi) * 128 + 16 * w + fr];
#pragma unroll
        for (int c4 = 0; c4 < 4; ++c4) { const int ct = 4 * gi + c4; f32x4 acc = {0.f, 0.f, 0.f, 0.f};
#pragma unroll
            for (int ks = 0; ks < 4; ++ks) if (2 * ks <= w) { const bf16x8 vf = *(const LAS bf16x8*)(lds + ((16 * ct + fr) * XT_STR + 32 * ks + 8 * fq) * 2); acc = MIX_MFMA(vf, wf[ks], acc); }
            const v2u gw = *(const v2u*)(gu + 16 * ct); const f32x2 g0 = gelu_pk((f32x2){bflo(gw.x), bfhi(gw.x)}), g1 = gelu_pk((f32x2){bflo(gw.y), bfhi(gw.y)});
            v2u o; o.x = pk2(g0.x * (acc[0] + bs), g0.y * (acc[1] + bs)); o.y = pk2(g1.x * (acc[2] + bs), g1.y * (acc[3] + bs)); *(v2u*)(yc + 16 * ct) = o; } }
    __syncthreads();
}
#undef MIX_MFMA
}
__device__ __forceinline__ void moe_offsets(Frame& F, int (&poff)[9]) {
    int acc = 0;
#pragma unroll
    for (int e = 0; e < 8; ++e) { const int c = (int)__hip_atomic_load(F.ctl + CW_CNT + e * 64, RLX_AGENT); poff[e] = acc; acc += (c + 255) >> 8; }
    poff[8] = acc;
}
__device__ __forceinline__ void moe_permute(Frame& F) {
    int poff[9]; moe_offsets(F, poff);
    const int* re = (const int*)(F.ws + WS_ROUTE); int* rs = (int*)(F.ws + WS_ROUTE) + 2 * M_;
    const bf16* hb = (const bf16*)(F.ws + WS_A); unsigned char* hp = F.ws + WS_HP;
    const int gwv = F.bid * NWAVES + F.wave, NGW = F.G * NWAVES;
    for (int m = gwv; m < M_; m += NGW) {
        const GAS v4u* src = (const GAS v4u*)(hb + (size_t)m * 1024);
        const v4u c0 = src[2 * F.lane], c1 = src[2 * F.lane + 1]; v4u o;
        o.x = pg8::fp8x4((f32x4){bflo(c0.x), bfhi(c0.x), bflo(c0.y), bfhi(c0.y)}); o.y = pg8::fp8x4((f32x4){bflo(c0.z), bfhi(c0.z), bflo(c0.w), bfhi(c0.w)});
        o.z = pg8::fp8x4((f32x4){bflo(c1.x), bfhi(c1.x), bflo(c1.y), bfhi(c1.y)}); o.w = pg8::fp8x4((f32x4){bflo(c1.z), bfhi(c1.z), bflo(c1.w), bfhi(c1.w)});
#pragma unroll
        for (int k = 0; k < 2; ++k) { const int e = re[k * M_ + m], sl = rs[k * M_ + m]; int po = 0;
#pragma unroll
            for (int q = 0; q < 8; ++q) po = (e == q) ? poff[q] : po;
            const int prow = po * 256 + sl;
            ((GAS v4u*)(hp + (size_t)prow * 1024))[F.lane] = o;
            if (F.lane == 0) rs[k * M_ + m] = prow; }
    }
}
__device__ __forceinline__ void ln_moe_final(Frame& F, const Args& A, const float* g, const float* bt, int ls, bool dry) {
    const int gwv = F.bid * NWAVES + F.wave, NGW = F.G * NWAVES;
    const float* mod = (const float*)(F.ws + WS_MOD); const int* rs = (const int*)(F.ws + WS_ROUTE) + 2 * M_; const float* rg = (const float*)(F.ws + WS_ROUTE) + 4 * M_;
    const bf16* yp = (const bf16*)(F.ws + WS_YP);
    for (int m = gwv * 2; m < M_; m += NGW * 2) { f32x4 x[2][4];
#pragma unroll
        for (int i = 0; i < 2; ++i) { const int p0 = rs[m + i], p1 = rs[M_ + m + i]; const float g0 = rg[m + i], g1 = rg[M_ + m + i];
            const GAS f32x4* xr = (const GAS f32x4*)(F.out + (size_t)(m + i) * 1024) + F.lane; const GAS v2u* y0 = (const GAS v2u*)(yp + (size_t)p0 * 1024) + F.lane; const GAS v2u* y1 = (const GAS v2u*)(yp + (size_t)p1 * 1024) + F.lane;
            const float* gt = mod + ((size_t)ls * 8 + ((m + i) >> 12)) * 3072 + 2048;
#pragma unroll
            for (int j = 0; j < 4; ++j) { const f32x4 xv = xr[64 * j], gv = ((const GAS f32x4*)gt)[F.lane + 64 * j]; const v2u a = y0[64 * j], b = y1[64 * j];
                const f32x4 yv = {g0 * bflo(a.x) + g1 * bflo(b.x), g0 * bfhi(a.x) + g1 * bfhi(b.x), g0 * bflo(a.y) + g1 * bflo(b.y), g0 * bfhi(a.y) + g1 * bfhi(b.y)};
                x[i][j] = xv * DN_ALPHA + (gv + 1.f) * yv; } }
        ln_rows2_loaded(g, bt, x, F.lane);
#pragma unroll
        for (int i = 0; i < 2; ++i) store_x_h(x[i], (dry ? (float*)(F.ws + WS_PROJ) : F.out) + (size_t)(m + i) * 1024, nullptr, mod, F.lane);
    }
}
constexpr int N_PHASES = 21;
#define MODP ((const float*)(F.ws + WS_MOD))
#define HA ((bf16*)(F.ws + WS_A))
#define PROJ ((bf16*)(F.ws + WS_PROJ))
#ifndef PHMASK
#define PHMASK 0x7FFF
#endif
#define EN(k) (((PHMASK) >> (k)) & 1)
#ifndef PROBE_SITE
#define PROBE_SITE -1
#endif
#define NREP(k) ((PROBE_SITE) == (k) ? 2 : 1)
__global__ void __launch_bounds__(NTHR, 2) fwd_kernel(Args args) {
    extern __shared__ __attribute__((aligned(16))) unsigned char lds[];
    Frame F0;
    F0.lds = (LAS unsigned char*)lds; F0.tid = threadIdx.x; F0.lane = F0.tid & 63; F0.wave = __builtin_amdgcn_readfirstlane(F0.tid >> 6);
    F0.G = gridDim.x; F0.bid = blockIdx.x; F0.ws = args.ws; F0.ctl = (gu32*)(args.ws + WS_CTL); F0.out = args.out;
    for (int u = F0.tid; u < (LDS_BYTES - LDSCTL_OFF) / 4; u += NTHR) ((LAS unsigned*)(F0.lds + LDSCTL_OFF))[u] = 0u;
    __syncthreads();
#if N_LAUNCH_MODE == 0
    XcdBarrier bar = xcd_barrier_post((unsigned*)(F0.ctl + CW_BAR), (volatile LAS unsigned*)(F0.lds + MISC_OFF) + 8);
#define GRID_BAR() do { const Frame Fb = phase_frame(F0); xcd_barrier(bar, Fb.tid == 0); } while (0)
#else
#define GRID_BAR() do {} while (0)
#endif
    const int lo = args.ph_lo, hi = args.ph_hi;
#define IN(k) (lo <= (k) && (k) < hi)
#define SEAM(k) do { if (IN(k) && IN((k) + 1)) GRID_BAR(); } while (0)

    if (EN(0) && IN(0)) for (int rep = 0; rep < NREP(0); ++rep) { Frame F = phase_frame(F0); const bool dry = rep > 0; (void)dry; p0a(F, args); } SEAM(0);
    if (EN(1) && IN(1)) for (int rep = 0; rep < NREP(1); ++rep) { Frame F = phase_frame(F0); const bool dry = rep > 0; (void)dry; ln_phase(F, args, args.in[I_X], args.in[I_LN0G], args.in[I_LN0B], 0, false, false); } SEAM(1);

    for (int l = 0; l < 2; ++l) {
        const int base = l == 0 ? 2 : 11;
        if (EN(2) && IN(base + 0)) for (int rep = 0; rep < NREP(2); ++rep) { Frame F = phase_frame(F0); const bool dry = rep > 0; (void)dry;
            pg8::Gemm g{HA, (const bf16*)(F.ws + WS_WIN + l * WIN_BYTES), M_, NPROJ, 1024, 1024, 0, 0}; pg8::StaticOrder S; S.init(M_, NPROJ, F.G, F.bid);
            pg8::EpiProj E{PROJ, (float*)(F.ws + WS_DTV)};
            pg8::gemm_phase<pg8::EpiProj, pg8::StaticOrder, true, true>(F.lds + RING_OFF, g, S, E, F.tid);
        } SEAM(base + 0);
#if PROBE_SITE == 100
        for (int xb = 0; xb < 8; ++xb) GRID_BAR();
#endif
        if (EN(3) && IN(base + 1)) for (int rep = 0; rep < NREP(3); ++rep) { Frame F = phase_frame(F0); const bool dry = rep > 0; (void)dry;
            token_local(F);
#ifdef MIX_NAIVE
            for (int u = F.bid; u < NB * NCH * 8; u += F.G) ssd_chunk_naive(F, args, l, u);
            for (int u = F.bid; u < NB * NCH; u += F.G) gmlp_naive(F, args, l, u);
#else
            for (int u = F.bid; u < NB * NCH * 2; u += F.G) mix::ssd_chunk(F, args, l, u);
            for (int u = F.bid; u < NB * NCH; u += F.G) mix::gmlp(F, args, l, u);
#endif
        } SEAM(base + 1);
        if (EN(4) && IN(base + 2)) for (int rep = 0; rep < NREP(4); ++rep) { Frame F = phase_frame(F0); const bool dry = rep > 0; (void)dry;
#ifdef MIX_NAIVE
            state_scan(F);
#else
            mix::state_scan2(F);
#endif
            { pg8::Gemm g{PROJ + PQ, (const bf16*)(F.ws + WS_WQB + l * WQB_BYTES), M_, 1024, 256, NPROJ, WS_WKVB - WS_WQB, (size_t)(PKV - PQ) * 2}; pg8::QkvOrder S; S.init(M_, 1024, F.G, F.bid);
              pg8::EpiQKV E{{(bf16*)(F.ws + WS_Q), (const float*)(F.ws + WS_RSTD), (const float*)(F.ws + WS_ROPE), (const float*)(F.ws + WS_ROPE) + 4096 * 16, QSCALE},
                            {(bf16*)(F.ws + WS_KN), (bf16*)(F.ws + WS_V), (const float*)(F.ws + WS_RSTD) + M_}};
              pg8::gemm_phase<pg8::EpiQKV, pg8::QkvOrder, true, true>(F.lds + RING_OFF, g, S, E, F.tid); }
        } SEAM(base + 2);
        if (EN(5) && IN(base + 3)) for (int rep = 0; rep < NREP(5); ++rep) { Frame F = phase_frame(F0); const bool dry = rep > 0; (void)dry;
#ifdef MIX_NAIVE
            for (int u = F.bid; u < NB * NCH * 2; u += F.G) ssd_finish_naive(F, args, l, u);
#else
#if PROBE_SITE == 55
            for (int u = F.bid; u < NB * NCH * 2; u += F.G) mix::ssd_finish(F, args, l, u, true);
#endif
            if (!dry) for (int u = F.bid; u < NB * NCH * 2; u += F.G) mix::ssd_finish(F, args, l, u);
#endif
#ifdef ATTN_NAIVE
            for (int u = F.bid; u < NB * 4 * 64; u += F.G) attn_naive(F, u);
#else
            for (int v = F.bid; v < NB * 4 * 8; v += F.G) { const int bh = v >> 3, s = v & 7; att::attn_unit(F, bh >> 2, bh & 3, s); att::attn_unit(F, bh >> 2, bh & 3, 15 - s); }
#endif
        } SEAM(base + 3);
        if (EN(6) && IN(base + 4)) for (int rep = 0; rep < NREP(6); ++rep) { Frame F = phase_frame(F0); const bool dry = rep > 0; (void)dry;
            pg8::Gemm g{HA, (const bf16*)(F.ws + WS_WOUT + l * WOUT_BYTES), M_, 1024, 1024, 1024, 0, 0}; pg8::StaticOrder S; S.init(M_, 1024, F.G, F.bid);
            pg8::EpiResid E{F.out, MODP + (size_t)((l * 2 + 0) * 8) * 3072 + 2048, nullptr, nullptr, DN_ALPHA, dry, 1.f};
            pg8::gemm_phase<pg8::EpiResid, pg8::StaticOrder, true, true>(F.lds + RING_OFF, g, S, E, F.tid);
        } SEAM(base + 4);
        if (EN(7) && IN(base + 5)) for (int rep = 0; rep < NREP(7); ++rep) { Frame F = phase_frame(F0); const bool dry = rep > 0; (void)dry; ln_phase(F, args, F.out, args.in[I_PLG] + (l * 2 + 0) * 1024, args.in[I_PLB] + (l * 2 + 0) * 1024, l * 2 + 1, l == 1, dry); } SEAM(base + 5);
        if (l == 0) {
            if (EN(9) && IN(base + 6)) for (int rep = 0; rep < NREP(9); ++rep) { Frame F = phase_frame(F0);
                pg8::Gemm g{HA, (const bf16*)(F.ws + WS_W13), M_, 5632, 1024, 1024, 0, 0}; pg8::StaticOrder S; S.init(M_, 5632, F.G, F.bid);
                pg8::EpiSwiGLU E{(void*)(F.ws + WS_ACT), FF, 1.f, 0.f};
                pg8::gemm_phase<pg8::EpiSwiGLU, pg8::StaticOrder, true, true, 2>(F.lds + RING_OFF, g, S, E, F.tid);
            } SEAM(base + 6);
            if (EN(10) && IN(base + 7)) for (int rep = 0; rep < NREP(10); ++rep) { Frame F = phase_frame(F0); const bool dry = rep > 0;
                pg8::Gemm g{(const bf16*)(F.ws + WS_ACT), (const bf16*)(F.ws + WS_W2), M_, 1024, FF, FF, 0, 0}; pg8::StaticOrder S; S.init(M_, 1024, F.G, F.bid);
                pg8::EpiResid E{F.out, MODP + (size_t)((l * 2 + 1) * 8) * 3072 + 2048, nullptr, nullptr, DN_ALPHA, dry, 1.f};
                pg8::gemm_phase<pg8::EpiResid, pg8::StaticOrder, true, true, 2>(F.lds + RING_OFF, g, S, E, F.tid);
            } SEAM(base + 7);
            if (EN(11) && IN(base + 8)) for (int rep = 0; rep < NREP(11); ++rep) { Frame F = phase_frame(F0); const bool dry = rep > 0;
                ln_phase(F, args, F.out, args.in[I_PLG] + (l * 2 + 1) * 1024, args.in[I_PLB] + (l * 2 + 1) * 1024, 2, false, dry); } SEAM(base + 8);
        } else {
            if (EN(8) && IN(base + 6)) for (int rep = 0; rep < NREP(8); ++rep) { Frame F = phase_frame(F0); moe_permute(F); } SEAM(base + 6);
            if (EN(12) && IN(base + 7)) for (int rep = 0; rep < NREP(12); ++rep) { Frame F = phase_frame(F0);
                pg8::MoeOrder S; moe_offsets(F, S.poff); const int npan = S.poff[8]; S.init(npan * 256, 5632, F.G, F.bid);
                pg8::Gemm g{(const bf16*)(F.ws + WS_HP), (const bf16*)(F.ws + WS_MW13), npan * 256, 5632, 1024, 1024, W13_BYTES / 2, 0};
                pg8::EpiSwiGLU E{(void*)(F.ws + WS_ACTM), FF, 1.f / 32.f, 8.f};
                pg8::gemm_phase<pg8::EpiSwiGLU, pg8::MoeOrder, true, true, 1>(F.lds + RING_OFF, g, S, E, F.tid);
            } SEAM(base + 7);
            if (EN(13) && IN(base + 8)) for (int rep = 0; rep < NREP(13); ++rep) { Frame F = phase_frame(F0);
                pg8::MoeOrder S; moe_offsets(F, S.poff); const int npan = S.poff[8]; S.init(npan * 256, 1024, F.G, F.bid);
                pg8::Gemm g{(const bf16*)(F.ws + WS_ACTM), (const bf16*)(F.ws + WS_MW2), npan * 256, 1024, FF, FF, W2_BYTES / 2, 0};
                pg8::EpiY E{(bf16*)(F.ws + WS_YP), 1024, 1.f / 1024.f};
                pg8::gemm_phase<pg8::EpiY, pg8::MoeOrder, true, true, 1>(F.lds + RING_OFF, g, S, E, F.tid);
            } SEAM(base + 8);
            if (EN(14) && IN(base + 9)) for (int rep = 0; rep < NREP(14); ++rep) { Frame F = phase_frame(F0); const bool dry = rep > 0;
                ln_moe_final(F, args, args.in[I_PLG] + (l * 2 + 1) * 1024, args.in[I_PLB] + (l * 2 + 1) * 1024, l * 2 + 1, dry); }
        }
    }
}

extern "C" void kernel_launch(void* const* d_in, const int* in_sizes, int n_in, void* d_out, int out_size, void* d_ws, size_t ws_size, hipStream_t stream) {
    static int grid = 0;
    if (grid == 0) {
        if (n_in != 31 || out_size != M_ * D_ || ws_size < WS_END) { fprintf(stderr, "kernel_launch: unexpected shapes (n_in %d, out %d, ws %zu)\n", n_in, out_size, ws_size); grid = -1; return; }
        int dev = 0, cus = 0;
        if (hipGetDevice(&dev) != hipSuccess || hipDeviceGetAttribute(&cus, hipDeviceAttributeMultiprocessorCount, dev) != hipSuccess) { grid = -1; return; }
        if (hipFuncSetAttribute((const void*)fwd_kernel, hipFuncAttributeMaxDynamicSharedMemorySize, LDS_BYTES) != hipSuccess) { fprintf(stderr, "kernel_launch: hipFuncSetAttribute failed\n"); grid = -1; return; }
        int per_cu = 0;
        if (hipOccupancyMaxActiveBlocksPerMultiprocessor(&per_cu, (const void*)fwd_kernel, NTHR, LDS_BYTES) != hipSuccess || per_cu < 1) fprintf(stderr, "kernel_launch: occupancy query reports %d\n", per_cu);
        (void)hipGetLastError();
        grid = cus;
    }
    if (grid < 0) return;
    (void)hipMemsetAsync((char*)d_ws + WS_CTL, 0, CTL_ZERO_BYTES, stream);
    Args a{};
    for (int i = 0; i < 31; ++i) a.in[i] = (const float*)d_in[i];
    a.out = (float*)d_out; a.ws = (unsigned char*)d_ws;
#if N_LAUNCH_MODE == 0
    a.ph_lo = 0; a.ph_hi = N_PHASES;
    hipLaunchKernelGGL(fwd_kernel, dim3(grid), dim3(NTHR), LDS_BYTES, stream, a);
#else
    for (int p = 0; p < N_PHASES; ++p) { a.ph_lo = p; a.ph_hi = p + 1; hipLaunchKernelGGL(fwd_kernel, dim3(grid), dim3(NTHR), LDS_BYTES, stream, a); }
#endif
}
```

```cpp
#include <hip/hip_runtime.h>
#include <cstdio>
#include <cstdint>
#ifndef MOE_FP8
#define MOE_FP8 1
#endif
#define DENSE_FP8 0
#ifndef N_LAUNCH_MODE
#define N_LAUNCH_MODE 0
#endif
namespace pg8 {
#define PG8_LAS __attribute__((address_space(3)))
typedef unsigned short bf16_t;
typedef short bf16x8 __attribute__((ext_vector_type(8)));
typedef float f32x4 __attribute__((ext_vector_type(4)));
typedef unsigned u32x4 __attribute__((ext_vector_type(4)));
typedef int i32x4 __attribute__((ext_vector_type(4)));
typedef int i32x8 __attribute__((ext_vector_type(8)));
constexpr int BM = 256, BK = 64, HALF = 128, HTB = HALF * BK * 2  , STAGE_BYTES = 8 * HTB, NXCD = 8, WGM = 8;

__host__ __device__ __forceinline__ int lds_byte(int r, int c) { const int st = (r >> 4) * 2 + (c >> 5), rr = r & 15, cc = c & 31, ob = rr * 64 + cc * 2; return st * 1024 + (ob ^ (((ob >> 9) & 1) << 5)); }
__host__ __device__ __forceinline__ void stage_rc(int b, int& R, int& C) { const int st = b / 1024, sb = b % 1024, swz = sb ^ (((sb >> 9) & 1) << 5); R = (st >> 1) * 16 + swz / 64; C = (st & 1) * 32 + (swz % 64) / 2; }
__host__ __device__ __forceinline__ int perm32(int rho) { const int n = rho >> 4, i = rho & 15; return 8 * (i >> 2) + 4 * n + (i & 3); }

struct Unit { int pm, pn, e; };
struct Gemm { const bf16_t* A; const bf16_t* Bt; int M, N, K, lda; size_t estride, aestride; };

struct StaticOrder {
    int nM, nN, nwg, G, c;
    __host__ __device__ void init(int M, int N, int G_, int c_) { nM = M / BM; nN = N / BM; nwg = nM * nN; G = G_; c = c_; }
    __host__ __device__ bool next(int i, Unit& u) const {
        const long L = (long)i * G + c; if (L >= nwg) return false;
        int wgid = (int)L; { const int q = nwg / NXCD, r = nwg % NXCD, xcd = wgid % NXCD, off = wgid / NXCD; wgid = (xcd < r ? xcd * (q + 1) : r * (q + 1) + (xcd - r) * q) + off; }
        const int nig = WGM * nN, gid = wgid / nig, fm = gid * WGM, gsz = (nM - fm) < WGM ? (nM - fm) : WGM;
        u.pm = fm + ((wgid % nig) % gsz); u.pn = (wgid % nig) / gsz; u.e = 0; return true;
    }
    __device__ __forceinline__ void a_ready(const Unit&) const {}
    __device__ __forceinline__ void done(const Unit&) const {}
};
struct MoeOrder : StaticOrder {
    int poff[9];
    __device__ bool next(int i, Unit& u) const {
        if (!StaticOrder::next(i, u)) return false;
        int e = 0;
#pragma unroll
        for (int k = 1; k < 8; ++k) e += (u.pm >= poff[k]) ? 1 : 0;
        u.e = e; return true;
    }
};
struct QkvOrder : StaticOrder {
    __device__ bool next(int i, Unit& u) const { if (!StaticOrder::next(i, u)) return false; u.e = u.pn >> 1; u.pn &= 1; return true; }
};
__device__ __forceinline__ unsigned cvt_pk_bf16(float lo, float hi) { unsigned r; asm volatile("v_cvt_pk_bf16_f32 %0, %1, %2" : "=v"(r) : "v"(lo), "v"(hi)); return r; }
typedef float f32x2 __attribute__((ext_vector_type(2)));
__device__ __forceinline__ u32x4 pack8(const f32x4 v0, const f32x4 v1) { u32x4 w; w.x = cvt_pk_bf16(v0[0], v0[1]); w.y = cvt_pk_bf16(v0[2], v0[3]); w.z = cvt_pk_bf16(v1[0], v1[1]); w.w = cvt_pk_bf16(v1[2], v1[3]); return w; }
__device__ __forceinline__ float silu_f(float a) { return a * __builtin_amdgcn_rcpf(1.f + __expf(-a)); }
__device__ __forceinline__ float q8(float x) { x = fminf(fmaxf(x, -448.f), 448.f); const int p = __builtin_amdgcn_cvt_pk_fp8_f32(x, x, 0, false); return __builtin_amdgcn_cvt_f32_fp8(p, 0); }
__device__ __forceinline__ float clamp8(float x) { return fminf(fmaxf(x, -448.f), 448.f); }
__device__ __forceinline__ unsigned fp8x4(const f32x4 v) { int p = __builtin_amdgcn_cvt_pk_fp8_f32(clamp8(v[0]), clamp8(v[1]), 0, false); p = __builtin_amdgcn_cvt_pk_fp8_f32(clamp8(v[2]), clamp8(v[3]), p, true); return (unsigned)p; }

struct EpiProj {
    static constexpr bool PERM = true, AFTER_DRAIN = false;
    bf16_t* O; float* dtv;
    __device__ __forceinline__ void operator()(const f32x4 (&acc)[2][2][4][2], const Unit& u, int wr, int wc, int fr, int fq) const {
        const int row0 = u.pm * BM + wr * 64 + fr, col0 = u.pn * BM + wc * 32 + 8 * fq;
#pragma unroll
        for (int ai = 0; ai < 2; ++ai)
#pragma unroll
            for (int m = 0; m < 4; ++m) { bf16_t* rowp = O + (size_t)(row0 + ai * HALF + m * 16) * 2304 + col0;
#pragma unroll
                for (int bj = 0; bj < 2; ++bj) *(u32x4*)(rowp + bj * HALF) = pack8(acc[ai][bj][m][0], acc[ai][bj][m][1]); }
        if (u.pn == 6 && wc == 1 && fq == 0) {
#pragma unroll
            for (int ai = 0; ai < 2; ++ai)
#pragma unroll
                for (int m = 0; m < 4; ++m) { float* dp = dtv + (size_t)(row0 + ai * HALF + m * 16) * 8; *(f32x4*)dp = acc[ai][1][m][0]; *(f32x4*)(dp + 4) = acc[ai][1][m][1]; }
        }
    }
};
struct EpiQ {
    static constexpr bool PERM = true, AFTER_DRAIN = false;
    bf16_t* Q; const float* rstd; const float* ropec; const float* ropes; float qscale;
    __device__ __forceinline__ void operator()(const f32x4 (&acc)[2][2][4][2], const Unit& u, int wr, int wc, int fr, int fq) const {
        const int row0 = u.pm * BM + wr * 64 + fr;
#pragma unroll
        for (int bj = 0; bj < 2; ++bj) { const int lc = bj * HALF + wc * 32 + 8 * fq; if (lc >= 192) continue;
            const int hc = lc % 96, g = (hc - 64) >> 3;
#pragma unroll
            for (int ai = 0; ai < 2; ++ai)
#pragma unroll
                for (int m = 0; m < 4; ++m) { const int row = row0 + ai * HALF + m * 16; const float s = rstd[row] * qscale; f32x4 v0 = acc[ai][bj][m][0] * s, v1 = acc[ai][bj][m][1] * s;
                    if (hc >= 64) { const int t = row & 4095; const f32x4 c4 = *(const f32x4*)(ropec + t * 16 + 4 * g), s4 = *(const f32x4*)(ropes + t * 16 + 4 * g);
                        const f32x4 o0 = v0 * c4 - v1 * s4, o1 = v0 * s4 + v1 * c4; v0 = o0; v1 = o1; }
                    *(u32x4*)(Q + (size_t)row * 384 + u.pn * 192 + lc) = pack8(v0, v1); asm volatile("" ::: "memory"); } }
    }
};
struct EpiKV {
    static constexpr bool PERM = true, AFTER_DRAIN = false;
    bf16_t* KN; bf16_t* V; const float* rstd;
    __device__ __forceinline__ void operator()(const f32x4 (&acc)[2][2][4][2], const Unit& u, int wr, int wc, int fr, int fq) const {
        const int row0 = u.pm * BM + wr * 64 + fr, col0 = wc * 32 + 8 * fq; bf16_t* base = u.pn == 0 ? KN : V;
#pragma unroll
        for (int ai = 0; ai < 2; ++ai)
#pragma unroll
            for (int m = 0; m < 4; ++m) { const int row = row0 + ai * HALF + m * 16; const float s = rstd[row];
#pragma unroll
                for (int bj = 0; bj < 2; ++bj) *(u32x4*)(base + (size_t)row * 256 + col0 + bj * HALF) = pack8(acc[ai][bj][m][0] * s, acc[ai][bj][m][1] * s); }
    }
};
struct EpiQKV {
    static constexpr bool PERM = true, AFTER_DRAIN = false;
    EpiQ q; EpiKV kv;
    __device__ __forceinline__ void operator()(const f32x4 (&acc)[2][2][4][2], const Unit& u, int wr, int wc, int fr, int fq) const { if (u.e == 0) q(acc, u, wr, wc, fr, fq); else kv(acc, u, wr, wc, fr, fq); }
};
struct EpiSwiGLU {
    static constexpr bool PERM = true, AFTER_DRAIN = false;
    void* O; int ldo; float ain, qs;
    __device__ __forceinline__ void operator()(const f32x4 (&acc)[2][2][4][2], const Unit& u, int wr, int wc, int fr, int fq) const {
        const int row0 = u.pm * BM + wr * 64 + fr, col0 = u.pn * HALF + wc * 32 + 8 * fq;
#pragma unroll
        for (int ai = 0; ai < 2; ++ai)
#pragma unroll
            for (int m = 0; m < 4; ++m) { const f32x4 a0 = acc[ai][0][m][0] * ain, a1 = acc[ai][0][m][1] * ain, g0 = acc[ai][1][m][0] * ain, g1 = acc[ai][1][m][1] * ain;
                const f32x4 r0 = {silu_f(a0[0]) * g0[0], silu_f(a0[1]) * g0[1], silu_f(a0[2]) * g0[2], silu_f(a0[3]) * g0[3]}, r1 = {silu_f(a1[0]) * g1[0], silu_f(a1[1]) * g1[1], silu_f(a1[2]) * g1[2], silu_f(a1[3]) * g1[3]};
                const size_t off = (size_t)(row0 + ai * HALF + m * 16) * ldo + col0;
                if (qs == 0.f) *(u32x4*)((bf16_t*)O + off) = pack8(r0, r1);
                else { typedef unsigned u32x2 __attribute__((ext_vector_type(2))); u32x2 w; w.x = fp8x4(r0 * qs); w.y = fp8x4(r1 * qs); *(u32x2*)((unsigned char*)O + off) = w; } }
    }
};
struct EpiY {
    static constexpr bool PERM = true, AFTER_DRAIN = false;
    bf16_t* O; int ldo; float ascale;
    __device__ __forceinline__ void operator()(const f32x4 (&acc)[2][2][4][2], const Unit& u, int wr, int wc, int fr, int fq) const {
        const int row0 = u.pm * BM + wr * 64 + fr, col0 = u.pn * BM + wc * 32 + 8 * fq;
#pragma unroll
        for (int ai = 0; ai < 2; ++ai)
#pragma unroll
            for (int m = 0; m < 4; ++m) { bf16_t* rowp = O + (size_t)(row0 + ai * HALF + m * 16) * ldo + col0;
#pragma unroll
                for (int bj = 0; bj < 2; ++bj) *(u32x4*)(rowp + bj * HALF) = pack8(acc[ai][bj][m][0] * ascale, acc[ai][bj][m][1] * ascale); }
    }
};
struct EpiResid {
    static constexpr bool PERM = true, AFTER_DRAIN = false;
    bf16_t* X; const float* gate; float xscale; bool dry; float ascale;
    __device__ __forceinline__ void operator()(const f32x4 (&acc)[2][2][4][2], const Unit& u, int wr, int wc, int fr, int fq) const {
        const int row0 = u.pm * BM + wr * 64 + fr, col0 = u.pn * BM + wc * 32 + 8 * fq;
        const float* gp = gate + (size_t)((u.pm * BM) >> 12) * 3072 + col0;
        f32x4 gv[2][2];
#pragma unroll
        for (int bj = 0; bj < 2; ++bj) { gv[bj][0] = *(const f32x4*)(gp + bj * HALF) + 1.f; gv[bj][1] = *(const f32x4*)(gp + bj * HALF + 4) + 1.f; }
#pragma unroll
        for (int ai = 0; ai < 2; ++ai)
#pragma unroll
            for (int m = 0; m < 4; ++m) { bf16_t* xp = X + (size_t)(row0 + ai * HALF + m * 16) * 1024 + col0;
#pragma unroll
                for (int bj = 0; bj < 2; ++bj) { const u32x4 o = *(const u32x4*)(xp + bj * HALF);
                    const f32x4 o0 = {__uint_as_float(o.x << 16), __uint_as_float(o.x & 0xffff0000u), __uint_as_float(o.y << 16), __uint_as_float(o.y & 0xffff0000u)}, o1 = {__uint_as_float(o.z << 16), __uint_as_float(o.z & 0xffff0000u), __uint_as_float(o.w << 16), __uint_as_float(o.w & 0xffff0000u)};
                    if (!dry) *(u32x4*)(xp + bj * HALF) = pack8(o0 * xscale + gv[bj][0] * (acc[ai][bj][m][0] * ascale), o1 * xscale + gv[bj][1] * (acc[ai][bj][m][1] * ascale)); } }
    }
};
template <class Epi, class Sched, bool ALIGN_EPI = false, bool SP2 = false, int ES = 2  >
__device__ __forceinline__ void gemm_phase(PG8_LAS unsigned char* lds, const Gemm g, const Sched& S, const Epi& E, int tid) {
    const int wid = __builtin_amdgcn_readfirstlane(tid >> 6), lane = tid & 63, wr = wid >> 2, wc = wid & 3, fr = lane & 15, fq = lane >> 4;
    int K = g.K; asm volatile("" : "+s"(K));
    const int nt = (K * ES) / (BK * 2);
    unsigned voffA[2], voffB[2];
#pragma unroll
    for (int i = 0; i < 2; ++i) { int R, C; stage_rc(tid * 16 + i * 8192, R, C); const int Rb = Epi::PERM ? ((R & ~31) + perm32(R & 31)) : R;
        voffA[i] = (unsigned)(R * g.lda * ES + C * 2); voffB[i] = (unsigned)(Rb * K * ES + C * 2); }
    const size_t kstep = (size_t)(BK * 2);
    const size_t hstepA = (size_t)HALF * g.lda * ES, hstepB = (size_t)HALF * K * ES;
    const size_t tstepA = 2 * hstepA, tstepB = 2 * hstepB;
    const unsigned ldsw = (unsigned)wid * 1024u;
    const int aoff = lds_byte(wr * 64 + fr, fq * 8), boff = lds_byte(wc * 32 + fr, fq * 8);
#define PG8_SA(b, h) (((b) * 2 + (h)) * HTB)
#define PG8_SB(b, h) ((4 + (b) * 2 + (h)) * HTB)
#define PG8_STAGE(bufoff, gbase, voff) do { _Pragma("unroll") for (int _i = 0; _i < 2; ++_i) \
        __builtin_amdgcn_global_load_lds((const unsigned*)((const char*)(gbase) + (voff)[_i]), (PG8_LAS unsigned*)(lds + (bufoff) + ldsw + _i * 8192), 16, 0, 0); } while (0)
#define PG8_LDA(dst, b, h) do { _Pragma("unroll") for (int m = 0; m < 4; ++m) _Pragma("unroll") for (int k = 0; k < 2; ++k) dst[m][k] = *(const PG8_LAS bf16x8*)(lds + PG8_SA(b, h) + aoff + m * 2048 + k * 1024); } while (0)
#define PG8_LDB(dst, b, h) do { _Pragma("unroll") for (int n = 0; n < 2; ++n) _Pragma("unroll") for (int k = 0; k < 2; ++k) dst[n][k] = *(const PG8_LAS bf16x8*)(lds + PG8_SB(b, h) + boff + n * 2048 + k * 1024); } while (0)
#define PG8_CAT(x) __builtin_shufflevector(__builtin_bit_cast(i32x4, (x)[0]), __builtin_bit_cast(i32x4, (x)[1]), 0, 1, 2, 3, 4, 5, 6, 7)
#define PG8_MMA(ai, bj, At, Bt) do { __builtin_amdgcn_s_setprio(1); if constexpr (ES == 2) { _Pragma("unroll") for (int m = 0; m < 4; ++m) _Pragma("unroll") for (int n = 0; n < 2; ++n) _Pragma("unroll") for (int k = 0; k < 2; ++k) \
        acc[ai][bj][m][n] = __builtin_amdgcn_mfma_f32_16x16x32_bf16(Bt[n][k], At[m][k], acc[ai][bj][m][n], 0, 0, 0); } else { _Pragma("unroll") for (int m = 0; m < 4; ++m) _Pragma("unroll") for (int n = 0; n < 2; ++n) \
        asm volatile("v_mfma_scale_f32_16x16x128_f8f6f4 %0, %1, %2, %0, %3, %3 op_sel_hi:[0,0,0]" : "+v"(acc[ai][bj][m][n]) : "v"(PG8_CAT(Bt[n])), "v"(PG8_CAT(At[m])), "v"(sc1)); } __builtin_amdgcn_s_setprio(0); } while (0)
#define PG8_WAIT_V(n) asm volatile("s_waitcnt vmcnt(" #n ")" ::: "memory")
#define PG8_WAIT_L(n) asm volatile("s_waitcnt lgkmcnt(" #n ")" ::: "memory")
#define PG8_BAR __builtin_amdgcn_s_barrier()
#define PG8_SCHED __builtin_amdgcn_sched_barrier(0)
    Unit cur, nxt; int ui = 0;
    if (!S.next(0, cur)) return;
    const int sc1 = 0x7f7f7f7f; (void)sc1;
    f32x4 acc[2][2][4][2];
#pragma unroll
    for (int a = 0; a < 2; ++a)
#pragma unroll
        for (int b = 0; b < 2; ++b)
#pragma unroll
            for (int m = 0; m < 4; ++m)
#pragma unroll
                for (int n = 0; n < 2; ++n) acc[a][b][m][n] = (f32x4){0.f, 0.f, 0.f, 0.f};
    bf16x8 At[4][2], B0[2][2], B1[2][2];
    const char* cA = (const char*)g.A + (size_t)cur.e * g.aestride + (size_t)cur.pm * tstepA; const char* cB = (const char*)g.Bt + (size_t)cur.e * g.estride + (size_t)cur.pn * tstepB;
    S.a_ready(cur);
    if constexpr (SP2) {
        PG8_STAGE(PG8_SB(0, 0), cB, voffB); PG8_STAGE(PG8_SB(0, 1), cB + hstepB, voffB); PG8_STAGE(PG8_SA(0, 0), cA, voffA); PG8_STAGE(PG8_SA(0, 1), cA + hstepA, voffA);
        if (wr == 1) PG8_BAR;
        PG8_WAIT_V(2); PG8_BAR;
        PG8_STAGE(PG8_SB(1, 0), cB + kstep, voffB); PG8_STAGE(PG8_SA(1, 0), cA + kstep, voffA); PG8_STAGE(PG8_SB(1, 1), cB + hstepB + kstep, voffB);
        PG8_WAIT_V(6); PG8_BAR;
    } else {
        PG8_STAGE(PG8_SB(0, 0), cB, voffB); PG8_STAGE(PG8_SA(0, 0), cA, voffA); PG8_STAGE(PG8_SB(0, 1), cB + hstepB, voffB); PG8_STAGE(PG8_SA(0, 1), cA + hstepA, voffA);
        if (wr == 1) PG8_BAR;
        PG8_WAIT_V(4); PG8_BAR;
        PG8_STAGE(PG8_SB(1, 0), cB + kstep, voffB); PG8_STAGE(PG8_SA(1, 0), cA + kstep, voffA); PG8_STAGE(PG8_SB(1, 1), cB + hstepB + kstep, voffB);
        PG8_WAIT_V(6); PG8_BAR;
    }
    for (;;) {
        const bool has_next = S.next(ui + 1, nxt);
        const char* nA = has_next ? (const char*)g.A + (size_t)nxt.e * g.aestride + (size_t)nxt.pm * tstepA : cA; const char* nB = has_next ? (const char*)g.Bt + (size_t)nxt.e * g.estride + (size_t)nxt.pn * tstepB : cB;
        for (int t = 0; t < nt; t += 2) {
            const bool last = (t == nt - 2);
            const char* a1 = cA + (size_t)(t + 1) * kstep;
            const char* a2 = last ? nA : cA + (size_t)(t + 2) * kstep; const char* b2 = last ? nB : cB + (size_t)(t + 2) * kstep;
            const char* a3 = a2 + kstep; const char* b3 = b2 + kstep;
            if (last && has_next) S.a_ready(nxt);
            if constexpr (SP2) {
            PG8_LDB(B0, 0, 0); PG8_LDB(B1, 0, 1); PG8_SCHED; PG8_LDA(At, 0, 0); PG8_STAGE(PG8_SA(1, 1), a1 + hstepA, voffA);
            PG8_WAIT_V(8); PG8_WAIT_L(0); PG8_BAR; PG8_MMA(0, 0, At, B0); PG8_MMA(0, 1, At, B1); PG8_BAR; PG8_SCHED;
            PG8_LDA(At, 0, 1); PG8_STAGE(PG8_SB(0, 0), b2, voffB); PG8_STAGE(PG8_SB(0, 1), b2 + hstepB, voffB); PG8_STAGE(PG8_SA(0, 0), a2, voffA);
            PG8_WAIT_V(8); PG8_WAIT_L(0); PG8_BAR; PG8_MMA(1, 0, At, B0); PG8_MMA(1, 1, At, B1); PG8_BAR; PG8_SCHED;
            PG8_LDB(B0, 1, 0); PG8_LDB(B1, 1, 1); PG8_SCHED; PG8_LDA(At, 1, 0); PG8_STAGE(PG8_SA(0, 1), a2 + hstepA, voffA);
            PG8_WAIT_V(8); PG8_WAIT_L(0); PG8_BAR; PG8_MMA(0, 0, At, B0); PG8_MMA(0, 1, At, B1); PG8_BAR; PG8_SCHED;
            PG8_LDA(At, 1, 1); PG8_STAGE(PG8_SB(1, 0), b3, voffB); PG8_STAGE(PG8_SB(1, 1), b3 + hstepB, voffB); PG8_STAGE(PG8_SA(1, 0), a3, voffA);
            PG8_WAIT_V(8); PG8_WAIT_L(0); PG8_BAR; PG8_MMA(1, 0, At, B0); PG8_MMA(1, 1, At, B1); PG8_BAR; PG8_SCHED;
            } else {
            PG8_LDB(B0, 0, 0); PG8_SCHED; PG8_LDA(At, 0, 0); PG8_STAGE(PG8_SA(1, 1), a1 + hstepA, voffA);
            PG8_WAIT_L(8); PG8_BAR; PG8_WAIT_L(0); PG8_MMA(0, 0, At, B0); PG8_BAR; PG8_SCHED;
            PG8_LDB(B1, 0, 1); PG8_STAGE(PG8_SB(0, 0), b2, voffB);
            PG8_BAR; PG8_WAIT_L(0); PG8_MMA(0, 1, At, B1); PG8_BAR;
            PG8_LDA(At, 0, 1); PG8_STAGE(PG8_SA(0, 0), a2, voffA);
            PG8_BAR; PG8_WAIT_L(0); PG8_MMA(1, 0, At, B0); PG8_BAR; PG8_SCHED;
            PG8_STAGE(PG8_SB(0, 1), b2 + hstepB, voffB);
            PG8_WAIT_V(6); PG8_BAR; PG8_MMA(1, 1, At, B1); PG8_BAR;
            PG8_LDB(B0, 1, 0); PG8_SCHED; PG8_LDA(At, 1, 0); PG8_STAGE(PG8_SA(0, 1), a2 + hstepA, voffA);
            PG8_WAIT_L(8); PG8_BAR; PG8_WAIT_L(0); PG8_MMA(0, 0, At, B0); PG8_BAR; PG8_SCHED;
            PG8_LDB(B1, 1, 1); PG8_STAGE(PG8_SB(1, 0), b3, voffB);
            PG8_BAR; PG8_WAIT_L(0); PG8_MMA(0, 1, At, B1); PG8_BAR;
            PG8_LDA(At, 1, 1); PG8_STAGE(PG8_SA(1, 0), a3, voffA);
            PG8_BAR; PG8_WAIT_L(0); PG8_MMA(1, 0, At, B0); PG8_BAR; PG8_SCHED;
            PG8_STAGE(PG8_SB(1, 1), b3 + hstepB, voffB);
            PG8_WAIT_V(6); PG8_BAR; PG8_MMA(1, 1, At, B1); PG8_BAR;
            }
        }
        if constexpr (ES == 1) asm volatile("s_nop 15\n\ts_nop 15" ::: "memory");
        if constexpr (ALIGN_EPI) { if (wr == 0) PG8_BAR; }
        if constexpr (!Epi::AFTER_DRAIN) { E(acc, cur, wr, wc, fr, fq); S.done(cur); }
        if (!has_next) break;
#pragma unroll
        for (int a = 0; a < 2; ++a)
#pragma unroll
            for (int b = 0; b < 2; ++b)
#pragma unroll
                for (int m = 0; m < 4; ++m)
#pragma unroll
                    for (int n = 0; n < 2; ++n) acc[a][b][m][n] = (f32x4){0.f, 0.f, 0.f, 0.f};
        cur = nxt; cA = nA; cB = nB; ++ui;
        if constexpr (ALIGN_EPI) { if (wr == 1) PG8_BAR; }
    }
    PG8_WAIT_V(0);
    if constexpr (!ALIGN_EPI) { if (wr == 0) PG8_BAR; }
    PG8_BAR;
    if constexpr (Epi::AFTER_DRAIN) { E.fused(acc, cur, wr, wc, fr, fq, lds, wid, lane); S.done(cur); }
#undef PG8_SA
#undef PG8_SB
#undef PG8_STAGE
#undef PG8_LDA
#undef PG8_LDB
#undef PG8_MMA
#undef PG8_CAT
#undef PG8_WAIT_V
#undef PG8_WAIT_L
#undef PG8_BAR
#undef PG8_SCHED
}
}
constexpr int NWAVES = 8, NTHR = 512;
constexpr int NB = 8, T_ = 4096, D_ = 1024, M_ = NB * T_, DIN = 2216, NPROJ = 2304, FF = 2816, NE = 8, NCH = 32  ;
constexpr int PZ = 0, PX = 512, PB = 1024, PC = 1152, PQ = 1280, PKV = 1536, PKPE = 1664, PDT = 1696, PGU = 1792, PGV = 2048;
constexpr float LN_EPS = 1e-5f, RMS_EPS = 1e-6f, DN_ALPHA = 1.41421356237f;
constexpr float QSCALE = 0.10206207261596575f * 1.4426950408889634f;
constexpr int MOE_MAXP = 272;
constexpr size_t MiB = 1u << 20;
constexpr size_t WS_CTL = 0, CTL_ZERO_BYTES = 1 * MiB;
constexpr size_t WS_MOD = 1 * MiB, WS_ROPE = 2 * MiB, WS_WQB = 3 * MiB, WS_WKVB = 4 * MiB, WS_ROUTE = 5 * MiB, WS_RSTD = 6 * MiB, WS_DTV = 7 * MiB, WS_ACS = 8 * MiB, WS_GMW = 10 * MiB;
constexpr size_t WS_WIN = 16 * MiB, WS_WOUT = 25 * MiB, WS_W13 = 29 * MiB, WS_W2 = 40 * MiB, WS_MW13 = 46 * MiB  , WS_MW2 = 90 * MiB  ;
constexpr size_t WS_A = 112 * MiB, WS_PROJ = 176 * MiB, WS_Q = 320 * MiB, WS_KN = 344 * MiB, WS_V = 360 * MiB, WS_KPE = 376 * MiB, WS_ST = 378 * MiB;
constexpr size_t WS_CC = 410 * MiB, WS_SB = 418 * MiB;
constexpr size_t WS_XS = 440 * MiB;
constexpr size_t WS_ACT = 176 * MiB;
constexpr size_t WS_HP = 176 * MiB, WS_ACTM = 248 * MiB, WS_YP = 112 * MiB, WS_END = 512 * MiB;
static_assert(WS_ACT + (size_t)M_ * FF * 2 <= WS_END && WS_HP + (size_t)MOE_MAXP * 256 * 1024 <= WS_ACTM && WS_YP + (size_t)MOE_MAXP * 256 * 2048 <= WS_ACTM && WS_SB + 16 * MiB <= WS_XS && WS_ACTM + (size_t)MOE_MAXP * 256 * 2816 <= WS_XS && WS_XS + 64 * MiB <= WS_END, "d_ws map");
constexpr size_t W13_BYTES = (size_t)5632 * 1024 * 2, W2_BYTES = (size_t)1024 * 2816 * 2, WIN_BYTES = (size_t)NPROJ * 1024 * 2, WOUT_BYTES = (size_t)1024 * 1024 * 2, WQB_BYTES = (size_t)512 * 256 * 2;
constexpr int CW_TMO = 0, CW_CODE = 1, CW_BAR = 4096, CW_CNT = 8192;
constexpr int RING_OFF = 0, RING_BYTES = 131072, LDSCTL_OFF = RING_BYTES, MISC_OFF = LDSCTL_OFF + 320, LDS_BYTES = 147456;

#define GAS __attribute__((address_space(1)))
#define LAS __attribute__((address_space(3)))
typedef unsigned short bf16;
typedef unsigned v4u __attribute__((ext_vector_type(4)));
typedef unsigned v2u __attribute__((ext_vector_type(2)));
typedef float f32x4 __attribute__((ext_vector_type(4)));
typedef GAS unsigned gu32;
#define RLX_AGENT __ATOMIC_RELAXED, __HIP_MEMORY_SCOPE_AGENT
#define LDS_WAIT() asm volatile("s_waitcnt lgkmcnt(0)" ::: "memory")
__device__ __forceinline__ unsigned f2bf(float f) { unsigned u = __builtin_bit_cast(unsigned, f); return (u + 0x7fffu + ((u >> 16) & 1u)) >> 16; }
__device__ __forceinline__ unsigned pk2(float lo, float hi) { return f2bf(lo) | (f2bf(hi) << 16); }
__device__ __forceinline__ float bf2f(bf16 v) { return __uint_as_float((unsigned)v << 16); }
__device__ __forceinline__ float bflo(unsigned w) { return __uint_as_float(w << 16); }
__device__ __forceinline__ float bfhi(unsigned w) { return __uint_as_float(w & 0xffff0000u); }
__device__ __forceinline__ float silu(float a) { return a / (1.f + __expf(-a)); }
__device__ __forceinline__ float gelu_erf(float v) { return 0.5f * v * (1.f + erff(v * 0.70710678118654752f)); }

#define XB_TMO      128
#define XB_XCNT(j)  (256  + 64 * (j))
#define XB_XSUB(j)  (1280 + 64 * (j))
#define XB_XGEN(j)  (2304 + 64 * (j))
#define XB_TOP      3328
#define XB_TOPGEN   3392
#define XCD_BAR_WORDS 3456
#define XB_SPIN_CAP (1u << 22)
__device__ __forceinline__ unsigned xb_ld(unsigned* p)              { return __hip_atomic_load(p, __ATOMIC_RELAXED, __HIP_MEMORY_SCOPE_AGENT); }
__device__ __forceinline__ unsigned xb_add(unsigned* p, unsigned v) { return __hip_atomic_fetch_add(p, v, __ATOMIC_RELAXED, __HIP_MEMORY_SCOPE_AGENT); }
__device__ __forceinline__ unsigned xb_xcc_id() { return (unsigned)__builtin_amdgcn_s_getreg((3 << 11) | 20) & 0xFu; }
#define XB_SPIN(cond, bar) do { unsigned _sp = 0; while (cond) { __builtin_amdgcn_s_sleep(1); \
    if ((++_sp & 255u) == 0u) { if (xb_ld(&(bar)[XB_TMO])) break; if (_sp > XB_SPIN_CAP) { atomicAdd(&(bar)[XB_TMO], 1u); break; } } } } while (0)
struct XcdBarrier { unsigned* bar; unsigned x; volatile LAS unsigned* st; };
__device__ __forceinline__ XcdBarrier xcd_barrier_post(unsigned* bar, volatile LAS unsigned* st) {
    XcdBarrier b; b.bar = bar; b.x = xb_xcc_id(); b.st = st;
    if (threadIdx.x == 0) (void)xb_add(&bar[XB_XCNT(b.x)], 1u);
    return b;
}
__device__ __forceinline__ void xcd_barrier_complete(unsigned* bar, unsigned x, unsigned& nloc, unsigned& nx) {
    const unsigned G = gridDim.x * gridDim.y * gridDim.z;
    unsigned sum, cnt, mine, sp = 0u;
    for (;;) {
        sum = 0u; cnt = 0u; mine = 0u;
#pragma unroll
        for (unsigned j = 0; j < 16; ++j) { const unsigned c = xb_ld(&bar[XB_XCNT(j)]); sum += c; cnt += (c > 0u) ? 1u : 0u; mine = (j == x) ? c : mine; }
        if (sum == G) break;
        __builtin_amdgcn_s_sleep(1);
        if ((++sp & 255u) == 0u) { if (xb_ld(&bar[XB_TMO])) break; if (sp > XB_SPIN_CAP) { atomicAdd(&bar[XB_TMO], 1u); break; } }
    }
    nloc = mine > 0u ? mine : 1u; nx = cnt > 0u ? cnt : 1u;
}
__device__ __forceinline__ void xcd_barrier(const XcdBarrier& b, bool leader) {
    asm volatile("s_waitcnt vmcnt(0)" ::: "memory");
    __syncthreads();
    if (leader) {
        unsigned* bar = b.bar;
        __builtin_amdgcn_s_waitcnt(0);
        unsigned nloc = b.st[0], nx = b.st[1];
        if (nloc == 0u) { xcd_barrier_complete(bar, b.x, nloc, nx); b.st[0] = nloc; b.st[1] = nx; }
        const unsigned old = xb_add(&bar[XB_XSUB(b.x)], 1u);
        const unsigned gen = old / nloc;
        if (old + 1u == (gen + 1u) * nloc) {
            __builtin_amdgcn_fence(__ATOMIC_RELEASE, "agent");
            asm volatile("s_waitcnt vmcnt(0)" ::: "memory");
            const unsigned og = xb_add(&bar[XB_TOP], 1u);
            const unsigned tg = og / nx;
            if (og + 1u == (tg + 1u) * nx) xb_add(&bar[XB_TOPGEN], 1u);
            else XB_SPIN(xb_ld(&bar[XB_TOPGEN]) == tg, bar);
            __builtin_amdgcn_fence(__ATOMIC_ACQUIRE, "agent");
            xb_add(&bar[XB_XGEN(b.x)], 1u);
            asm volatile("s_waitcnt vmcnt(0)" ::: "memory");
        } else {
            XB_SPIN(xb_ld(&bar[XB_XGEN(b.x)]) == gen, bar);
            __builtin_amdgcn_fence(__ATOMIC_ACQUIRE, "agent");
            asm volatile("s_waitcnt vmcnt(0)" ::: "memory");
        }
    }
    __syncthreads();
}

struct Args { const float* in[31]; float* out; unsigned char* ws; int ph_lo, ph_hi; };
enum { I_X = 0, I_C, I_LN0G, I_LN0B, I_ADAW, I_ADAB, I_PLG, I_PLB, I_WIN, I_CONVW, I_CONVB, I_DTB, I_ALOG, I_SSDD, I_SSDNW, I_QNORM, I_WQB, I_KVNORM, I_WKVB,
       I_GMLNG, I_GMLNB, I_GMWS, I_GMBS, I_WOUT, I_FW1, I_FW3, I_FW2, I_ROUTER, I_MW1, I_MW3, I_MW2 };
struct Frame {
    LAS unsigned char* lds; gu32* ctl; unsigned char* ws; float* out;
    int tid, lane, wave, G, bid;
};
__device__ __forceinline__ Frame phase_frame(const Frame& F0) {
    Frame P = F0; asm volatile("" : "+s"(P.wave)); asm volatile("" : "+s"(P.ws)); asm volatile("" : "+s"(P.out)); asm volatile("" : "+s"(P.G)); asm volatile("" : "+s"(P.bid));
    P.lane = (int)__builtin_amdgcn_mbcnt_hi(~0u, __builtin_amdgcn_mbcnt_lo(~0u, 0u)); asm volatile("" : "+v"(P.lane));
    P.tid = P.wave * 64 + P.lane; P.ctl = (gu32*)(P.ws + WS_CTL); return P;
}
__device__ __forceinline__ float wave_sum(float v) {
#pragma unroll
    for (int o = 1; o < 64; o <<= 1) v += __shfl_xor(v, o);
    return v;
}
__device__ __forceinline__ float wave_max(float v) {
#pragma unroll
    for (int o = 1; o < 64; o <<= 1) v = fmaxf(v, __shfl_xor(v, o));
    return v;
}

struct SrcId   { __device__ __forceinline__ int operator()(int n) const { return n; } };
struct SrcWin  { __device__ __forceinline__ int operator()(int n) const {
    if (n < 1280) return n;
    if (n < 1536) return 1288 + (n - 1280);
    if (n < 1664) return 1544 + (n - 1536);
    if (n < 1696) { const int d = n - 1664, g = d >> 3, w = d & 7; return 1672 + ((w < 4) ? 4 * g + w : 16 + 4 * g + (w - 4)); }
    if (n < 1704) return 1280 + (n - 1696);
    if (n < 1792) return -1;
    if (n < 2048) return 1704 + (n - 1792);
    return 1960 + (n - 2048); } };
struct SrcHalf { __device__ __forceinline__ int operator()(int n) const { return 128 * (n >> 8) + (n & 127); } };
struct SrcQB   { __device__ __forceinline__ int operator()(int n) const { const int pn = n >> 8, lc = n & 255; if (lc >= 192) return -1; const int h = 2 * pn + lc / 96, hc = lc % 96; if (hc < 64) return h * 96 + hc;
    const int d = hc - 64, g = d >> 3, w = d & 7; return h * 96 + 64 + ((w < 4) ? 4 * g + w : 16 + 4 * g + (w - 4)); } };
struct SrcKVB  { __device__ __forceinline__ int operator()(int n) const { const int t = n >> 8, r = n & 255, h = r >> 6, d = r & 63; return h * 128 + t * 64 + d; } };
template <class SrcFn>
__device__ __forceinline__ void tr_item(const float* W, int ldw, int Ksrc, const float* kscale, SrcFn src, bf16* WT, int Kdst, int k0, int n0, LAS unsigned char* scr, int lane, float qs = 0.f, bool out8 = false) {
    const int n4 = (lane & 15) * 4, kr = lane >> 4, sc = src(n0 + n4);
    f32x4 v[16];
#pragma unroll
    for (int i = 0; i < 16; ++i) { const int k = k0 + 4 * i + kr; v[i] = (sc >= 0 && k < Ksrc) ? *(const GAS f32x4*)(W + (size_t)k * ldw + sc) : (f32x4){0.f, 0.f, 0.f, 0.f}; }
    if (kscale) {
#pragma unroll
        for (int i = 0; i < 16; ++i) { const int k = k0 + 4 * i + kr; if (k < Ksrc) v[i] = v[i] * kscale[k]; } }
    if (qs != 0.f) { const float iq = out8 ? 1.f : 1.f / qs;
#pragma unroll
        for (int i = 0; i < 16; ++i) { v[i].x = pg8::q8(v[i].x * qs) * iq; v[i].y = pg8::q8(v[i].y * qs) * iq; v[i].z = pg8::q8(v[i].z * qs) * iq; v[i].w = pg8::q8(v[i].w * qs) * iq; } }
#pragma unroll
    for (int i = 0; i < 16; ++i) { LAS unsigned char* p = scr + (4 * i + kr) * 132 + n4 * 2; *(LAS unsigned*)p = pk2(v[i].x, v[i].y); *(LAS unsigned*)(p + 4) = pk2(v[i].z, v[i].w); }
    LDS_WAIT(); asm volatile("" ::: "memory");
    const int c = lane & 7;
#pragma unroll
    for (int j = 0; j < 8; ++j) { const int n = (lane >> 3) + 8 * j; const LAS unsigned char* p = scr + (8 * c) * 132 + n * 2;
        v4u o; o.x = (unsigned)*(const LAS bf16*)(p) | ((unsigned)*(const LAS bf16*)(p + 132) << 16); o.y = (unsigned)*(const LAS bf16*)(p + 264) | ((unsigned)*(const LAS bf16*)(p + 396) << 16);
        o.z = (unsigned)*(const LAS bf16*)(p + 528) | ((unsigned)*(const LAS bf16*)(p + 660) << 16); o.w = (unsigned)*(const LAS bf16*)(p + 792) | ((unsigned)*(const LAS bf16*)(p + 924) << 16);
        if (!out8) *(GAS v4u*)(WT + (size_t)(n0 + n) * Kdst + k0 + 8 * c) = o;
        else { v2u o8; o8.x = pg8::fp8x4((f32x4){bflo(o.x), bfhi(o.x), bflo(o.y), bfhi(o.y)}); o8.y = pg8::fp8x4((f32x4){bflo(o.z), bfhi(o.z), bflo(o.w), bfhi(o.w)});
            *(GAS v2u*)((unsigned char*)WT + (size_t)(n0 + n) * Kdst + k0 + 8 * c) = o8; } }
    LDS_WAIT(); asm volatile("" ::: "memory");
}
__device__ __forceinline__ void p0a(Frame& F, const Args& A) {
    if (F.bid < 192) {
        const int ls = F.bid / 48, col0 = (F.bid % 48) * 64;
        LAS float* sc = (LAS float*)(F.lds);
        LAS float* red = (LAS float*)(F.lds + 32768);
        const float* c = A.in[I_C];
        for (int i = F.tid; i < 8 * 1024; i += NTHR) sc[i] = silu(c[i]);
        __syncthreads();
        const float* w = A.in[I_ADAW] + (size_t)ls * 1024 * 3072 + col0 + F.lane;
        float acc[8];
#pragma unroll
        for (int b = 0; b < 8; ++b) acc[b] = 0.f;
        const int kb = F.wave * 128;
#pragma unroll 16
        for (int k = 0; k < 128; ++k) { const float wv = w[(size_t)(kb + k) * 3072];
#pragma unroll
            for (int b = 0; b < 8; ++b) acc[b] += sc[b * 1024 + kb + k] * wv; }
#pragma unroll
        for (int b = 0; b < 8; ++b) red[(F.wave * 8 + b) * 64 + F.lane] = acc[b];
        __syncthreads();
        { const int b = F.tid >> 6, l = F.tid & 63; float s = 0.f;
#pragma unroll
          for (int wv = 0; wv < 8; ++wv) s += red[(wv * 8 + b) * 64 + l];
          float* mod = (float*)(F.ws + WS_MOD);
          mod[((size_t)ls * 8 + b) * 3072 + col0 + l] = s + A.in[I_ADAB][ls * 3072 + col0 + l]; }
        __syncthreads();
    }
    {
        const double inv[16] = {1.0, 0.5623413251903491, 0.31622776601683794, 0.1778279410038923, 0.1, 0.05623413251903491, 0.03162277660168379, 0.01778279410038923,
                                0.01, 0.005623413251903491, 0.0031622776601683794, 0.0017782794100389228, 0.001, 0.0005623413251903491, 0.00031622776601683794, 0.00017782794100389227};
        float* rc = (float*)(F.ws + WS_ROPE); float* rs = rc + 4096 * 16;
        for (int idx = F.bid * NTHR + F.tid; idx < 4096 * 16; idx += F.G * NTHR) { const int t = idx >> 4, i = idx & 15;
            double iv = inv[0];
#pragma unroll
            for (int q = 1; q < 16; ++q) iv = (i == q) ? inv[q] : iv;
            const double rev = (double)t * iv * 0.15915494309189535; const float fr = (float)(rev - floor(rev));
            rc[idx] = __builtin_amdgcn_cosf(fr); rs[idx] = __builtin_amdgcn_sinf(fr); }
    }
    { const float* W = A.in[I_GMWS]; bf16* o = (bf16*)(F.ws + WS_GMW);
      for (int idx = F.bid * NTHR + F.tid; idx < 2 * 4 * 128 * 128; idx += F.G * NTHR) { const int s = idx & 127, t = (idx >> 7) & 127; o[idx] = (bf16)(s <= t ? f2bf(W[idx]) : 0u); } }
    LAS unsigned char* scr = F.lds + RING_OFF + F.wave * 16384;
    const int gw = F.bid * NWAVES + F.wave, NGW = F.G * NWAVES;
    constexpr int I_WINc = 16 * 36, I_WOUTc = 16 * 16, I_W13c = 16 * 88, I_W2c = 44 * 16, I_QBc = 4 * 8;
    constexpr int NITEMS = 2 * I_WINc + 2 * I_WOUTc + 9 * I_W13c + 9 * I_W2c + 4 * I_QBc;
    for (int it = gw; it < NITEMS; it += NGW) {
        int r = it;
        if (r < 9 * I_W13c) { const int e = r / I_W13c; r %= I_W13c; const int kb = r / 88, nb = r % 88; const int which = (nb >> 1) & 1;
            const float* W = e == 0 ? (which ? A.in[I_FW3] : A.in[I_FW1]) : ((which ? A.in[I_MW3] : A.in[I_MW1]) + (size_t)(e - 1) * 1024 * FF);
            bf16* WT = e == 0 ? (bf16*)(F.ws + WS_W13) : (bf16*)(F.ws + WS_MW13 + (size_t)(e - 1) * (W13_BYTES / 2));
            tr_item(W, FF, 1024, nullptr, SrcHalf(), WT, 1024, kb * 64, nb * 64, scr, F.lane, e > 0 ? 32.f : 0.f, e > 0); continue; } r -= 9 * I_W13c;
        if (r < 9 * I_W2c) { const int e = r / I_W2c; r %= I_W2c; const int kb = r / 16, nb = r % 16;
            const float* W = e == 0 ? A.in[I_FW2] : A.in[I_MW2] + (size_t)(e - 1) * FF * 1024;
            bf16* WT = e == 0 ? (bf16*)(F.ws + WS_W2) : (bf16*)(F.ws + WS_MW2 + (size_t)(e - 1) * (W2_BYTES / 2));
            tr_item(W, 1024, FF, nullptr, SrcId(), WT, FF, kb * 64, nb * 64, scr, F.lane, e > 0 ? 128.f : 0.f, e > 0); continue; } r -= 9 * I_W2c;
        if (r < 2 * I_WINc) { const int l = r / I_WINc; r %= I_WINc; const int kb = r / 36, nb = r % 36;
            tr_item(A.in[I_WIN] + (size_t)l * 1024 * DIN, DIN, 1024, nullptr, SrcWin(), (bf16*)(F.ws + WS_WIN + l * WIN_BYTES), 1024, kb * 64, nb * 64, scr, F.lane); continue; } r -= 2 * I_WINc;
        if (r < 2 * I_WOUTc) { const int l = r / I_WOUTc; r %= I_WOUTc; const int kb = r / 16, nb = r % 16;
            tr_item(A.in[I_WOUT] + (size_t)l * 1024 * 1024, 1024, 1024, nullptr, SrcId(), (bf16*)(F.ws + WS_WOUT + l * WOUT_BYTES), 1024, kb * 64, nb * 64, scr, F.lane); continue; } r -= 2 * I_WOUTc;
        { const int l = (r / I_QBc) & 1, isk = r / (2 * I_QBc); r %= I_QBc; const int kb = r / 8, nb = r % 8;
          if (!isk) tr_item(A.in[I_WQB] + (size_t)l * 256 * 384, 384, 256, A.in[I_QNORM] + l * 256, SrcQB(), (bf16*)(F.ws + WS_WQB + l * WQB_BYTES), 256, kb * 64, nb * 64, scr, F.lane);
          else      tr_item(A.in[I_WKVB] + (size_t)l * 128 * 512, 512, 128, A.in[I_KVNORM] + l * 128, SrcKVB(), (bf16*)(F.ws + WS_WKVB + l * WQB_BYTES), 256, kb * 64, nb * 64, scr, F.lane); }
    }
    __syncthreads();
}
__device__ __forceinline__ int lcol(int lane, int j) { return (j >> 1) * 512 + 8 * lane + 4 * (j & 1); }
__device__ __forceinline__ void unpack_row(const v4u a, const v4u b, f32x4 (&x)[4]) {
    x[0] = (f32x4){bflo(a.x), bfhi(a.x), bflo(a.y), bfhi(a.y)}; x[1] = (f32x4){bflo(a.z), bfhi(a.z), bflo(a.w), bfhi(a.w)};
    x[2] = (f32x4){bflo(b.x), bfhi(b.x), bflo(b.y), bfhi(b.y)}; x[3] = (f32x4){bflo(b.z), bfhi(b.z), bflo(b.w), bfhi(b.w)}; }
__device__ __forceinline__ void load_row(const float* pf, const bf16* pb, f32x4 (&x)[4], int lane) {
    if (pf) {
#pragma unroll
        for (int j = 0; j < 4; ++j) x[j] = *(const GAS f32x4*)(pf + lcol(lane, j)); }
    else unpack_row(*(const GAS v4u*)(pb + 8 * lane), *(const GAS v4u*)(pb + 512 + 8 * lane), x);
}
template <int NR> __device__ __forceinline__ void ln_rows(const float* g, const float* bt, f32x4 (&x)[NR][4], int lane) {
    float s[NR], s2[NR];
#pragma unroll
    for (int i = 0; i < NR; ++i) { s[i] = 0.f;
#pragma unroll
        for (int j = 0; j < 4; ++j) s[i] += (x[i][j].x + x[i][j].y) + (x[i][j].z + x[i][j].w); }
#pragma unroll
    for (int o = 1; o < 64; o <<= 1) {
#pragma unroll
        for (int i = 0; i < NR; ++i) s[i] += __shfl_xor(s[i], o); }
#pragma unroll
    for (int i = 0; i < NR; ++i) { const float mean = s[i] * (1.f / 1024.f); s2[i] = 0.f;
#pragma unroll
        for (int j = 0; j < 4; ++j) { x[i][j] = x[i][j] - mean; s2[i] += (x[i][j].x * x[i][j].x + x[i][j].y * x[i][j].y) + (x[i][j].z * x[i][j].z + x[i][j].w * x[i][j].w); } }
#pragma unroll
    for (int o = 1; o < 64; o <<= 1) {
#pragma unroll
        for (int i = 0; i < NR; ++i) s2[i] += __shfl_xor(s2[i], o); }
#pragma unroll
    for (int j = 0; j < 4; ++j) { const f32x4 gg = *(const GAS f32x4*)(g + lcol(lane, j)), bb = *(const GAS f32x4*)(bt + lcol(lane, j));
#pragma unroll
        for (int i = 0; i < NR; ++i) { const float rstd = 1.f / sqrtf(s2[i] * (1.f / 1024.f) + LN_EPS); x[i][j] = x[i][j] * rstd * gg + bb; } }
}
__device__ __forceinline__ void store_rows(f32x4 (&x)[4], bf16* xs, float* xf, bf16* hout, const float* modp, int lane) {
    if (xs) { *(GAS v4u*)(xs + 8 * lane) = __builtin_bit_cast(v4u, pg8::pack8(x[0], x[1])); *(GAS v4u*)(xs + 512 + 8 * lane) = __builtin_bit_cast(v4u, pg8::pack8(x[2], x[3])); }
    if (xf) {
#pragma unroll
        for (int j = 0; j < 4; ++j) *(GAS f32x4*)(xf + lcol(lane, j)) = x[j]; }
    if (hout) {
#pragma unroll
        for (int j = 0; j < 4; ++j) { const f32x4 sh = *(const GAS f32x4*)(modp + lcol(lane, j)), sc = *(const GAS f32x4*)(modp + 1024 + lcol(lane, j)); x[j] = x[j] * (sc + 1.f) + sh; }
        *(GAS v4u*)(hout + 8 * lane) = __builtin_bit_cast(v4u, pg8::pack8(x[0], x[1])); *(GAS v4u*)(hout + 512 + 8 * lane) = __builtin_bit_cast(v4u, pg8::pack8(x[2], x[3])); }
}
__device__ __forceinline__ void ln_phase(Frame& F, const Args& A, const float* vin, const float* g, const float* bt, int ls, bool route, bool dry) {
    const int gwv = F.bid * NWAVES + F.wave, NGW = F.G * NWAVES;
    const float* mod = (const float*)(F.ws + WS_MOD);
    bf16* hb = dry ? (bf16*)(F.ws + WS_Q) : (bf16*)(F.ws + WS_A); bf16* xs = (bf16*)(F.ws + WS_XS); bf16* xo = dry ? (bf16*)(F.ws + WS_PROJ) : xs;
    if (!route) {
        f32x4 nx[2][4];
        if (gwv * 2 < M_) {
#pragma unroll
            for (int i = 0; i < 2; ++i) load_row(vin ? vin + (size_t)(gwv * 2 + i) * 1024 : nullptr, xs + (size_t)(gwv * 2 + i) * 1024, nx[i], F.lane); }
        for (int m = gwv * 2; m < M_; m += NGW * 2) { f32x4 x[2][4];
#pragma unroll
            for (int i = 0; i < 2; ++i)
#pragma unroll
                for (int j = 0; j < 4; ++j) x[i][j] = nx[i][j];
            const int mn = m + NGW * 2;
            if (mn < M_) {
#pragma unroll
                for (int i = 0; i < 2; ++i) load_row(vin ? vin + (size_t)(mn + i) * 1024 : nullptr, xs + (size_t)(mn + i) * 1024, nx[i], F.lane); }
            ln_rows<2>(g, bt, x, F.lane);
#pragma unroll
            for (int i = 0; i < 2; ++i) store_rows(x[i], xo + (size_t)(m + i) * 1024, nullptr, ls >= 0 ? hb + (size_t)(m + i) * 1024 : nullptr, mod + ((size_t)(ls < 0 ? 0 : ls) * 8 + (m >> 12)) * 3072, F.lane); }
    } else {
        f32x4 wr[4][4][2];
        const float* R = A.in[I_ROUTER];
#pragma unroll
        for (int j = 0; j < 4; ++j)
#pragma unroll
            for (int i = 0; i < 4; ++i) { const float* rp = R + (size_t)(lcol(F.lane, j) + i) * 8; wr[j][i][0] = *(const f32x4*)rp; wr[j][i][1] = *(const f32x4*)(rp + 4); }
        int* re = (int*)(F.ws + WS_ROUTE); int* rs = re + 2 * M_; float* rg = (float*)(rs + 2 * M_);
        int it = 0, myE0 = -1, myE1 = -1, myM = 0; float myG0 = 0.f;
        for (int m = gwv; m < M_; m += NGW) { f32x4 x1[1][4]; load_row(nullptr, xs + (size_t)m * 1024, x1[0], F.lane); ln_rows<1>(g, bt, x1, F.lane); f32x4 (&x)[4] = x1[0];
            store_rows(x, xo + (size_t)m * 1024, nullptr, hb + (size_t)m * 1024, mod + ((size_t)ls * 8 + (m >> 12)) * 3072, F.lane);
            f32x4 p0 = {0.f, 0.f, 0.f, 0.f}, p1 = {0.f, 0.f, 0.f, 0.f};
#pragma unroll
            for (int j = 0; j < 4; ++j) { p0 += wr[j][0][0] * x[j].x + wr[j][1][0] * x[j].y + wr[j][2][0] * x[j].z + wr[j][3][0] * x[j].w;
                                           p1 += wr[j][0][1] * x[j].x + wr[j][1][1] * x[j].y + wr[j][2][1] * x[j].z + wr[j][3][1] * x[j].w; }
            float lg[8] = {wave_sum(p0.x), wave_sum(p0.y), wave_sum(p0.z), wave_sum(p0.w), wave_sum(p1.x), wave_sum(p1.y), wave_sum(p1.z), wave_sum(p1.w)};
            int i0 = 0; float v0 = lg[0];
#pragma unroll
            for (int e = 1; e < 8; ++e) if (lg[e] > v0) { v0 = lg[e]; i0 = e; }
            int i1 = -1; float v1 = -INFINITY;
#pragma unroll
            for (int e = 0; e < 8; ++e) if (e != i0 && lg[e] > v1) { v1 = lg[e]; i1 = e; }
            if (F.lane == it) { myE0 = i0; myE1 = i1; myG0 = 1.f / (1.f + __expf(v1 - v0)); myM = m; }
            ++it;
            if (it == 16 || m + NGW >= M_) {
                const bool act = F.lane < it && !dry; unsigned base[8]; unsigned long long b0[8], b1[8];
#pragma unroll
                for (int e = 0; e < 8; ++e) { b0[e] = __ballot(act && myE0 == e); b1[e] = __ballot(act && myE1 == e); }
#pragma unroll
                for (int e = 0; e < 8; ++e) { base[e] = 0u;
                    if (F.lane == 0 && (b0[e] | b1[e])) base[e] = atomicAdd((unsigned*)(F.ctl + CW_CNT + e * 64), (unsigned)(__popcll(b0[e]) + __popcll(b1[e]))); }
                int s0 = 0, s1 = 0; const unsigned long long lt = (1ull << F.lane) - 1ull;
#pragma unroll
                for (int e = 0; e < 8; ++e) { const unsigned bb = __builtin_amdgcn_readfirstlane(base[e]);
                    if (myE0 == e) s0 = (int)bb + __popcll(b0[e] & lt); if (myE1 == e) s1 = (int)bb + __popcll(b0[e]) + __popcll(b1[e] & lt); }
                if (act) { re[myM] = myE0; re[M_ + myM] = myE1; rs[myM] = s0; rs[M_ + myM] = s1; rg[myM] = myG0; rg[M_ + myM] = 1.f - myG0; }
                it = 0; }
        }
    }
}
__device__ __forceinline__ float conv_silu(const bf16* proj, const float* cw, const float* cb, int b, int t, int ch, int pcol) {
    float a = cb[ch];
#pragma unroll
    for (int k = 0; k < 4; ++k) { const int tt = t - 3 + k; if (tt >= 0) a += cw[k * 768 + ch] * bf2f(proj[((size_t)b * T_ + tt) * NPROJ + pcol]); }
    return silu(a);
}
__device__ __forceinline__ void ssd_chunk_naive(Frame& F, const Args& A, int l, int unit) {
    const int h = unit & 7, c = (unit >> 3) & 31, b = unit >> 8, g = h >> 2;
    const int row0 = b * T_ + c * 128;
    const bf16* proj = (const bf16*)(F.ws + WS_PROJ);
    const float* cw = A.in[I_CONVW] + l * 4 * 768; const float* cb = A.in[I_CONVB] + l * 768;
    LAS float* xs = (LAS float*)(F.lds);
    LAS float* Bs = (LAS float*)(F.lds + 32768);
    LAS float* Cs = (LAS float*)(F.lds + 65536);
    LAS float* dts = (LAS float*)(F.lds + 98304);
    LAS float* acs = dts + 128;
    for (int idx = F.tid; idx < 128 * 64; idx += NTHR) { const int t = idx >> 6, p = idx & 63;
        xs[idx] = conv_silu(proj, cw, cb, b, c * 128 + t, 64 * h + p, PX + 64 * h + p);
        Bs[idx] = conv_silu(proj, cw, cb, b, c * 128 + t, 512 + 64 * g + p, PB + 64 * g + p);
        Cs[idx] = conv_silu(proj, cw, cb, b, c * 128 + t, 640 + 64 * g + p, PC + 64 * g + p); }
    const float* dtv = (const float*)(F.ws + WS_DTV); float* ACS = (float*)(F.ws + WS_ACS);
    if (F.tid < 128) { const float xv = dtv[(size_t)(row0 + F.tid) * 8 + h] + A.in[I_DTB][l * 8 + h]; const float ev = __expf(xv); dts[F.tid] = xv > 20.f ? xv : (ev < 0.01f ? ev * (1.f - ev * (0.5f - ev * 0.33333333f)) : __logf(1.f + ev)); }
    __syncthreads();
    if (F.tid == 0) { const float Ah = -__expf(A.in[I_ALOG][l * 8 + h]); float s = 0.f; for (int t = 0; t < 128; ++t) { s += dts[t] * Ah; acs[t] = s; } }
    __syncthreads();
    if (F.tid < 128) ACS[(size_t)(row0 + F.tid) * 8 + h] = acs[F.tid];
    { float* ST = (float*)(F.ws + WS_ST) + (size_t)((b * NCH + c) * 8 + h) * 4096; const float alast = acs[127];
      for (int idx = F.tid; idx < 4096; idx += NTHR) { const int p = idx >> 6, n = idx & 63; float a = 0.f;
          for (int s = 0; s < 128; ++s) a += xs[s * 64 + p] * Bs[s * 64 + n] * (dts[s] * __expf(alast - acs[s]));
          ST[idx] = a; } }
    { const int lq = F.tid >> 2, pq = (F.tid & 3) * 16; float y[16];
#pragma unroll
      for (int i = 0; i < 16; ++i) y[i] = 0.f;
      const float al = acs[lq];
      for (int s = 0; s <= lq; ++s) { float cbv = 0.f;
#pragma unroll 8
          for (int n = 0; n < 64; ++n) cbv += Cs[lq * 64 + n] * Bs[s * 64 + n];
          const float gg = cbv * __expf(al - acs[s]) * dts[s];
#pragma unroll
          for (int i = 0; i < 16; ++i) y[i] += gg * xs[s * 64 + pq + i]; }
      const float Dh = A.in[I_SSDD][l * 8 + h];
      bf16* yc = (bf16*)(F.ws + WS_A) + (size_t)(row0 + lq) * 1024 + 64 * h + pq;
#pragma unroll
      for (int i = 0; i < 16; i += 2) *(unsigned*)(yc + i) = pk2(y[i] + Dh * xs[lq * 64 + pq + i], y[i + 1] + Dh * xs[lq * 64 + pq + i + 1]); }
    __syncthreads();
}
__device__ __forceinline__ void gmlp_naive(Frame& F, const Args& A, int l, int unit) {
    const int row0 = unit * 128;
    const bf16* proj = (const bf16*)(F.ws + WS_PROJ);
    LAS float* vs = (LAS float*)(F.lds);
    for (int r = F.wave * 16; r < F.wave * 16 + 16; ++r) { const bf16* gp = proj + (size_t)(row0 + r) * NPROJ + PGV + 4 * F.lane; const v2u w = *(const v2u*)gp;
        float v[4] = {gelu_erf(bflo(w.x)), gelu_erf(bfhi(w.x)), gelu_erf(bflo(w.y)), gelu_erf(bfhi(w.y))};
        const float mean = wave_sum((v[0] + v[1]) + (v[2] + v[3])) * (1.f / 256.f); float s2 = 0.f;
#pragma unroll
        for (int i = 0; i < 4; ++i) { v[i] -= mean; s2 += v[i] * v[i]; }
        const float rstd = 1.f / sqrtf(wave_sum(s2) * (1.f / 256.f) + LN_EPS);
#pragma unroll
        for (int i = 0; i < 4; ++i) vs[r * 256 + 4 * F.lane + i] = v[i] * rstd * A.in[I_GMLNG][l * 256 + 4 * F.lane + i] + A.in[I_GMLNB][l * 256 + 4 * F.lane + i]; }
    __syncthreads();
    { const int t = F.tid >> 2, g = F.tid & 3; const float* W = A.in[I_GMWS] + ((size_t)(l * 4 + g) * 128 + t) * 128; float a[64];
#pragma unroll
      for (int i = 0; i < 64; ++i) a[i] = 0.f;
      for (int s = 0; s <= t; ++s) { const float w = W[s];
#pragma unroll
          for (int i = 0; i < 64; ++i) a[i] += w * vs[s * 256 + 64 * g + i]; }
      const float bs = A.in[I_GMBS][(l * 4 + g) * 128 + t];
      const bf16* gu = proj + (size_t)(row0 + t) * NPROJ + PGU + 64 * g; bf16* yc = (bf16*)(F.ws + WS_A) + (size_t)(row0 + t) * 1024 + 768 + 64 * g;
#pragma unroll
      for (int i = 0; i < 64; i += 2) { const unsigned w = *(const unsigned*)(gu + i); *(unsigned*)(yc + i) = pk2(gelu_erf(bflo(w)) * (a[i] + bs), gelu_erf(bfhi(w)) * (a[i + 1] + bs)); } }
    __syncthreads();
}
__device__ __forceinline__ void token_local(Frame& F) {
    const int gwv = F.bid * NWAVES + F.wave, NGW = F.G * NWAVES;
    const bf16* proj = (const bf16*)(F.ws + WS_PROJ); float* rq = (float*)(F.ws + WS_RSTD); float* rkv = rq + M_; bf16* kpe = (bf16*)(F.ws + WS_KPE);
    const float* rc = (const float*)(F.ws + WS_ROPE); const float* rsn = rc + 4096 * 16;
    const int g = (F.lane & 15) >> 2, w = F.lane & 3, ri = 4 * g + w;
    for (int m0 = gwv * 4; m0 < M_; m0 += NGW * 4) {
        v2u wq[4]; unsigned wk[4]; float x1[4], x2[4], cs[4], sn[4];
#pragma unroll
        for (int i = 0; i < 4; ++i) { const bf16* pr = proj + (size_t)(m0 + i) * NPROJ; wq[i] = *(const v2u*)(pr + PQ + 4 * F.lane); wk[i] = *(const unsigned*)(pr + PKV + 2 * F.lane);
            x1[i] = bf2f(pr[PKPE + 8 * g + w]); x2[i] = bf2f(pr[PKPE + 8 * g + 4 + w]); const int t = (m0 + i) & 4095; cs[i] = rc[t * 16 + ri]; sn[i] = rsn[t * 16 + ri]; }
        float sq[4], sk[4];
#pragma unroll
        for (int i = 0; i < 4; ++i) { sq[i] = bflo(wq[i].x) * bflo(wq[i].x) + bfhi(wq[i].x) * bfhi(wq[i].x) + bflo(wq[i].y) * bflo(wq[i].y) + bfhi(wq[i].y) * bfhi(wq[i].y); sk[i] = bflo(wk[i]) * bflo(wk[i]) + bfhi(wk[i]) * bfhi(wk[i]); }
#pragma unroll
        for (int o = 1; o < 64; o <<= 1) {
#pragma unroll
            for (int i = 0; i < 4; ++i) { sq[i] += __shfl_xor(sq[i], o); sk[i] += __shfl_xor(sk[i], o); } }
#pragma unroll
        for (int i = 0; i < 4; ++i) { const int m = m0 + i;
            if (F.lane == 0) { rq[m] = 1.f / sqrtf(sq[i] * (1.f / 256.f) + RMS_EPS); rkv[m] = 1.f / sqrtf(sk[i] * (1.f / 128.f) + RMS_EPS); }
            if (F.lane < 16) { kpe[(size_t)m * 32 + 8 * g + w] = (bf16)f2bf(x1[i] * cs[i] - x2[i] * sn[i]); kpe[(size_t)m * 32 + 8 * g + 4 + w] = (bf16)f2bf(x1[i] * sn[i] + x2[i] * cs[i]); } }
    }
}
__device__ __forceinline__ void state_scan(Frame& F) {
    float* ST = (float*)(F.ws + WS_ST); const float* ACS = (const float*)(F.ws + WS_ACS);
    for (int idx = F.bid * NTHR + F.tid; idx < NB * 8 * 4096; idx += F.G * NTHR) { const int pn = idx & 4095, h = (idx >> 12) & 7, b = idx >> 15; float cur = 0.f;
        for (int c = 0; c < NCH; ++c) { const size_t a = (size_t)((b * NCH + c) * 8 + h) * 4096 + pn; const float s = ST[a]; ST[a] = cur;
            cur = cur * __expf(ACS[(size_t)(b * T_ + c * 128 + 127) * 8 + h]) + s; } }
}
__device__ __forceinline__ void ssd_finish_naive(Frame& F, const Args& A, int l, int unit) {
    const int g = unit & 1, c = (unit >> 1) & 31, b = unit >> 6; const int row0 = b * T_ + c * 128;
    const bf16* proj = (const bf16*)(F.ws + WS_PROJ);
    const float* cw = A.in[I_CONVW] + l * 4 * 768; const float* cb = A.in[I_CONVB] + l * 768;
    LAS float* Sin = (LAS float*)(F.lds);
    LAS float* Cs = (LAS float*)(F.lds + 4 * 64 * 65 * 4);
    const float* ST = (const float*)(F.ws + WS_ST) + (size_t)((b * NCH + c) * 8 + 4 * g) * 4096;
    for (int idx = F.tid; idx < 4 * 4096; idx += NTHR) { const int r = idx >> 12, p = (idx >> 6) & 63, n = idx & 63; Sin[(r * 64 + p) * 65 + n] = ST[idx]; }
    for (int idx = F.tid; idx < 128 * 64; idx += NTHR) { const int t = idx >> 6, n = idx & 63; Cs[t * 65 + n] = conv_silu(proj, cw, cb, b, c * 128 + t, 640 + 64 * g + n, PC + 64 * g + n); }
    __syncthreads();
    const int lq = F.tid >> 2, r = F.tid & 3, h = 4 * g + r;
    float cv[64];
#pragma unroll
    for (int n = 0; n < 64; ++n) cv[n] = Cs[lq * 65 + n];
    const float ea = __expf(((const float*)(F.ws + WS_ACS))[(size_t)(row0 + lq) * 8 + h]);
    bf16* yc = (bf16*)(F.ws + WS_A) + (size_t)(row0 + lq) * 1024 + 64 * h; const bf16* zp = proj + (size_t)(row0 + lq) * NPROJ + PZ + 64 * h;
    float ss = 0.f;
#pragma unroll 1
    for (int p = 0; p < 64; ++p) { float a = 0.f;
#pragma unroll
        for (int n = 0; n < 64; ++n) a += cv[n] * Sin[(r * 64 + p) * 65 + n];
        const float y = bf2f(yc[p]) + ea * a, gy = y * silu(bf2f(zp[p])); ss += gy * gy; }
    ss += __shfl_xor(ss, 1); ss += __shfl_xor(ss, 2);
    const float rs = 1.f / sqrtf(ss * (1.f / 256.f) + RMS_EPS); const float* nw = A.in[I_SSDNW] + l * 512 + 64 * h;
#pragma unroll 1
    for (int p = 0; p < 64; ++p) { float a = 0.f;
#pragma unroll
        for (int n = 0; n < 64; ++n) a += cv[n] * Sin[(r * 64 + p) * 65 + n];
        const float y = bf2f(yc[p]) + ea * a, gy = y * silu(bf2f(zp[p])); yc[p] = (bf16)f2bf(gy * rs * nw[p]); }
    __syncthreads();
}
__device__ __forceinline__ void attn_naive(Frame& F, int unit) {
    const int qb = unit & 63, h = (unit >> 6) & 3, b = unit >> 8;
    const bf16* Q = (const bf16*)(F.ws + WS_Q); const bf16* KN = (const bf16*)(F.ws + WS_KN); const bf16* V = (const bf16*)(F.ws + WS_V); const bf16* KPE = (const bf16*)(F.ws + WS_KPE);
    LAS float* Kt = (LAS float*)(F.lds);
    LAS float* Vt = (LAS float*)(F.lds + 64 * 97 * 4);
    LAS float* Qs = Vt + 64 * 64;
    LAS float* Pw = Qs + 64 * 96 + F.wave * 64;
    for (int idx = F.tid; idx < 64 * 96; idx += NTHR) { const int r = idx / 96, d = idx % 96; Qs[idx] = bf2f(Q[(size_t)(b * T_ + qb * 64 + r) * 384 + h * 96 + d]); }
    float mx[8], ls[8], o[8];
#pragma unroll
    for (int i = 0; i < 8; ++i) { mx[i] = -INFINITY; ls[i] = 0.f; o[i] = 0.f; }
    for (int kt = 0; kt <= qb; ++kt) {
        __syncthreads();
        for (int idx = F.tid; idx < 64 * 96; idx += NTHR) { const int j = idx / 96, d = idx % 96; const size_t row = (size_t)(b * T_ + kt * 64 + j);
            Kt[j * 97 + d] = d < 64 ? bf2f(KN[row * 256 + h * 64 + d]) : bf2f(KPE[row * 32 + d - 64]); }
        for (int idx = F.tid; idx < 64 * 64; idx += NTHR) { const int j = idx >> 6, d = idx & 63; Vt[idx] = bf2f(V[(size_t)(b * T_ + kt * 64 + j) * 256 + h * 64 + d]); }
        __syncthreads();
#pragma unroll
        for (int i = 0; i < 8; ++i) { const int qr = F.wave * 8 + i; float s = 0.f;
#pragma unroll 8
            for (int d = 0; d < 96; ++d) s += Qs[qr * 96 + d] * Kt[F.lane * 97 + d];
            if (kt * 64 + F.lane > qb * 64 + qr) s = -INFINITY;
            const float mn = fmaxf(mx[i], wave_max(s)), p = exp2f(s - mn), corr = exp2f(mx[i] - mn);
            ls[i] = ls[i] * corr + wave_sum(p); mx[i] = mn;
            Pw[F.lane] = p; LDS_WAIT(); asm volatile("" ::: "memory");
            float a = 0.f;
#pragma unroll 8
            for (int j = 0; j < 64; ++j) a += Pw[j] * Vt[j * 64 + F.lane];
            o[i] = o[i] * corr + a; LDS_WAIT(); asm volatile("" ::: "memory"); }
    }
    bf16* yc = (bf16*)(F.ws + WS_A);
#pragma unroll
    for (int i = 0; i < 8; ++i) yc[(size_t)(b * T_ + qb * 64 + F.wave * 8 + i) * 1024 + 512 + h * 64 + F.lane] = (bf16)f2bf(o[i] / ls[i]);
    __syncthreads();
}
namespace att {
typedef short bf16x8 __attribute__((ext_vector_type(8)));
typedef short s16x4 __attribute__((ext_vector_type(4)));
typedef float f32x16 __attribute__((ext_vector_type(16)));
typedef unsigned u32x4 __attribute__((ext_vector_type(4)));
constexpr int KSLOT = 12288, VSLOT = 8192, NSLOT = 3, LDS_K = 0, LDS_V = NSLOT * KSLOT, LDS_TOTAL = NSLOT * (KSLOT + VSLOT);
__device__ __forceinline__ int crow(int r, int hi) { return (r & 3) + 8 * (r >> 2) + 4 * hi; }
__device__ __forceinline__ s16x4 vtr(const LAS unsigned char* p) { return __builtin_bit_cast(s16x4, __builtin_amdgcn_ds_read_tr16_b64_v4i16((LAS s16x4*)p)); }
__device__ __forceinline__ float xhalf(float v) { return __shfl_xor(v, 32); }
__device__ __forceinline__ unsigned pk(float lo, float hi) { typedef float f2 __attribute__((ext_vector_type(2))); typedef __bf16 b2 __attribute__((ext_vector_type(2))); f2 v = {lo, hi}; b2 b = __builtin_convertvector(v, b2); return __builtin_bit_cast(unsigned, b); }
__device__ __forceinline__ bf16x8 pack8r(const f32x16& x, int s) { u32x4 w; w.x = pk(x[8 * s], x[8 * s + 1]); w.y = pk(x[8 * s + 2], x[8 * s + 3]); w.z = pk(x[8 * s + 4], x[8 * s + 5]); w.w = pk(x[8 * s + 6], x[8 * s + 7]); return __builtin_bit_cast(bf16x8, w); }
#define ATT_MFMA(a, b, c) __builtin_amdgcn_mfma_f32_32x32x16_bf16((a), (b), (c), 0, 0, 0)
__device__ __forceinline__ void attn_unit(Frame& F, int b, int h, int qb) {
    const int lane = F.lane, r32 = lane & 31, hi = lane >> 5, wid = F.wave;
    const size_t rowbase = (size_t)b * T_; const int q0 = qb * 256, qrow = q0 + 32 * wid + r32;
    const bf16* Q = (const bf16*)(F.ws + WS_Q); const bf16* KN = (const bf16*)(F.ws + WS_KN); const bf16* V = (const bf16*)(F.ws + WS_V); const bf16* KPE = (const bf16*)(F.ws + WS_KPE);
    LAS unsigned char* lds = F.lds;
    const int NT = (q0 + 256) / 64;
    const bf16* srcA = KN + (rowbase + lane) * 256 + h * 64 + 8 * wid; const int dstA = LDS_K + wid * 1024;
    const bf16* srcB; int dstB; size_t strB;
    if (wid < 4) { srcB = KPE + (rowbase + lane) * 32 + 8 * wid; dstB = LDS_K + (8 + wid) * 1024; strB = 64 * 32; }
    else { srcB = V + (rowbase + 16 * (wid - 4) + (lane >> 2)) * 256 + h * 64 + 8 * (lane & 3); dstB = LDS_V + (wid - 4) * 1024; strB = 64 * 256; }
    const bf16* srcC = V + (rowbase + 16 * (wid & 3) + (lane >> 2)) * 256 + h * 64 + 32 + 8 * (lane & 3); const int dstC = LDS_V + (4 + (wid & 3)) * 1024;
    const int slotB = wid < 4 ? KSLOT : VSLOT;
#define ATT_DMA(t, s) do { \
        __builtin_amdgcn_global_load_lds((const unsigned*)(srcA + (size_t)(t) * 64 * 256), (LAS unsigned*)(lds + dstA + (s) * KSLOT), 16, 0, 0); \
        __builtin_amdgcn_global_load_lds((const unsigned*)(srcB + (size_t)(t) * strB), (LAS unsigned*)(lds + dstB + (s) * slotB), 16, 0, 0); \
        __builtin_amdgcn_global_load_lds((const unsigned*)(srcC + (size_t)(t) * 64 * 256), (LAS unsigned*)(lds + dstC + (s) * VSLOT), 16, 0, 0); } while (0)
    bf16x8 qr[6];
#pragma unroll
    for (int d0 = 0; d0 < 6; ++d0) qr[d0] = *(const GAS bf16x8*)(Q + (rowbase + qrow) * 384 + h * 96 + 16 * d0 + 8 * hi);
    asm volatile("s_waitcnt vmcnt(0)" ::: "memory");
    ATT_DMA(0, 0); ATT_DMA(1, 1);
    f32x16 o0, o1;
#pragma unroll
    for (int i = 0; i < 16; ++i) { o0[i] = 0.f; o1[i] = 0.f; }
    float m = -INFINITY, l = 0.f;
    const int voff = ((lane >> 4) & 1) * 32 + (lane & 3) * 8 + (4 * hi + ((lane & 15) >> 2)) * 64;
    int slot = 0;
    for (int t = 0; t < NT; ++t) {
        if (t + 1 < NT) asm volatile("s_waitcnt vmcnt(3)" ::: "memory"); else asm volatile("s_waitcnt vmcnt(0)" ::: "memory");
        __builtin_amdgcn_s_barrier(); asm volatile("" ::: "memory");
        if (t + 2 < NT) { const int s2 = slot == 0 ? 2 : slot - 1; ATT_DMA(t + 2, s2); }
        if (64 * t <= q0 + 32 * wid + 31) {
            const LAS unsigned char* kb = lds + LDS_K + slot * KSLOT + hi * 1024 + r32 * 16;
            const LAS unsigned char* vb = lds + LDS_V + slot * VSLOT + voff;
            bf16x8 kf[12]; s16x4 vlo[8], vhi[8];
#pragma unroll
            for (int d0 = 0; d0 < 6; ++d0) { kf[2 * d0] = *(const LAS bf16x8*)(kb + d0 * 2048); kf[2 * d0 + 1] = *(const LAS bf16x8*)(kb + d0 * 2048 + 512); }
#pragma unroll
            for (int i = 0; i < 8; ++i) { vlo[i] = vtr(vb + (i & 1) * 4096 + (i >> 1) * 1024); vhi[i] = vtr(vb + (i & 1) * 4096 + (i >> 1) * 1024 + 512); }
            __builtin_amdgcn_sched_barrier(0);
            f32x16 p0, p1;
#pragma unroll
            for (int i = 0; i < 16; ++i) { p0[i] = 0.f; p1[i] = 0.f; }
#pragma unroll
            for (int d0 = 0; d0 < 6; ++d0) { p0 = ATT_MFMA(kf[2 * d0], qr[d0], p0); p1 = ATT_MFMA(kf[2 * d0 + 1], qr[d0], p1); }
            if (64 * t + 63 > q0 + 32 * wid) {
#pragma unroll
                for (int r = 0; r < 16; ++r) { const int kv = 64 * t + crow(r, hi); if (kv > qrow) p0[r] = -INFINITY; if (kv + 32 > qrow) p1[r] = -INFINITY; }
            }
            float mx = fmaxf(p0[0], p1[0]);
#pragma unroll
            for (int r = 1; r < 16; ++r) mx = fmaxf(mx, fmaxf(p0[r], p1[r]));
            mx = fmaxf(mx, xhalf(mx));
            const float mn = fmaxf(m, mx);
            if (__any(mn > m)) { const float corr = __builtin_amdgcn_exp2f(m - mn); l *= corr;
#pragma unroll
                for (int i = 0; i < 16; ++i) { o0[i] *= corr; o1[i] *= corr; }
                m = mn; }
            float sum = 0.f;
#pragma unroll
            for (int r = 0; r < 16; ++r) { p0[r] = __builtin_amdgcn_exp2f(p0[r] - m); p1[r] = __builtin_amdgcn_exp2f(p1[r] - m); sum += p0[r] + p1[r]; }
            l += sum;
            const bf16x8 pa[4] = {pack8r(p0, 0), pack8r(p0, 1), pack8r(p1, 0), pack8r(p1, 1)};
#pragma unroll
            for (int ks = 0; ks < 4; ++ks) {
                o0 = ATT_MFMA(((bf16x8){vlo[2 * ks][0], vlo[2 * ks][1], vlo[2 * ks][2], vlo[2 * ks][3], vhi[2 * ks][0], vhi[2 * ks][1], vhi[2 * ks][2], vhi[2 * ks][3]}), pa[ks], o0);
                o1 = ATT_MFMA(((bf16x8){vlo[2 * ks + 1][0], vlo[2 * ks + 1][1], vlo[2 * ks + 1][2], vlo[2 * ks + 1][3], vhi[2 * ks + 1][0], vhi[2 * ks + 1][1], vhi[2 * ks + 1][2], vhi[2 * ks + 1][3]}), pa[ks], o1); }
        }
        slot = slot == 2 ? 0 : slot + 1;
    }
    l += xhalf(l);
    const float rl = 1.f / l;
    bf16* yc = (bf16*)(F.ws + WS_A) + (rowbase + qrow) * 1024 + 512 + h * 64;
#pragma unroll
    for (int g = 0; g < 4; ++g) { v2u w0, w1; w0.x = pk(o0[4 * g] * rl, o0[4 * g + 1] * rl); w0.y = pk(o0[4 * g + 2] * rl, o0[4 * g + 3] * rl); w1.x = pk(o1[4 * g] * rl, o1[4 * g + 1] * rl); w1.y = pk(o1[4 * g + 2] * rl, o1[4 * g + 3] * rl);
        *(GAS v2u*)(yc + 8 * g + 4 * hi) = w0; *(GAS v2u*)(yc + 32 + 8 * g + 4 * hi) = w1; }
    asm volatile("s_waitcnt lgkmcnt(0)" ::: "memory"); __builtin_amdgcn_s_barrier(); asm volatile("" ::: "memory");
#undef ATT_DMA
}
#undef ATT_MFMA
}
namespace mix {
typedef short bf16x8 __attribute__((ext_vector_type(8)));
typedef short s16x4 __attribute__((ext_vector_type(4)));
typedef float f32x2 __attribute__((ext_vector_type(2)));
#define MIX_MFMA(a, b, c) __builtin_amdgcn_mfma_f32_16x16x32_bf16((a), (b), (c), 0, 0, 0)
constexpr int XP = 272, BP = 80;
constexpr int LX = 0, LBS = LX + 128 * XP * 2, LCS = LBS + 128 * BP * 2, LDT = LCS + 128 * BP * 2, LACS = LDT + 4 * 128 * 4, LEND = LACS + 4 * 128 * 4;
static_assert(LEND <= RING_BYTES, "SSD LDS map");
__device__ __forceinline__ s16x4 trd(const LAS unsigned char* img, int P, int row0, int col0, int lane) {
    return __builtin_bit_cast(s16x4, __builtin_amdgcn_ds_read_tr16_b64_v4i16((LAS s16x4*)(img + (row0 + ((lane & 15) >> 2)) * P + col0 * 2 + (lane & 3) * 8))); }
#define MIX_CAT(a, b) ((bf16x8){(a)[0], (a)[1], (a)[2], (a)[3], (b)[0], (b)[1], (b)[2], (b)[3]})
__device__ __forceinline__ float softplus(float xv) { const float ev = __expf(xv); return xv > 20.f ? xv : (ev < 0.01f ? ev * (1.f - ev * (0.5f - ev * 0.33333333f)) : __logf(1.f + ev)); }
__device__ __forceinline__ f32x2 gelu_pk(f32x2 v) {
    const f32x2 av = __builtin_elementwise_abs(v), d = av * 0.2316418882f + 1.0f;
    f32x2 t; t.x = __builtin_amdgcn_rcpf(d.x); t.y = __builtin_amdgcn_rcpf(d.y);
    f32x2 q = t * 0.5307027145f + (-0.7265760135f); q = q * t + 0.7107068705f; q = q * t + (-0.142248368f); q = q * t + 0.127414796f; q = q * t;
    const f32x2 s = (v * v) * (-0.72134752044f);
    f32x2 e; e.x = __builtin_amdgcn_exp2f(s.x); e.y = __builtin_amdgcn_exp2f(s.y);
    const f32x2 m = v * (q * e), r = v - m;
    f32x2 o; o.x = v.x < 0.f ? m.x : r.x; o.y = v.y < 0.f ? m.y : r.y; return o;
}
__device__ __forceinline__ void ssd_chunk(Frame& F, const Args& A, int l, int unit) {
    const int g = unit & 1, c = (unit >> 1) & 31, b = unit >> 6; const int row0 = b * T_ + c * 128, tq0 = c * 128;
    const int tid = F.tid, lane = F.lane, w = F.wave, fr = lane & 15, fq = lane >> 4;
    const bf16* proj = (const bf16*)(F.ws + WS_PROJ);
    const float* cw = A.in[I_CONVW] + l * 4 * 768; const float* cb = A.in[I_CONVB] + l * 768;
    LAS unsigned char* lds = F.lds;
    { const int chp = tid & 127, tseg = tid >> 7, cg = 2 * chp, ch = 256 * g + cg;
      float wk[4][2];
#pragma unroll
      for (int k = 0; k < 4; ++k) { wk[k][0] = cw[k * 768 + ch]; wk[k][1] = cw[k * 768 + ch + 1]; }
      const float b0 = cb[ch], b1 = cb[ch + 1];
      unsigned xin[35];
#pragma unroll
      for (int i = 0; i < 35; ++i) { const int tt = tq0 + 32 * tseg - 3 + i; xin[i] = tt >= 0 ? *(const unsigned*)(proj + (size_t)(b * T_ + tt) * NPROJ + PX + ch) : 0u; }
      LAS unsigned char* x0p = lds + LX + (32 * tseg) * XP * 2 + cg * 2;
#pragma unroll
      for (int i = 0; i < 32; i += 2) { float y[2][2];
#pragma unroll
          for (int u = 0; u < 2; ++u) { float a0 = b0, a1 = b1;
#pragma unroll
              for (int k = 0; k < 4; ++k) { a0 += wk[k][0] * bflo(xin[i + u + k]); a1 += wk[k][1] * bfhi(xin[i + u + k]); }
              y[u][0] = silu(a0); y[u][1] = silu(a1); }
          *(LAS unsigned*)(x0p + i * XP * 2) = pk2(y[0][0], y[0][1]); *(LAS unsigned*)(x0p + (i + 1) * XP * 2) = pk2(y[1][0], y[1][1]); } }
    { const int which = tid >> 8, chp = tid & 31, tseg = (tid >> 5) & 7, n0 = 2 * chp, ch = 512 + which * 128 + 64 * g + n0, pcol = (which ? PC : PB) + 64 * g + n0;
      float wk[4][2];
#pragma unroll
      for (int k = 0; k < 4; ++k) { wk[k][0] = cw[k * 768 + ch]; wk[k][1] = cw[k * 768 + ch + 1]; }
      const float b0 = cb[ch], b1 = cb[ch + 1];
      unsigned xin[19];
#pragma unroll
      for (int i = 0; i < 19; ++i) { const int tt = tq0 + 16 * tseg - 3 + i; xin[i] = tt >= 0 ? *(const unsigned*)(proj + (size_t)(b * T_ + tt) * NPROJ + pcol) : 0u; }
      bf16* CC = (bf16*)(F.ws + WS_CC);
#pragma unroll
      for (int i = 0; i < 16; i += 2) { float y[2][2];
#pragma unroll
          for (int u = 0; u < 2; ++u) { float a0 = b0, a1 = b1;
#pragma unroll
              for (int k = 0; k < 4; ++k) { a0 += wk[k][0] * bflo(xin[i + u + k]); a1 += wk[k][1] * bfhi(xin[i + u + k]); }
              y[u][0] = silu(a0); y[u][1] = silu(a1); }
          const int s = 16 * tseg + i;
          const unsigned r0 = pk2(y[0][0], y[0][1]), r1 = pk2(y[1][0], y[1][1]);
          if (which == 0) { *(LAS unsigned*)(lds + LBS + (s * BP + n0) * 2) = r0; *(LAS unsigned*)(lds + LBS + ((s + 1) * BP + n0) * 2) = r1; }
          else { *(LAS unsigned*)(lds + LCS + (s * BP + n0) * 2) = r0; *(LAS unsigned*)(lds + LCS + ((s + 1) * BP + n0) * 2) = r1;
              *(unsigned*)(CC + (size_t)(row0 + s) * 128 + 64 * g + n0) = r0; *(unsigned*)(CC + (size_t)(row0 + s + 1) * 128 + 64 * g + n0) = r1; } } }
    if (w < 4) { const int h = 4 * g + w; const float* dtv = (const float*)(F.ws + WS_DTV); const float bias = A.in[I_DTB][l * 8 + h], Ah = -__expf(A.in[I_ALOG][l * 8 + h]);
        const float d0 = softplus(dtv[(size_t)(row0 + 2 * lane) * 8 + h] + bias), d1 = softplus(dtv[(size_t)(row0 + 2 * lane + 1) * 8 + h] + bias);
        const float a0 = d0 * Ah, a1 = d1 * Ah; float s = a0 + a1;
#pragma unroll
        for (int o = 1; o < 64; o <<= 1) { const float v = __shfl_up(s, o); if (lane >= o) s += v; }
        const float c1 = s, c0 = s - a1;
        LAS float* dts = (LAS float*)(lds + LDT) + w * 128; LAS float* acs = (LAS float*)(lds + LACS) + w * 128;
        dts[2 * lane] = d0; dts[2 * lane + 1] = d1; acs[2 * lane] = c0; acs[2 * lane + 1] = c1;
        float* ACS = (float*)(F.ws + WS_ACS); ACS[(size_t)(row0 + 2 * lane) * 8 + h] = c0; ACS[(size_t)(row0 + 2 * lane + 1) * 8 + h] = c1; }
    __syncthreads();
    f32x4 cbT[8];
    { bf16x8 cf[2];
#pragma unroll
      for (int ks = 0; ks < 2; ++ks) cf[ks] = *(const LAS bf16x8*)(lds + LCS + ((16 * w + fr) * BP + 32 * ks + 8 * fq) * 2);
#pragma unroll
      for (int st = 0; st < 8; ++st) { cbT[st] = (f32x4){0.f, 0.f, 0.f, 0.f};
          {
#pragma unroll
              for (int ks = 0; ks < 2; ++ks) { const bf16x8 bfg = *(const LAS bf16x8*)(lds + LBS + ((16 * st + fr) * BP + 32 * ks + 8 * fq) * 2); cbT[st] = MIX_MFMA(bfg, cf[ks], cbT[st]); } } } }
    const int lrow = 16 * w + fr;
#pragma unroll 1
    for (int r = 0; r < 4; ++r) { const int h = 4 * g + r;
        const LAS float* dts = (const LAS float*)(lds + LDT) + r * 128; const LAS float* acs = (const LAS float*)(lds + LACS) + r * 128;
        const float al = acs[lrow];
        bf16x8 gf[4];
#pragma unroll
        for (int i = 0; i < 4; ++i) { float gv[8];
#pragma unroll
            for (int hf = 0; hf < 2; ++hf) { const int st = 2 * i + hf; const f32x4 a4 = *(const LAS f32x4*)(acs + 16 * st + 4 * fq), d4 = *(const LAS f32x4*)(dts + 16 * st + 4 * fq);
#pragma unroll
                for (int j = 0; j < 4; ++j) { const int s = 16 * st + 4 * fq + j; gv[4 * hf + j] = s <= lrow ? cbT[st][j] * __expf(al - a4[j]) * d4[j] : 0.f; } }
            v4u pw; pw.x = pk2(gv[0], gv[1]); pw.y = pk2(gv[2], gv[3]); pw.z = pk2(gv[4], gv[5]); pw.w = pk2(gv[6], gv[7]); gf[i] = __builtin_bit_cast(bf16x8, pw); }
        const float Dh = A.in[I_SSDD][l * 8 + h];
        const LAS unsigned char* ximg = lds + LX;
        bf16* yc = (bf16*)(F.ws + WS_A) + (size_t)(row0 + lrow) * 1024 + 64 * h;
#pragma unroll
        for (int pt = 0; pt < 4; ++pt) { f32x4 acc = {0.f, 0.f, 0.f, 0.f};
#pragma unroll
            for (int i = 0; i < 4; ++i) { const s16x4 x0 = trd(ximg, XP * 2, 32 * i + 4 * fq, 64 * r + 16 * pt, lane), x1 = trd(ximg, XP * 2, 32 * i + 16 + 4 * fq, 64 * r + 16 * pt, lane);
                acc = MIX_MFMA(MIX_CAT(x0, x1), gf[i], acc); }
            const v2u xl = *(const LAS v2u*)(ximg + (lrow * XP + 64 * r + 16 * pt + 4 * fq) * 2);
            v2u o; o.x = pk2(acc[0] + Dh * bflo(xl.x), acc[1] + Dh * bfhi(xl.x)); o.y = pk2(acc[2] + Dh * bflo(xl.y), acc[3] + Dh * bfhi(xl.y));
            *(v2u*)(yc + 16 * pt + 4 * fq) = o; }
        { const float alast = acs[127]; const int pt = w >> 1; f32x4 s0 = {0.f, 0.f, 0.f, 0.f}, s1 = {0.f, 0.f, 0.f, 0.f};
#pragma unroll
          for (int ks = 0; ks < 4; ++ks) { const s16x4 xlo = trd(ximg, XP * 2, 32 * ks + 8 * fq, 64 * r + 16 * pt, lane), xhi = trd(ximg, XP * 2, 32 * ks + 8 * fq + 4, 64 * r + 16 * pt, lane);
              const v2u xa2 = __builtin_bit_cast(v2u, xlo), xb2 = __builtin_bit_cast(v2u, xhi); v4u xw; xw.x = xa2.x; xw.y = xa2.y; xw.z = xb2.x; xw.w = xb2.y;
              const f32x4 a0 = *(const LAS f32x4*)(acs + 32 * ks + 8 * fq), a1 = *(const LAS f32x4*)(acs + 32 * ks + 8 * fq + 4), d0 = *(const LAS f32x4*)(dts + 32 * ks + 8 * fq), d1 = *(const LAS f32x4*)(dts + 32 * ks + 8 * fq + 4);
              v4u sw; sw.x = pk2(bflo(xw.x) * d0[0] * __expf(alast - a0[0]), bfhi(xw.x) * d0[1] * __expf(alast - a0[1])); sw.y = pk2(bflo(xw.y) * d0[2] * __expf(alast - a0[2]), bfhi(xw.y) * d0[3] * __expf(alast - a0[3]));
              sw.z = pk2(bflo(xw.z) * d1[0] * __expf(alast - a1[0]), bfhi(xw.z) * d1[1] * __expf(alast - a1[1])); sw.w = pk2(bflo(xw.w) * d1[2] * __expf(alast - a1[2]), bfhi(xw.w) * d1[3] * __expf(alast - a1[3]));
              const bf16x8 xa = __builtin_bit_cast(bf16x8, sw);
              const LAS unsigned char* bimg = lds + LBS;
              const bf16x8 bt0 = MIX_CAT(trd(bimg, BP * 2, 32 * ks + 8 * fq, 16 * (2 * (w & 1)), lane), trd(bimg, BP * 2, 32 * ks + 8 * fq + 4, 16 * (2 * (w & 1)), lane));
              const bf16x8 bt1 = MIX_CAT(trd(bimg, BP * 2, 32 * ks + 8 * fq, 16 * (2 * (w & 1) + 1), lane), trd(bimg, BP * 2, 32 * ks + 8 * fq + 4, 16 * (2 * (w & 1) + 1), lane));
              s0 = MIX_MFMA(xa, bt0, s0); s1 = MIX_MFMA(xa, bt1, s1); }
          float* ST = (float*)(F.ws + WS_ST) + (size_t)((b * NCH + c) * 8 + h) * 4096 + (16 * pt + 4 * fq) * 64 + 32 * (w & 1) + fr;
#pragma unroll
          for (int j = 0; j < 4; ++j) { ST[j * 64] = s0[j]; ST[j * 64 + 16] = s1[j]; } }
    }
    __syncthreads();
}
__device__ __forceinline__ void state_scan2(Frame& F) {
    const float* ST = (const float*)(F.ws + WS_ST); const float* ACS = (const float*)(F.ws + WS_ACS); bf16* SB = (bf16*)(F.ws + WS_SB);
    for (int idx = F.bid * NTHR + F.tid; idx < NB * 8 * 4096; idx += F.G * NTHR) { const int pn = idx & 4095, h = (idx >> 12) & 7, b = idx >> 15; float cur = 0.f;
#pragma unroll 4
        for (int c = 0; c < NCH; ++c) { const size_t a = (size_t)((b * NCH + c) * 8 + h) * 4096 + pn; const float s = ST[a]; SB[a] = (bf16)f2bf(cur);
            cur = cur * __expf(ACS[(size_t)(b * T_ + c * 128 + 127) * 8 + h]) + s; } }
}
__device__ __forceinline__ void ssd_finish(Frame& F, const Args& A, int l, int unit, bool dry = false) {
    const int g = unit & 1, c = (unit >> 1) & 31, b = unit >> 6; const int row0 = b * T_ + c * 128;
    const int lane = F.lane, w = F.wave, fr = lane & 15, fq = lane >> 4, lrow = row0 + 16 * w + fr;
    const bf16* proj = (const bf16*)(F.ws + WS_PROJ); const bf16* CC = (const bf16*)(F.ws + WS_CC); const bf16* SB = (const bf16*)(F.ws + WS_SB) + (size_t)((b * NCH + c) * 8 + 4 * g) * 4096;
    bf16x8 cf[2];
#pragma unroll
    for (int ks = 0; ks < 2; ++ks) cf[ks] = *(const bf16x8*)(CC + (size_t)lrow * 128 + 64 * g + 32 * ks + 8 * fq);
    const f32x4 acs4 = *(const f32x4*)((const float*)(F.ws + WS_ACS) + (size_t)lrow * 8 + 4 * g);
    bf16* yc = (bf16*)(F.ws + WS_A) + (size_t)lrow * 1024 + 256 * g + 4 * fq; const bf16* zp = proj + (size_t)lrow * NPROJ + PZ + 256 * g + 4 * fq;
    float gy[4][4][4]; float ss = 0.f;
    bf16x8 sf[2][4][2]; v2u yd[2][4], zz[2][4];
#define SSDF_LOAD(buf, r) do { _Pragma("unroll") for (int pt = 0; pt < 4; ++pt) { _Pragma("unroll") for (int ks = 0; ks < 2; ++ks) sf[buf][pt][ks] = *(const bf16x8*)(SB + (size_t)(r) * 4096 + (16 * pt + fr) * 64 + 32 * ks + 8 * fq); \
        yd[buf][pt] = *(const v2u*)(yc + 64 * (r) + 16 * pt); zz[buf][pt] = *(const v2u*)(zp + 64 * (r) + 16 * pt); } } while (0)
    SSDF_LOAD(0, 0);
#pragma unroll
    for (int r = 0; r < 4; ++r) { const float ea = __expf(acs4[r]); const int cur = r & 1;
        if (r < 3) SSDF_LOAD(cur ^ 1, r + 1);
#pragma unroll
        for (int pt = 0; pt < 4; ++pt) { f32x4 acc = {0.f, 0.f, 0.f, 0.f};
#pragma unroll
            for (int ks = 0; ks < 2; ++ks) acc = MIX_MFMA(sf[cur][pt][ks], cf[ks], acc);
            const float y0 = bflo(yd[cur][pt].x) + ea * acc[0], y1 = bfhi(yd[cur][pt].x) + ea * acc[1], y2 = bflo(yd[cur][pt].y) + ea * acc[2], y3 = bfhi(yd[cur][pt].y) + ea * acc[3];
            gy[r][pt][0] = y0 * silu(bflo(zz[cur][pt].x)); gy[r][pt][1] = y1 * silu(bfhi(zz[cur][pt].x)); gy[r][pt][2] = y2 * silu(bflo(zz[cur][pt].y)); gy[r][pt][3] = y3 * silu(bfhi(zz[cur][pt].y));
            ss += (gy[r][pt][0] * gy[r][pt][0] + gy[r][pt][1] * gy[r][pt][1]) + (gy[r][pt][2] * gy[r][pt][2] + gy[r][pt][3] * gy[r][pt][3]); } }
#undef SSDF_LOAD
    ss += __shfl_xor(ss, 16); ss += __shfl_xor(ss, 32);
    const float rs = 1.f / sqrtf(ss * (1.f / 256.f) + RMS_EPS); const float* nw = A.in[I_SSDNW] + l * 512 + 256 * g + 4 * fq;
#pragma unroll
    for (int r = 0; r < 4; ++r)
#pragma unroll
        for (int pt = 0; pt < 4; ++pt) { const f32x4 n4 = *(const f32x4*)(nw + 64 * r + 16 * pt); v2u o; o.x = pk2(gy[r][pt][0] * rs * n4[0], gy[r][pt][1] * rs * n4[1]); o.y = pk2(gy[r][pt][2] * rs * n4[2], gy[r][pt][3] * rs * n4[3]);
            *(v2u*)((dry ? (bf16*)(F.ws + WS_ST) + (size_t)lrow * 512 + 256 * g + 4 * fq : yc) + 64 * r + 16 * pt) = o; }
}
__device__ __forceinline__ void gmlp(Frame& F, const Args& A, int l, int unit) {
    const int row0 = unit * 128; const int lane = F.lane, w = F.wave, fr = lane & 15, fq = lane >> 4;
    const GAS bf16* proj = (const GAS bf16*)(F.ws + WS_PROJ); LAS unsigned char* lds = F.lds;
    const int trow = row0 + 16 * w + fr; const GAS bf16* GMW = (const GAS bf16*)(F.ws + WS_GMW) + (size_t)l * 4 * 128 * 128;
    v2u wv[16], guv[16]; bf16x8 wf[4][4]; float bs[4];
#pragma unroll
    for (int i = 0; i < 16; ++i) wv[i] = *(const GAS v2u*)(proj + (size_t)(row0 + 16 * w + i) * NPROJ + PGV + 4 * lane);
#pragma unroll
    for (int ct = 0; ct < 16; ++ct) guv[ct] = *(const GAS v2u*)(proj + (size_t)trow * NPROJ + PGU + 16 * ct + 4 * fq);
#pragma unroll
    for (int gi = 0; gi < 4; ++gi) { bs[gi] = A.in[I_GMBS][(l * 4 + gi) * 128 + 16 * w + fr];
#pragma unroll
        for (int ks = 0; ks < 4; ++ks) wf[gi][ks] = *(const GAS bf16x8*)(GMW + ((size_t)gi * 128 + 16 * w + fr) * 128 + 32 * ks + 8 * fq); }
    { const f32x4 lg = *(const f32x4*)(A.in[I_GMLNG] + l * 256 + 4 * lane), lb = *(const f32x4*)(A.in[I_GMLNB] + l * 256 + 4 * lane);
#pragma unroll
      for (int i0 = 0; i0 < 16; i0 += 4) { float v[4][4], sm[4], s2[4];
#pragma unroll
          for (int i = 0; i < 4; ++i) { const f32x2 g0 = gelu_pk((f32x2){bflo(wv[i0 + i].x), bfhi(wv[i0 + i].x)}), g1 = gelu_pk((f32x2){bflo(wv[i0 + i].y), bfhi(wv[i0 + i].y)});
              v[i][0] = g0.x; v[i][1] = g0.y; v[i][2] = g1.x; v[i][3] = g1.y; sm[i] = (v[i][0] + v[i][1]) + (v[i][2] + v[i][3]); }
#pragma unroll
          for (int o = 1; o < 64; o <<= 1) {
#pragma unroll
              for (int i = 0; i < 4; ++i) sm[i] += __shfl_xor(sm[i], o); }
#pragma unroll
          for (int i = 0; i < 4; ++i) { const float mean = sm[i] * (1.f / 256.f); s2[i] = 0.f;
#pragma unroll
              for (int k = 0; k < 4; ++k) { v[i][k] -= mean; s2[i] += v[i][k] * v[i][k]; } }
#pragma unroll
          for (int o = 1; o < 64; o <<= 1) {
#pragma unroll
              for (int i = 0; i < 4; ++i) s2[i] += __shfl_xor(s2[i], o); }
#pragma unroll
          for (int i = 0; i < 4; ++i) { const float rstd = 1.f / sqrtf(s2[i] * (1.f / 256.f) + LN_EPS); const int sr = 16 * w + i0 + i;
              v2u o; o.x = pk2(v[i][0] * rstd * lg[0] + lb[0], v[i][1] * rstd * lg[1] + lb[1]); o.y = pk2(v[i][2] * rstd * lg[2] + lb[2], v[i][3] * rstd * lg[3] + lb[3]); *(LAS v2u*)(lds + (sr * XP + 4 * lane) * 2) = o; } } }
    __syncthreads();
    GAS bf16* yc = (GAS bf16*)(F.ws + WS_A) + (size_t)trow * 1024 + 768 + 4 * fq;
#pragma unroll
    for (int ct = 0; ct < 16; ++ct) { f32x4 acc = {0.f, 0.f, 0.f, 0.f};
#pragma unroll
        for (int ks = 0; ks < 4; ++ks) { const bf16x8 vf = MIX_CAT(trd(lds, XP * 2, 32 * ks + 8 * fq, 16 * ct, lane), trd(lds, XP * 2, 32 * ks + 8 * fq + 4, 16 * ct, lane)); acc = MIX_MFMA(vf, wf[ct >> 2][ks], acc); }
        const f32x2 g0 = gelu_pk((f32x2){bflo(guv[ct].x), bfhi(guv[ct].x)}), g1 = gelu_pk((f32x2){bflo(guv[ct].y), bfhi(guv[ct].y)}); const float bb = bs[ct >> 2];
        v2u o; o.x = pk2(g0.x * (acc[0] + bb), g0.y * (acc[1] + bb)); o.y = pk2(g1.x * (acc[2] + bb), g1.y * (acc[3] + bb)); *(GAS v2u*)(yc + 16 * ct) = o; }
    __syncthreads();
}
#undef MIX_MFMA
#undef MIX_CAT
}
__device__ __forceinline__ void moe_offsets(Frame& F, int (&poff)[9]) {
    int acc = 0;
#pragma unroll
    for (int e = 0; e < 8; ++e) { const int c = (int)__hip_atomic_load(F.ctl + CW_CNT + e * 64, RLX_AGENT); poff[e] = acc; acc += (c + 255) >> 8; }
    poff[8] = acc;
}
__device__ __forceinline__ void moe_permute(Frame& F) {
    int poff[9]; moe_offsets(F, poff);
    const int* re = (const int*)(F.ws + WS_ROUTE); int* rs = (int*)(F.ws + WS_ROUTE) + 2 * M_;
    const bf16* hb = (const bf16*)(F.ws + WS_A); unsigned char* hp = F.ws + WS_HP;
    const int gwv = F.bid * NWAVES + F.wave, NGW = F.G * NWAVES;
    for (int m = gwv; m < M_; m += NGW) {
        const GAS v4u* src = (const GAS v4u*)(hb + (size_t)m * 1024);
        const v4u c0 = src[2 * F.lane], c1 = src[2 * F.lane + 1]; v4u o;
        o.x = pg8::fp8x4((f32x4){bflo(c0.x), bfhi(c0.x), bflo(c0.y), bfhi(c0.y)}); o.y = pg8::fp8x4((f32x4){bflo(c0.z), bfhi(c0.z), bflo(c0.w), bfhi(c0.w)});
        o.z = pg8::fp8x4((f32x4){bflo(c1.x), bfhi(c1.x), bflo(c1.y), bfhi(c1.y)}); o.w = pg8::fp8x4((f32x4){bflo(c1.z), bfhi(c1.z), bflo(c1.w), bfhi(c1.w)});
#pragma unroll
        for (int k = 0; k < 2; ++k) { const int e = re[k * M_ + m], sl = rs[k * M_ + m]; int po = 0;
#pragma unroll
            for (int q = 0; q < 8; ++q) po = (e == q) ? poff[q] : po;
            const int prow = po * 256 + sl;
            ((GAS v4u*)(hp + (size_t)prow * 1024))[F.lane] = o;
            if (F.lane == 0) rs[k * M_ + m] = prow; }
    }
}
__device__ __forceinline__ void ln_moe_final(Frame& F, const Args& A, const float* g, const float* bt, int ls, bool dry) {
    const int gwv = F.bid * NWAVES + F.wave, NGW = F.G * NWAVES;
    const float* mod = (const float*)(F.ws + WS_MOD); const int* rs = (const int*)(F.ws + WS_ROUTE) + 2 * M_; const float* rg = (const float*)(F.ws + WS_ROUTE) + 4 * M_;
    const bf16* yp = (const bf16*)(F.ws + WS_YP); const bf16* xs = (const bf16*)(F.ws + WS_XS);
    for (int m = gwv * 2; m < M_; m += NGW * 2) { f32x4 x[2][4];
#pragma unroll
        for (int i = 0; i < 2; ++i) { const int p0 = rs[m + i], p1 = rs[M_ + m + i]; const float g0 = rg[m + i], g1 = rg[M_ + m + i];
            f32x4 xv[4], y0[4], y1[4]; load_row(nullptr, xs + (size_t)(m + i) * 1024, xv, F.lane); load_row(nullptr, yp + (size_t)p0 * 1024, y0, F.lane); load_row(nullptr, yp + (size_t)p1 * 1024, y1, F.lane);
            const float* gt = mod + ((size_t)ls * 8 + ((m + i) >> 12)) * 3072 + 2048;
#pragma unroll
            for (int j = 0; j < 4; ++j) { const f32x4 gv = *(const GAS f32x4*)(gt + lcol(F.lane, j)); x[i][j] = xv[j] * DN_ALPHA + (gv + 1.f) * (y0[j] * g0 + y1[j] * g1); } }
        ln_rows<2>(g, bt, x, F.lane);
#pragma unroll
        for (int i = 0; i < 2; ++i) store_rows(x[i], nullptr, (dry ? (float*)(F.ws + WS_PROJ) : F.out) + (size_t)(m + i) * 1024, nullptr, mod, F.lane);
    }
}
constexpr int N_PHASES = 21;
#define MODP ((const float*)(F.ws + WS_MOD))
#define HA ((bf16*)(F.ws + WS_A))
#define PROJ ((bf16*)(F.ws + WS_PROJ))
#ifndef PHMASK
#define PHMASK 0x7FFF
#endif
#define EN(k) (((PHMASK) >> (k)) & 1)
#ifndef PROBE_SITE
#define PROBE_SITE -1
#endif
#define NREP(k) ((PROBE_SITE) == (k) ? 2 : 1)
__global__ void __launch_bounds__(NTHR, 2) fwd_kernel(Args args) {
    extern __shared__ __attribute__((aligned(16))) unsigned char lds[];
    Frame F0;
    F0.lds = (LAS unsigned char*)lds; F0.tid = threadIdx.x; F0.lane = F0.tid & 63; F0.wave = __builtin_amdgcn_readfirstlane(F0.tid >> 6);
    F0.G = gridDim.x; F0.bid = blockIdx.x; F0.ws = args.ws; F0.ctl = (gu32*)(args.ws + WS_CTL); F0.out = args.out;
    for (int u = F0.tid; u < (LDS_BYTES - LDSCTL_OFF) / 4; u += NTHR) ((LAS unsigned*)(F0.lds + LDSCTL_OFF))[u] = 0u;
    __syncthreads();
#if N_LAUNCH_MODE == 0
    XcdBarrier bar = xcd_barrier_post((unsigned*)(F0.ctl + CW_BAR), (volatile LAS unsigned*)(F0.lds + MISC_OFF) + 8);
#define GRID_BAR() do { const Frame Fb = phase_frame(F0); xcd_barrier(bar, Fb.tid == 0); } while (0)
#else
#define GRID_BAR() do {} while (0)
#endif
    const int lo = args.ph_lo, hi = args.ph_hi;
#define IN(k) (lo <= (k) && (k) < hi)
#define SEAM(k) do { if (IN(k) && IN((k) + 1)) GRID_BAR(); } while (0)

    if (EN(0) && IN(0)) for (int rep = 0; rep < NREP(0); ++rep) { Frame F = phase_frame(F0); const bool dry = rep > 0; (void)dry; p0a(F, args); } SEAM(0);
    if (EN(1) && IN(1)) for (int rep = 0; rep < NREP(1); ++rep) { Frame F = phase_frame(F0); const bool dry = rep > 0; (void)dry; ln_phase(F, args, args.in[I_X], args.in[I_LN0G], args.in[I_LN0B], 0, false, false); } SEAM(1);

    for (int l = 0; l < 2; ++l) {
        const int base = l == 0 ? 2 : 11;
        if (EN(2) && IN(base + 0)) for (int rep = 0; rep < NREP(2); ++rep) { Frame F = phase_frame(F0); const bool dry = rep > 0; (void)dry;
            pg8::Gemm g{HA, (const bf16*)(F.ws + WS_WIN + l * WIN_BYTES), M_, NPROJ, 1024, 1024, 0, 0}; pg8::StaticOrder S; S.init(M_, NPROJ, F.G, F.bid);
            pg8::EpiProj E{PROJ, (float*)(F.ws + WS_DTV)};
            pg8::gemm_phase<pg8::EpiProj, pg8::StaticOrder, true, true>(F.lds + RING_OFF, g, S, E, F.tid);
        } SEAM(base + 0);
#if PROBE_SITE == 100
        for (int xb = 0; xb < 8; ++xb) GRID_BAR();
#endif
        if (EN(3) && IN(base + 1)) for (int rep = 0; rep < NREP(3); ++rep) { Frame F = phase_frame(F0); const bool dry = rep > 0; (void)dry;
            token_local(F);
#if PROBE_SITE == 31
            token_local(F);
#endif
#ifdef MIX_NAIVE
            for (int u = F.bid; u < NB * NCH * 8; u += F.G) ssd_chunk_naive(F, args, l, u);
            for (int u = F.bid; u < NB * NCH; u += F.G) gmlp_naive(F, args, l, u);
#else
            for (int u = F.bid; u < NB * NCH * 2; u += F.G) mix::ssd_chunk(F, args, l, u);
#if PROBE_SITE == 32
            for (int u = F.bid; u < NB * NCH * 2; u += F.G) mix::ssd_chunk(F, args, l, u);
#endif
            for (int u = F.bid; u < NB * NCH; u += F.G) mix::gmlp(F, args, l, u);
#if PROBE_SITE == 33
            for (int u = F.bid; u < NB * NCH; u += F.G) mix::gmlp(F, args, l, u);
#endif
#endif
        } SEAM(base + 1);
        if (EN(4) && IN(base + 2)) for (int rep = 0; rep < NREP(4); ++rep) { Frame F = phase_frame(F0); const bool dry = rep > 0; (void)dry;
#ifdef MIX_NAIVE
            state_scan(F);
#else
            mix::state_scan2(F);
#endif
            { pg8::Gemm g{PROJ + PQ, (const bf16*)(F.ws + WS_WQB + l * WQB_BYTES), M_, 1024, 256, NPROJ, WS_WKVB - WS_WQB, (size_t)(PKV - PQ) * 2}; pg8::QkvOrder S; S.init(M_, 1024, F.G, F.bid);
              pg8::EpiQKV E{{(bf16*)(F.ws + WS_Q), (const float*)(F.ws + WS_RSTD), (const float*)(F.ws + WS_ROPE), (const float*)(F.ws + WS_ROPE) + 4096 * 16, QSCALE},
                            {(bf16*)(F.ws + WS_KN), (bf16*)(F.ws + WS_V), (const float*)(F.ws + WS_RSTD) + M_}};
              pg8::gemm_phase<pg8::EpiQKV, pg8::QkvOrder, true, true>(F.lds + RING_OFF, g, S, E, F.tid); }
        } SEAM(base + 2);
        if (EN(5) && IN(base + 3)) for (int rep = 0; rep < NREP(5); ++rep) { Frame F = phase_frame(F0); const bool dry = rep > 0; (void)dry;
#ifdef MIX_NAIVE
            for (int u = F.bid; u < NB * NCH * 2; u += F.G) ssd_finish_naive(F, args, l, u);
#else
#if PROBE_SITE == 55
            for (int u = F.bid; u < NB * NCH * 2; u += F.G) mix::ssd_finish(F, args, l, u, true);
#endif
            if (!dry) for (int u = F.bid; u < NB * NCH * 2; u += F.G) mix::ssd_finish(F, args, l, u);
#endif
#ifdef ATTN_NAIVE
            for (int u = F.bid; u < NB * 4 * 64; u += F.G) attn_naive(F, u);
#else
            for (int v = F.bid; v < NB * 4 * 8; v += F.G) { const int bh = v >> 3, s = v & 7; att::attn_unit(F, bh >> 2, bh & 3, s); att::attn_unit(F, bh >> 2, bh & 3, 15 - s); }
#endif
        } SEAM(base + 3);
        if (EN(6) && IN(base + 4)) for (int rep = 0; rep < NREP(6); ++rep) { Frame F = phase_frame(F0); const bool dry = rep > 0; (void)dry;
            pg8::Gemm g{HA, (const bf16*)(F.ws + WS_WOUT + l * WOUT_BYTES), M_, 1024, 1024, 1024, 0, 0}; pg8::StaticOrder S; S.init(M_, 1024, F.G, F.bid);
            pg8::EpiResid E{(bf16*)(F.ws + WS_XS), MODP + (size_t)((l * 2 + 0) * 8) * 3072 + 2048, DN_ALPHA, dry, 1.f};
            pg8::gemm_phase<pg8::EpiResid, pg8::StaticOrder, true, true>(F.lds + RING_OFF, g, S, E, F.tid);
        } SEAM(base + 4);
        if (EN(7) && IN(base + 5)) for (int rep = 0; rep < NREP(7); ++rep) { Frame F = phase_frame(F0); const bool dry = rep > 0; (void)dry; ln_phase(F, args, nullptr, args.in[I_PLG] + (l * 2 + 0) * 1024, args.in[I_PLB] + (l * 2 + 0) * 1024, l * 2 + 1, l == 1, dry); } SEAM(base + 5);
        if (l == 0) {
            if (EN(9) && IN(base + 6)) for (int rep = 0; rep < NREP(9); ++rep) { Frame F = phase_frame(F0);
                pg8::Gemm g{HA, (const bf16*)(F.ws + WS_W13), M_, 5632, 1024, 1024, 0, 0}; pg8::StaticOrder S; S.init(M_, 5632, F.G, F.bid);
                pg8::EpiSwiGLU E{(void*)(F.ws + WS_ACT), FF, 1.f, 0.f};
                pg8::gemm_phase<pg8::EpiSwiGLU, pg8::StaticOrder, true, true, 2>(F.lds + RING_OFF, g, S, E, F.tid);
            } SEAM(base + 6);
            if (EN(10) && IN(base + 7)) for (int rep = 0; rep < NREP(10); ++rep) { Frame F = phase_frame(F0); const bool dry = rep > 0;
                pg8::Gemm g{(const bf16*)(F.ws + WS_ACT), (const bf16*)(F.ws + WS_W2), M_, 1024, FF, FF, 0, 0}; pg8::StaticOrder S; S.init(M_, 1024, F.G, F.bid);
                pg8::EpiResid E{(bf16*)(F.ws + WS_XS), MODP + (size_t)((l * 2 + 1) * 8) * 3072 + 2048, DN_ALPHA, dry, 1.f};
                pg8::gemm_phase<pg8::EpiResid, pg8::StaticOrder, true, true, 2>(F.lds + RING_OFF, g, S, E, F.tid);
            } SEAM(base + 7);
            if (EN(11) && IN(base + 8)) for (int rep = 0; rep < NREP(11); ++rep) { Frame F = phase_frame(F0); const bool dry = rep > 0;
                ln_phase(F, args, nullptr, args.in[I_PLG] + (l * 2 + 1) * 1024, args.in[I_PLB] + (l * 2 + 1) * 1024, 2, false, dry); } SEAM(base + 8);
        } else {
            if (EN(8) && IN(base + 6)) for (int rep = 0; rep < NREP(8); ++rep) { Frame F = phase_frame(F0); moe_permute(F); } SEAM(base + 6);
            if (EN(12) && IN(base + 7)) for (int rep = 0; rep < NREP(12); ++rep) { Frame F = phase_frame(F0);
                pg8::MoeOrder S; moe_offsets(F, S.poff); const int npan = S.poff[8]; S.init(npan * 256, 5632, F.G, F.bid);
                pg8::Gemm g{(const bf16*)(F.ws + WS_HP), (const bf16*)(F.ws + WS_MW13), npan * 256, 5632, 1024, 1024, W13_BYTES / 2, 0};
                pg8::EpiSwiGLU E{(void*)(F.ws + WS_ACTM), FF, 1.f / 32.f, 8.f};
                pg8::gemm_phase<pg8::EpiSwiGLU, pg8::MoeOrder, true, true, 1>(F.lds + RING_OFF, g, S, E, F.tid);
            } SEAM(base + 7);
            if (EN(13) && IN(base + 8)) for (int rep = 0; rep < NREP(13); ++rep) { Frame F = phase_frame(F0);
                pg8::MoeOrder S; moe_offsets(F, S.poff); const int npan = S.poff[8]; S.init(npan * 256, 1024, F.G, F.bid);
                pg8::Gemm g{(const bf16*)(F.ws + WS_ACTM), (const bf16*)(F.ws + WS_MW2), npan * 256, 1024, FF, FF, W2_BYTES / 2, 0};
                pg8::EpiY E{(bf16*)(F.ws + WS_YP), 1024, 1.f / 1024.f};
                pg8::gemm_phase<pg8::EpiY, pg8::MoeOrder, true, true, 1>(F.lds + RING_OFF, g, S, E, F.tid);
            } SEAM(base + 8);
            if (EN(14) && IN(base + 9)) for (int rep = 0; rep < NREP(14); ++rep) { Frame F = phase_frame(F0); const bool dry = rep > 0;
                ln_moe_final(F, args, args.in[I_PLG] + (l * 2 + 1) * 1024, args.in[I_PLB] + (l * 2 + 1) * 1024, l * 2 + 1, dry); }
        }
    }
}

extern "C" void kernel_launch(void* const* d_in, const int* in_sizes, int n_in, void* d_out, int out_size, void* d_ws, size_t ws_size, hipStream_t stream) {
    static int grid = 0;
    if (grid == 0) {
        if (n_in != 31 || out_size != M_ * D_ || ws_size < WS_END) { fprintf(stderr, "kernel_launch: unexpected shapes (n_in %d, out %d, ws %zu)\n", n_in, out_size, ws_size); grid = -1; return; }
        int dev = 0, cus = 0;
        if (hipGetDevice(&dev) != hipSuccess || hipDeviceGetAttribute(&cus, hipDeviceAttributeMultiprocessorCount, dev) != hipSuccess) { grid = -1; return; }
        if (hipFuncSetAttribute((const void*)fwd_kernel, hipFuncAttributeMaxDynamicSharedMemorySize, LDS_BYTES) != hipSuccess) { fprintf(stderr, "kernel_launch: hipFuncSetAttribute failed\n"); grid = -1; return; }
        int per_cu = 0;
        if (hipOccupancyMaxActiveBlocksPerMultiprocessor(&per_cu, (const void*)fwd_kernel, NTHR, LDS_BYTES) != hipSuccess || per_cu < 1) fprintf(stderr, "kernel_launch: occupancy query reports %d\n", per_cu);
        (void)hipGetLastError();
        grid = cus;
    }
    if (grid < 0) return;
    (void)hipMemsetAsync((char*)d_ws + WS_CTL, 0, CTL_ZERO_BYTES, stream);
    Args a{};
    for (int i = 0; i < 31; ++i) a.in[i] = (const float*)d_in[i];
    a.out = (float*)d_out; a.ws = (unsigned char*)d_ws;
#if N_LAUNCH_MODE == 0
    a.ph_lo = 0; a.ph_hi = N_PHASES;
    hipLaunchKernelGGL(fwd_kernel, dim3(grid), dim3(NTHR), LDS_BYTES, stream, a);
#else
    for (int p = 0; p < N_PHASES; ++p) { a.ph_lo = p; a.ph_hi = p + 1; hipLaunchKernelGGL(fwd_kernel, dim3(grid), dim3(NTHR), LDS_BYTES, stream, a); }
#endif
}
```

```cpp
#include <hip/hip_runtime.h>
#include <cstdio>
#include <cstdint>
#ifndef MOE_FP8
#define MOE_FP8 1
#endif
#define DENSE_FP8 0
#ifndef N_LAUNCH_MODE
#define N_LAUNCH_MODE 0
#endif
namespace pg8 {
#define PG8_LAS __attribute__((address_space(3)))
typedef unsigned short bf16_t;
typedef short bf16x8 __attribute__((ext_vector_type(8)));
typedef float f32x4 __attribute__((ext_vector_type(4)));
typedef unsigned u32x4 __attribute__((ext_vector_type(4)));
typedef int i32x4 __attribute__((ext_vector_type(4)));
typedef int i32x8 __attribute__((ext_vector_type(8)));
constexpr int BM = 256, BK = 64, HALF = 128, HTB = HALF * BK * 2  , STAGE_BYTES = 8 * HTB, NXCD = 8, WGM = 8;

__host__ __device__ __forceinline__ int lds_byte(int r, int c) { const int st = (r >> 4) * 2 + (c >> 5), rr = r & 15, cc = c & 31, ob = rr * 64 + cc * 2; return st * 1024 + (ob ^ (((ob >> 9) & 1) << 5)); }
__host__ __device__ __forceinline__ void stage_rc(int b, int& R, int& C) { const int st = b / 1024, sb = b % 1024, swz = sb ^ (((sb >> 9) & 1) << 5); R = (st >> 1) * 16 + swz / 64; C = (st & 1) * 32 + (swz % 64) / 2; }
__host__ __device__ __forceinline__ int perm32(int rho) { const int n = rho >> 4, i = rho & 15; return 8 * (i >> 2) + 4 * n + (i & 3); }

struct Unit { int pm, pn, e; };
struct Gemm { const bf16_t* A; const bf16_t* Bt; int M, N, K, lda; size_t estride, aestride; };

struct StaticOrder {
    int nM, nN, nwg, G, c;
    __host__ __device__ void init(int M, int N, int G_, int c_) { nM = M / BM; nN = N / BM; nwg = nM * nN; G = G_; c = c_; }
    __host__ __device__ bool next(int i, Unit& u) const {
        const long L = (long)i * G + c; if (L >= nwg) return false;
        int wgid = (int)L; { const int q = nwg / NXCD, r = nwg % NXCD, xcd = wgid % NXCD, off = wgid / NXCD; wgid = (xcd < r ? xcd * (q + 1) : r * (q + 1) + (xcd - r) * q) + off; }
        const int nig = WGM * nN, gid = wgid / nig, fm = gid * WGM, gsz = (nM - fm) < WGM ? (nM - fm) : WGM;
        u.pm = fm + ((wgid % nig) % gsz); u.pn = (wgid % nig) / gsz; u.e = 0; return true;
    }
    __device__ __forceinline__ void a_ready(const Unit&) const {}
    __device__ __forceinline__ void done(const Unit&) const {}
};
struct MoeOrder : StaticOrder {
    int poff[9];
    __device__ bool next(int i, Unit& u) const {
        if (!StaticOrder::next(i, u)) return false;
        int e = 0;
#pragma unroll
        for (int k = 1; k < 8; ++k) e += (u.pm >= poff[k]) ? 1 : 0;
        u.e = e; return true;
    }
};
struct QkvOrder : StaticOrder {
    __device__ bool next(int i, Unit& u) const { if (!StaticOrder::next(i, u)) return false; u.e = u.pn >> 1; u.pn &= 1; return true; }
};
__device__ __forceinline__ unsigned cvt_pk_bf16(float lo, float hi) { unsigned r; asm volatile("v_cvt_pk_bf16_f32 %0, %1, %2" : "=v"(r) : "v"(lo), "v"(hi)); return r; }
typedef float f32x2 __attribute__((ext_vector_type(2)));
__device__ __forceinline__ u32x4 pack8(const f32x4 v0, const f32x4 v1) { u32x4 w; w.x = cvt_pk_bf16(v0[0], v0[1]); w.y = cvt_pk_bf16(v0[2], v0[3]); w.z = cvt_pk_bf16(v1[0], v1[1]); w.w = cvt_pk_bf16(v1[2], v1[3]); return w; }
__device__ __forceinline__ float silu_f(float a) { return a * __builtin_amdgcn_rcpf(1.f + __expf(-a)); }
__device__ __forceinline__ float q8(float x) { x = fminf(fmaxf(x, -448.f), 448.f); const int p = __builtin_amdgcn_cvt_pk_fp8_f32(x, x, 0, false); return __builtin_amdgcn_cvt_f32_fp8(p, 0); }
__device__ __forceinline__ float clamp8(float x) { return fminf(fmaxf(x, -448.f), 448.f); }
__device__ __forceinline__ unsigned fp8x4(const f32x4 v) { int p = __builtin_amdgcn_cvt_pk_fp8_f32(clamp8(v[0]), clamp8(v[1]), 0, false); p = __builtin_amdgcn_cvt_pk_fp8_f32(clamp8(v[2]), clamp8(v[3]), p, true); return (unsigned)p; }

struct EpiProj {
    static constexpr bool PERM = true, AFTER_DRAIN = false;
    bf16_t* O; float* dtv;
    __device__ __forceinline__ void operator()(const f32x4 (&acc)[2][2][4][2], const Unit& u, int wr, int wc, int fr, int fq) const {
        const int row0 = u.pm * BM + wr * 64 + fr, col0 = u.pn * BM + wc * 32 + 8 * fq;
#pragma unroll
        for (int ai = 0; ai < 2; ++ai)
#pragma unroll
            for (int m = 0; m < 4; ++m) { bf16_t* rowp = O + (size_t)(row0 + ai * HALF + m * 16) * 2304 + col0;
#pragma unroll
                for (int bj = 0; bj < 2; ++bj) *(u32x4*)(rowp + bj * HALF) = pack8(acc[ai][bj][m][0], acc[ai][bj][m][1]); }
        if (u.pn == 6 && wc == 1 && fq == 0) {
#pragma unroll
            for (int ai = 0; ai < 2; ++ai)
#pragma unroll
                for (int m = 0; m < 4; ++m) { float* dp = dtv + (size_t)(row0 + ai * HALF + m * 16) * 8; *(f32x4*)dp = acc[ai][1][m][0]; *(f32x4*)(dp + 4) = acc[ai][1][m][1]; }
        }
    }
};
struct EpiQ {
    static constexpr bool PERM = true, AFTER_DRAIN = false;
    bf16_t* Q; const float* rstd; const float* ropec; const float* ropes; float qscale;
    __device__ __forceinline__ void operator()(const f32x4 (&acc)[2][2][4][2], const Unit& u, int wr, int wc, int fr, int fq) const {
        const int row0 = u.pm * BM + wr * 64 + fr;
#pragma unroll
        for (int bj = 0; bj < 2; ++bj) { const int lc = bj * HALF + wc * 32 + 8 * fq; if (lc >= 192) continue;
            const int hc = lc % 96, g = (hc - 64) >> 3;
#pragma unroll
            for (int ai = 0; ai < 2; ++ai)
#pragma unroll
                for (int m = 0; m < 4; ++m) { const int row = row0 + ai * HALF + m * 16; const float s = rstd[row] * qscale; f32x4 v0 = acc[ai][bj][m][0] * s, v1 = acc[ai][bj][m][1] * s;
                    if (hc >= 64) { const int t = row & 4095; const f32x4 c4 = *(const f32x4*)(ropec + t * 16 + 4 * g), s4 = *(const f32x4*)(ropes + t * 16 + 4 * g);
                        const f32x4 o0 = v0 * c4 - v1 * s4, o1 = v0 * s4 + v1 * c4; v0 = o0; v1 = o1; }
                    *(u32x4*)(Q + (size_t)row * 384 + u.pn * 192 + lc) = pack8(v0, v1); asm volatile("" ::: "memory"); } }
    }
};
struct EpiKV {
    static constexpr bool PERM = true, AFTER_DRAIN = false;
    bf16_t* KN; bf16_t* V; const float* rstd;
    __device__ __forceinline__ void operator()(const f32x4 (&acc)[2][2][4][2], const Unit& u, int wr, int wc, int fr, int fq) const {
        const int row0 = u.pm * BM + wr * 64 + fr, col0 = wc * 32 + 8 * fq; bf16_t* base = u.pn == 0 ? KN : V;
#pragma unroll
        for (int ai = 0; ai < 2; ++ai)
#pragma unroll
            for (int m = 0; m < 4; ++m) { const int row = row0 + ai * HALF + m * 16; const float s = rstd[row];
#pragma unroll
                for (int bj = 0; bj < 2; ++bj) *(u32x4*)(base + (size_t)row * 256 + col0 + bj * HALF) = pack8(acc[ai][bj][m][0] * s, acc[ai][bj][m][1] * s); }
    }
};
struct EpiQKV {
    static constexpr bool PERM = true, AFTER_DRAIN = false;
    EpiQ q; EpiKV kv;
    __device__ __forceinline__ void operator()(const f32x4 (&acc)[2][2][4][2], const Unit& u, int wr, int wc, int fr, int fq) const { if (u.e == 0) q(acc, u, wr, wc, fr, fq); else kv(acc, u, wr, wc, fr, fq); }
};
struct EpiSwiGLU {
    static constexpr bool PERM = true, AFTER_DRAIN = false;
    void* O; int ldo; float ain, qs;
    __device__ __forceinline__ void operator()(const f32x4 (&acc)[2][2][4][2], const Unit& u, int wr, int wc, int fr, int fq) const {
        const int row0 = u.pm * BM + wr * 64 + fr, col0 = u.pn * HALF + wc * 32 + 8 * fq;
#pragma unroll
        for (int ai = 0; ai < 2; ++ai)
#pragma unroll
            for (int m = 0; m < 4; ++m) { const f32x4 a0 = acc[ai][0][m][0] * ain, a1 = acc[ai][0][m][1] * ain, g0 = acc[ai][1][m][0] * ain, g1 = acc[ai][1][m][1] * ain;
                const f32x4 r0 = {silu_f(a0[0]) * g0[0], silu_f(a0[1]) * g0[1], silu_f(a0[2]) * g0[2], silu_f(a0[3]) * g0[3]}, r1 = {silu_f(a1[0]) * g1[0], silu_f(a1[1]) * g1[1], silu_f(a1[2]) * g1[2], silu_f(a1[3]) * g1[3]};
                const size_t off = (size_t)(row0 + ai * HALF + m * 16) * ldo + col0;
                if (qs == 0.f) *(u32x4*)((bf16_t*)O + off) = pack8(r0, r1);
                else { typedef unsigned u32x2 __attribute__((ext_vector_type(2))); u32x2 w; w.x = fp8x4(r0 * qs); w.y = fp8x4(r1 * qs); *(u32x2*)((unsigned char*)O + off) = w; } }
    }
};
struct EpiY {
    static constexpr bool PERM = true, AFTER_DRAIN = false;
    bf16_t* O; int ldo; float ascale;
    __device__ __forceinline__ void operator()(const f32x4 (&acc)[2][2][4][2], const Unit& u, int wr, int wc, int fr, int fq) const {
        const int row0 = u.pm * BM + wr * 64 + fr, col0 = u.pn * BM + wc * 32 + 8 * fq;
#pragma unroll
        for (int ai = 0; ai < 2; ++ai)
#pragma unroll
            for (int m = 0; m < 4; ++m) { bf16_t* rowp = O + (size_t)(row0 + ai * HALF + m * 16) * ldo + col0;
#pragma unroll
                for (int bj = 0; bj < 2; ++bj) *(u32x4*)(rowp + bj * HALF) = pack8(acc[ai][bj][m][0] * ascale, acc[ai][bj][m][1] * ascale); }
    }
};
struct EpiResid {
    static constexpr bool PERM = true, AFTER_DRAIN = false;
    bf16_t* X; const float* gate; float xscale; bool dry; float ascale;
    __device__ __forceinline__ void operator()(const f32x4 (&acc)[2][2][4][2], const Unit& u, int wr, int wc, int fr, int fq) const {
        const int row0 = u.pm * BM + wr * 64 + fr, col0 = u.pn * BM + wc * 32 + 8 * fq;
        const float* gp = gate + (size_t)((u.pm * BM) >> 12) * 3072 + col0;
        f32x4 gv[2][2];
#pragma unroll
        for (int bj = 0; bj < 2; ++bj) { gv[bj][0] = *(const f32x4*)(gp + bj * HALF) + 1.f; gv[bj][1] = *(const f32x4*)(gp + bj * HALF + 4) + 1.f; }
#pragma unroll
        for (int ai = 0; ai < 2; ++ai)
#pragma unroll
            for (int m = 0; m < 4; ++m) { bf16_t* xp = X + (size_t)(row0 + ai * HALF + m * 16) * 1024 + col0;
#pragma unroll
                for (int bj = 0; bj < 2; ++bj) { const u32x4 o = *(const u32x4*)(xp + bj * HALF);
                    const f32x4 o0 = {__uint_as_float(o.x << 16), __uint_as_float(o.x & 0xffff0000u), __uint_as_float(o.y << 16), __uint_as_float(o.y & 0xffff0000u)}, o1 = {__uint_as_float(o.z << 16), __uint_as_float(o.z & 0xffff0000u), __uint_as_float(o.w << 16), __uint_as_float(o.w & 0xffff0000u)};
                    if (!dry) *(u32x4*)(xp + bj * HALF) = pack8(o0 * xscale + gv[bj][0] * (acc[ai][bj][m][0] * ascale), o1 * xscale + gv[bj][1] * (acc[ai][bj][m][1] * ascale)); } }
    }
};
template <class Epi, class Sched, bool ALIGN_EPI = false, bool SP2 = false, int ES = 2  >
__device__ __forceinline__ void gemm_phase(PG8_LAS unsigned char* lds, const Gemm g, const Sched& S, const Epi& E, int tid) {
    const int wid = __builtin_amdgcn_readfirstlane(tid >> 6), lane = tid & 63, wr = wid >> 2, wc = wid & 3, fr = lane & 15, fq = lane >> 4;
    int K = g.K; asm volatile("" : "+s"(K));
    const int nt = (K * ES) / (BK * 2);
    unsigned voffA[2], voffB[2];
#pragma unroll
    for (int i = 0; i < 2; ++i) { int R, C; stage_rc(tid * 16 + i * 8192, R, C); const int Rb = Epi::PERM ? ((R & ~31) + perm32(R & 31)) : R;
        voffA[i] = (unsigned)(R * g.lda * ES + C * 2); voffB[i] = (unsigned)(Rb * K * ES + C * 2); }
    const size_t kstep = (size_t)(BK * 2);
    const size_t hstepA = (size_t)HALF * g.lda * ES, hstepB = (size_t)HALF * K * ES;
    const size_t tstepA = 2 * hstepA, tstepB = 2 * hstepB;
    const unsigned ldsw = (unsigned)wid * 1024u;
    const int aoff = lds_byte(wr * 64 + fr, fq * 8), boff = lds_byte(wc * 32 + fr, fq * 8);
#define PG8_SA(b, h) (((b) * 2 + (h)) * HTB)
#define PG8_SB(b, h) ((4 + (b) * 2 + (h)) * HTB)
#define PG8_STAGE(bufoff, gbase, voff) do { _Pragma("unroll") for (int _i = 0; _i < 2; ++_i) \
        __builtin_amdgcn_global_load_lds((const unsigned*)((const char*)(gbase) + (voff)[_i]), (PG8_LAS unsigned*)(lds + (bufoff) + ldsw + _i * 8192), 16, 0, 0); } while (0)
#define PG8_LDA(dst, b, h) do { _Pragma("unroll") for (int m = 0; m < 4; ++m) _Pragma("unroll") for (int k = 0; k < 2; ++k) dst[m][k] = *(const PG8_LAS bf16x8*)(lds + PG8_SA(b, h) + aoff + m * 2048 + k * 1024); } while (0)
#define PG8_LDB(dst, b, h) do { _Pragma("unroll") for (int n = 0; n < 2; ++n) _Pragma("unroll") for (int k = 0; k < 2; ++k) dst[n][k] = *(const PG8_LAS bf16x8*)(lds + PG8_SB(b, h) + boff + n * 2048 + k * 1024); } while (0)
#define PG8_CAT(x) __builtin_shufflevector(__builtin_bit_cast(i32x4, (x)[0]), __builtin_bit_cast(i32x4, (x)[1]), 0, 1, 2, 3, 4, 5, 6, 7)
#define PG8_MMA(ai, bj, At, Bt) do { __builtin_amdgcn_s_setprio(1); if constexpr (ES == 2) { _Pragma("unroll") for (int m = 0; m < 4; ++m) _Pragma("unroll") for (int n = 0; n < 2; ++n) _Pragma("unroll") for (int k = 0; k < 2; ++k) \
        acc[ai][bj][m][n] = __builtin_amdgcn_mfma_f32_16x16x32_bf16(Bt[n][k], At[m][k], acc[ai][bj][m][n], 0, 0, 0); } else { _Pragma("unroll") for (int m = 0; m < 4; ++m) _Pragma("unroll") for (int n = 0; n < 2; ++n) \
        asm volatile("v_mfma_scale_f32_16x16x128_f8f6f4 %0, %1, %2, %0, %3, %3 op_sel_hi:[0,0,0]" : "+v"(acc[ai][bj][m][n]) : "v"(PG8_CAT(Bt[n])), "v"(PG8_CAT(At[m])), "v"(sc1)); } __builtin_amdgcn_s_setprio(0); } while (0)
#define PG8_WAIT_V(n) asm volatile("s_waitcnt vmcnt(" #n ")" ::: "memory")
#define PG8_WAIT_L(n) asm volatile("s_waitcnt lgkmcnt(" #n ")" ::: "memory")
#define PG8_BAR __builtin_amdgcn_s_barrier()
#define PG8_SCHED __builtin_amdgcn_sched_barrier(0)
    Unit cur, nxt; int ui = 0;
    if (!S.next(0, cur)) return;
    const int sc1 = 0x7f7f7f7f; (void)sc1;
    f32x4 acc[2][2][4][2];
#pragma unroll
    for (int a = 0; a < 2; ++a)
#pragma unroll
        for (int b = 0; b < 2; ++b)
#pragma unroll
            for (int m = 0; m < 4; ++m)
#pragma unroll
                for (int n = 0; n < 2; ++n) acc[a][b][m][n] = (f32x4){0.f, 0.f, 0.f, 0.f};
    bf16x8 At[4][2], B0[2][2], B1[2][2];
    const char* cA = (const char*)g.A + (size_t)cur.e * g.aestride + (size_t)cur.pm * tstepA; const char* cB = (const char*)g.Bt + (size_t)cur.e * g.estride + (size_t)cur.pn * tstepB;
    S.a_ready(cur);
    if constexpr (SP2) {
        PG8_STAGE(PG8_SB(0, 0), cB, voffB); PG8_STAGE(PG8_SB(0, 1), cB + hstepB, voffB); PG8_STAGE(PG8_SA(0, 0), cA, voffA); PG8_STAGE(PG8_SA(0, 1), cA + hstepA, voffA);
        if (wr == 1) PG8_BAR;
        PG8_WAIT_V(2); PG8_BAR;
        PG8_STAGE(PG8_SB(1, 0), cB + kstep, voffB); PG8_STAGE(PG8_SA(1, 0), cA + kstep, voffA); PG8_STAGE(PG8_SB(1, 1), cB + hstepB + kstep, voffB);
        PG8_WAIT_V(6); PG8_BAR;
    } else {
        PG8_STAGE(PG8_SB(0, 0), cB, voffB); PG8_STAGE(PG8_SA(0, 0), cA, voffA); PG8_STAGE(PG8_SB(0, 1), cB + hstepB, voffB); PG8_STAGE(PG8_SA(0, 1), cA + hstepA, voffA);
        if (wr == 1) PG8_BAR;
        PG8_WAIT_V(4); PG8_BAR;
        PG8_STAGE(PG8_SB(1, 0), cB + kstep, voffB); PG8_STAGE(PG8_SA(1, 0), cA + kstep, voffA); PG8_STAGE(PG8_SB(1, 1), cB + hstepB + kstep, voffB);
        PG8_WAIT_V(6); PG8_BAR;
    }
    for (;;) {
        const bool has_next = S.next(ui + 1, nxt);
        const char* nA = has_next ? (const char*)g.A + (size_t)nxt.e * g.aestride + (size_t)nxt.pm * tstepA : cA; const char* nB = has_next ? (const char*)g.Bt + (size_t)nxt.e * g.estride + (size_t)nxt.pn * tstepB : cB;
        for (int t = 0; t < nt; t += 2) {
            const bool last = (t == nt - 2);
            const char* a1 = cA + (size_t)(t + 1) * kstep;
            const char* a2 = last ? nA : cA + (size_t)(t + 2) * kstep; const char* b2 = last ? nB : cB + (size_t)(t + 2) * kstep;
            const char* a3 = a2 + kstep; const char* b3 = b2 + kstep;
            if (last && has_next) S.a_ready(nxt);
            if constexpr (SP2) {
            PG8_LDB(B0, 0, 0); PG8_LDB(B1, 0, 1); PG8_SCHED; PG8_LDA(At, 0, 0); PG8_STAGE(PG8_SA(1, 1), a1 + hstepA, voffA);
            PG8_WAIT_V(8); PG8_WAIT_L(0); PG8_BAR; PG8_MMA(0, 0, At, B0); PG8_MMA(0, 1, At, B1); PG8_BAR; PG8_SCHED;
            PG8_LDA(At, 0, 1); PG8_STAGE(PG8_SB(0, 0), b2, voffB); PG8_STAGE(PG8_SB(0, 1), b2 + hstepB, voffB); PG8_STAGE(PG8_SA(0, 0), a2, voffA);
            PG8_WAIT_V(8); PG8_WAIT_L(0); PG8_BAR; PG8_MMA(1, 0, At, B0); PG8_MMA(1, 1, At, B1); PG8_BAR; PG8_SCHED;
            PG8_LDB(B0, 1, 0); PG8_LDB(B1, 1, 1); PG8_SCHED; PG8_LDA(At, 1, 0); PG8_STAGE(PG8_SA(0, 1), a2 + hstepA, voffA);
            PG8_WAIT_V(8); PG8_WAIT_L(0); PG8_BAR; PG8_MMA(0, 0, At, B0); PG8_MMA(0, 1, At, B1); PG8_BAR; PG8_SCHED;
            PG8_LDA(At, 1, 1); PG8_STAGE(PG8_SB(1, 0), b3, voffB); PG8_STAGE(PG8_SB(1, 1), b3 + hstepB, voffB); PG8_STAGE(PG8_SA(1, 0), a3, voffA);
            PG8_WAIT_V(8); PG8_WAIT_L(0); PG8_BAR; PG8_MMA(1, 0, At, B0); PG8_MMA(1, 1, At, B1); PG8_BAR; PG8_SCHED;
            } else {
            PG8_LDB(B0, 0, 0); PG8_SCHED; PG8_LDA(At, 0, 0); PG8_STAGE(PG8_SA(1, 1), a1 + hstepA, voffA);
            PG8_WAIT_L(8); PG8_BAR; PG8_WAIT_L(0); PG8_MMA(0, 0, At, B0); PG8_BAR; PG8_SCHED;
            PG8_LDB(B1, 0, 1); PG8_STAGE(PG8_SB(0, 0), b2, voffB);
            PG8_BAR; PG8_WAIT_L(0); PG8_MMA(0, 1, At, B1); PG8_BAR;
            PG8_LDA(At, 0, 1); PG8_STAGE(PG8_SA(0, 0), a2, voffA);
            PG8_BAR; PG8_WAIT_L(0); PG8_MMA(1, 0, At, B0); PG8_BAR; PG8_SCHED;
            PG8_STAGE(PG8_SB(0, 1), b2 + hstepB, voffB);
            PG8_WAIT_V(6); PG8_BAR; PG8_MMA(1, 1, At, B1); PG8_BAR;
            PG8_LDB(B0, 1, 0); PG8_SCHED; PG8_LDA(At, 1, 0); PG8_STAGE(PG8_SA(0, 1), a2 + hstepA, voffA);
            PG8_WAIT_L(8); PG8_BAR; PG8_WAIT_L(0); PG8_MMA(0, 0, At, B0); PG8_BAR; PG8_SCHED;
            PG8_LDB(B1, 1, 1); PG8_STAGE(PG8_SB(1, 0), b3, voffB);
            PG8_BAR; PG8_WAIT_L(0); PG8_MMA(0, 1, At, B1); PG8_BAR;
            PG8_LDA(At, 1, 1); PG8_STAGE(PG8_SA(1, 0), a3, voffA);
            PG8_BAR; PG8_WAIT_L(0); PG8_MMA(1, 0, At, B0); PG8_BAR; PG8_SCHED;
            PG8_STAGE(PG8_SB(1, 1), b3 + hstepB, voffB);
            PG8_WAIT_V(6); PG8_BAR; PG8_MMA(1, 1, At, B1); PG8_BAR;
            }
        }
        if constexpr (ES == 1) asm volatile("s_nop 15\n\ts_nop 15" ::: "memory");
        if constexpr (ALIGN_EPI) { if (wr == 0) PG8_BAR; }
        if constexpr (!Epi::AFTER_DRAIN) { E(acc, cur, wr, wc, fr, fq); S.done(cur); }
        if (!has_next) break;
#pragma unroll
        for (int a = 0; a < 2; ++a)
#pragma unroll
            for (int b = 0; b < 2; ++b)
#pragma unroll
                for (int m = 0; m < 4; ++m)
#pragma unroll
                    for (int n = 0; n < 2; ++n) acc[a][b][m][n] = (f32x4){0.f, 0.f, 0.f, 0.f};
        cur = nxt; cA = nA; cB = nB; ++ui;
        if constexpr (ALIGN_EPI) { if (wr == 1) PG8_BAR; }
    }
    PG8_WAIT_V(0);
    if constexpr (!ALIGN_EPI) { if (wr == 0) PG8_BAR; }
    PG8_BAR;
    if constexpr (Epi::AFTER_DRAIN) { E.fused(acc, cur, wr, wc, fr, fq, lds, wid, lane); S.done(cur); }
#undef PG8_SA
#undef PG8_SB
#undef PG8_STAGE
#undef PG8_LDA
#undef PG8_LDB
#undef PG8_MMA
#undef PG8_CAT
#undef PG8_WAIT_V
#undef PG8_WAIT_L
#undef PG8_BAR
#undef PG8_SCHED
}
}
constexpr int NWAVES = 8, NTHR = 512;
constexpr int NB = 8, T_ = 4096, D_ = 1024, M_ = NB * T_, DIN = 2216, NPROJ = 2304, FF = 2816, NE = 8, NCH = 32  ;
constexpr int PZ = 0, PX = 512, PB = 1024, PC = 1152, PQ = 1280, PKV = 1536, PKPE = 1664, PDT = 1696, PGU = 1792, PGV = 2048;
constexpr float LN_EPS = 1e-5f, RMS_EPS = 1e-6f, DN_ALPHA = 1.41421356237f;
constexpr float QSCALE = 0.10206207261596575f * 1.4426950408889634f;
constexpr int MOE_MAXP = 272;
constexpr size_t MiB = 1u << 20;
constexpr size_t WS_CTL = 0, CTL_ZERO_BYTES = 1 * MiB;
constexpr size_t WS_MOD = 1 * MiB, WS_ROPE = 2 * MiB, WS_WQB = 3 * MiB, WS_WKVB = 4 * MiB, WS_ROUTE = 5 * MiB, WS_RSTD = 6 * MiB, WS_DTV = 7 * MiB, WS_ACS = 8 * MiB, WS_GMW = 10 * MiB;
constexpr size_t WS_WIN = 16 * MiB, WS_WOUT = 25 * MiB, WS_W13 = 29 * MiB, WS_W2 = 40 * MiB, WS_MW13 = 46 * MiB  , WS_MW2 = 90 * MiB  ;
constexpr size_t WS_A = 112 * MiB, WS_PROJ = 176 * MiB, WS_Q = 320 * MiB, WS_KN = 344 * MiB, WS_V = 360 * MiB, WS_KPE = 376 * MiB, WS_ST = 378 * MiB;
constexpr size_t WS_CC = 410 * MiB, WS_SB = 418 * MiB;
constexpr size_t WS_XS = 440 * MiB;
constexpr size_t WS_ACT = 176 * MiB;
constexpr size_t WS_HP = 176 * MiB, WS_ACTM = 248 * MiB, WS_YP = 112 * MiB, WS_END = 512 * MiB;
static_assert(WS_ACT + (size_t)M_ * FF * 2 <= WS_END && WS_HP + (size_t)MOE_MAXP * 256 * 1024 <= WS_ACTM && WS_YP + (size_t)MOE_MAXP * 256 * 2048 <= WS_ACTM && WS_SB + 16 * MiB <= WS_XS && WS_ACTM + (size_t)MOE_MAXP * 256 * 2816 <= WS_XS && WS_XS + 64 * MiB <= WS_END, "d_ws map");
constexpr size_t W13_BYTES = (size_t)5632 * 1024 * 2, W2_BYTES = (size_t)1024 * 2816 * 2, WIN_BYTES = (size_t)NPROJ * 1024 * 2, WOUT_BYTES = (size_t)1024 * 1024 * 2, WQB_BYTES = (size_t)512 * 256 * 2;
constexpr int CW_TMO = 0, CW_CODE = 1, CW_BAR = 4096, CW_CNT = 8192;
constexpr int RING_OFF = 0, RING_BYTES = 131072, LDSCTL_OFF = RING_BYTES, MISC_OFF = LDSCTL_OFF + 320, LDS_BYTES = 147456;

#define GAS __attribute__((address_space(1)))
#define LAS __attribute__((address_space(3)))
typedef unsigned short bf16;
typedef unsigned v4u __attribute__((ext_vector_type(4)));
typedef unsigned v2u __attribute__((ext_vector_type(2)));
typedef float f32x4 __attribute__((ext_vector_type(4)));
typedef GAS unsigned gu32;
#define RLX_AGENT __ATOMIC_RELAXED, __HIP_MEMORY_SCOPE_AGENT
#define LDS_WAIT() asm volatile("s_waitcnt lgkmcnt(0)" ::: "memory")
__device__ __forceinline__ unsigned f2bf(float f) { unsigned u = __builtin_bit_cast(unsigned, f); return (u + 0x7fffu + ((u >> 16) & 1u)) >> 16; }
__device__ __forceinline__ unsigned pk2(float lo, float hi) { return f2bf(lo) | (f2bf(hi) << 16); }
__device__ __forceinline__ float bf2f(bf16 v) { return __uint_as_float((unsigned)v << 16); }
__device__ __forceinline__ float bflo(unsigned w) { return __uint_as_float(w << 16); }
__device__ __forceinline__ float bfhi(unsigned w) { return __uint_as_float(w & 0xffff0000u); }
__device__ __forceinline__ float silu(float a) { return a * __builtin_amdgcn_rcpf(1.f + __expf(-a)); }
__device__ __forceinline__ float gelu_erf(float v) { return 0.5f * v * (1.f + erff(v * 0.70710678118654752f)); }

#define XB_TMO      128
#define XB_XCNT(j)  (256  + 64 * (j))
#define XB_XSUB(j)  (1280 + 64 * (j))
#define XB_XGEN(j)  (2304 + 64 * (j))
#define XB_TOP      3328
#define XB_TOPGEN   3392
#define XCD_BAR_WORDS 3456
#define XB_SPIN_CAP (1u << 22)
__device__ __forceinline__ unsigned xb_ld(unsigned* p)              { return __hip_atomic_load(p, __ATOMIC_RELAXED, __HIP_MEMORY_SCOPE_AGENT); }
__device__ __forceinline__ unsigned xb_add(unsigned* p, unsigned v) { return __hip_atomic_fetch_add(p, v, __ATOMIC_RELAXED, __HIP_MEMORY_SCOPE_AGENT); }
__device__ __forceinline__ unsigned xb_xcc_id() { return (unsigned)__builtin_amdgcn_s_getreg((3 << 11) | 20) & 0xFu; }
#define XB_SPIN(cond, bar) do { unsigned _sp = 0; while (cond) { __builtin_amdgcn_s_sleep(1); \
    if ((++_sp & 255u) == 0u) { if (xb_ld(&(bar)[XB_TMO])) break; if (_sp > XB_SPIN_CAP) { atomicAdd(&(bar)[XB_TMO], 1u); break; } } } } while (0)
struct XcdBarrier { unsigned* bar; unsigned x; volatile LAS unsigned* st; };
__device__ __forceinline__ XcdBarrier xcd_barrier_post(unsigned* bar, volatile LAS unsigned* st) {
    XcdBarrier b; b.bar = bar; b.x = xb_xcc_id(); b.st = st;
    if (threadIdx.x == 0) (void)xb_add(&bar[XB_XCNT(b.x)], 1u);
    return b;
}
__device__ __forceinline__ void xcd_barrier_complete(unsigned* bar, unsigned x, unsigned& nloc, unsigned& nx) {
    const unsigned G = gridDim.x * gridDim.y * gridDim.z;
    unsigned sum, cnt, mine, sp = 0u;
    for (;;) {
        sum = 0u; cnt = 0u; mine = 0u;
#pragma unroll
        for (unsigned j = 0; j < 16; ++j) { const unsigned c = xb_ld(&bar[XB_XCNT(j)]); sum += c; cnt += (c > 0u) ? 1u : 0u; mine = (j == x) ? c : mine; }
        if (sum == G) break;
        __builtin_amdgcn_s_sleep(1);
        if ((++sp & 255u) == 0u) { if (xb_ld(&bar[XB_TMO])) break; if (sp > XB_SPIN_CAP) { atomicAdd(&bar[XB_TMO], 1u); break; } }
    }
    nloc = mine > 0u ? mine : 1u; nx = cnt > 0u ? cnt : 1u;
}
__device__ __forceinline__ void xcd_barrier(const XcdBarrier& b, bool leader) {
    asm volatile("s_waitcnt vmcnt(0)" ::: "memory");
    __syncthreads();
    if (leader) {
        unsigned* bar = b.bar;
        __builtin_amdgcn_s_waitcnt(0);
        unsigned nloc = b.st[0], nx = b.st[1];
        if (nloc == 0u) { xcd_barrier_complete(bar, b.x, nloc, nx); b.st[0] = nloc; b.st[1] = nx; }
        const unsigned old = xb_add(&bar[XB_XSUB(b.x)], 1u);
        const unsigned gen = old / nloc;
        if (old + 1u == (gen + 1u) * nloc) {
            __builtin_amdgcn_fence(__ATOMIC_RELEASE, "agent");
            asm volatile("s_waitcnt vmcnt(0)" ::: "memory");
            const unsigned og = xb_add(&bar[XB_TOP], 1u);
            const unsigned tg = og / nx;
            if (og + 1u == (tg + 1u) * nx) xb_add(&bar[XB_TOPGEN], 1u);
            else XB_SPIN(xb_ld(&bar[XB_TOPGEN]) == tg, bar);
            __builtin_amdgcn_fence(__ATOMIC_ACQUIRE, "agent");
            xb_add(&bar[XB_XGEN(b.x)], 1u);
            asm volatile("s_waitcnt vmcnt(0)" ::: "memory");
        } else {
            XB_SPIN(xb_ld(&bar[XB_XGEN(b.x)]) == gen, bar);
            __builtin_amdgcn_fence(__ATOMIC_ACQUIRE, "agent");
            asm volatile("s_waitcnt vmcnt(0)" ::: "memory");
        }
    }
    __syncthreads();
}

struct Args { const float* in[31]; float* out; unsigned char* ws; int ph_lo, ph_hi; };
enum { I_X = 0, I_C, I_LN0G, I_LN0B, I_ADAW, I_ADAB, I_PLG, I_PLB, I_WIN, I_CONVW, I_CONVB, I_DTB, I_ALOG, I_SSDD, I_SSDNW, I_QNORM, I_WQB, I_KVNORM, I_WKVB,
       I_GMLNG, I_GMLNB, I_GMWS, I_GMBS, I_WOUT, I_FW1, I_FW3, I_FW2, I_ROUTER, I_MW1, I_MW3, I_MW2 };
struct Frame {
    LAS unsigned char* lds; gu32* ctl; unsigned char* ws; float* out;
    int tid, lane, wave, G, bid;
};
__device__ __forceinline__ Frame phase_frame(const Frame& F0) {
    Frame P = F0; asm volatile("" : "+s"(P.wave)); asm volatile("" : "+s"(P.ws)); asm volatile("" : "+s"(P.out)); asm volatile("" : "+s"(P.G)); asm volatile("" : "+s"(P.bid));
    P.lane = (int)__builtin_amdgcn_mbcnt_hi(~0u, __builtin_amdgcn_mbcnt_lo(~0u, 0u)); asm volatile("" : "+v"(P.lane));
    P.tid = P.wave * 64 + P.lane; P.ctl = (gu32*)(P.ws + WS_CTL); return P;
}
__device__ __forceinline__ float wave_sum(float v) {
#pragma unroll
    for (int o = 1; o < 64; o <<= 1) v += __shfl_xor(v, o);
    return v;
}
__device__ __forceinline__ float wave_max(float v) {
#pragma unroll
    for (int o = 1; o < 64; o <<= 1) v = fmaxf(v, __shfl_xor(v, o));
    return v;
}

struct SrcId   { __device__ __forceinline__ int operator()(int n) const { return n; } };
struct SrcWin  { __device__ __forceinline__ int operator()(int n) const {
    if (n < 1280) return n;
    if (n < 1536) return 1288 + (n - 1280);
    if (n < 1664) return 1544 + (n - 1536);
    if (n < 1696) { const int d = n - 1664, g = d >> 3, w = d & 7; return 1672 + ((w < 4) ? 4 * g + w : 16 + 4 * g + (w - 4)); }
    if (n < 1704) return 1280 + (n - 1696);
    if (n < 1792) return -1;
    if (n < 2048) return 1704 + (n - 1792);
    return 1960 + (n - 2048); } };
struct SrcHalf { __device__ __forceinline__ int operator()(int n) const { return 128 * (n >> 8) + (n & 127); } };
struct SrcQB   { __device__ __forceinline__ int operator()(int n) const { const int pn = n >> 8, lc = n & 255; if (lc >= 192) return -1; const int h = 2 * pn + lc / 96, hc = lc % 96; if (hc < 64) return h * 96 + hc;
    const int d = hc - 64, g = d >> 3, w = d & 7; return h * 96 + 64 + ((w < 4) ? 4 * g + w : 16 + 4 * g + (w - 4)); } };
struct SrcKVB  { __device__ __forceinline__ int operator()(int n) const { const int t = n >> 8, r = n & 255, h = r >> 6, d = r & 63; return h * 128 + t * 64 + d; } };
template <class SrcFn>
__device__ __forceinline__ void tr_item(const float* W, int ldw, int Ksrc, const float* kscale, SrcFn src, bf16* WT, int Kdst, int k0, int n0, LAS unsigned char* scr, int lane, float qs = 0.f, bool out8 = false) {
    const int n4 = (lane & 15) * 4, kr = lane >> 4, sc = src(n0 + n4);
    f32x4 v[16];
#pragma unroll
    for (int i = 0; i < 16; ++i) { const int k = k0 + 4 * i + kr; v[i] = (sc >= 0 && k < Ksrc) ? *(const GAS f32x4*)(W + (size_t)k * ldw + sc) : (f32x4){0.f, 0.f, 0.f, 0.f}; }
    if (kscale) {
#pragma unroll
        for (int i = 0; i < 16; ++i) { const int k = k0 + 4 * i + kr; if (k < Ksrc) v[i] = v[i] * kscale[k]; } }
    if (qs != 0.f) { const float iq = out8 ? 1.f : 1.f / qs;
#pragma unroll
        for (int i = 0; i < 16; ++i) { v[i].x = pg8::q8(v[i].x * qs) * iq; v[i].y = pg8::q8(v[i].y * qs) * iq; v[i].z = pg8::q8(v[i].z * qs) * iq; v[i].w = pg8::q8(v[i].w * qs) * iq; } }
#pragma unroll
    for (int i = 0; i < 16; ++i) { LAS unsigned char* p = scr + (4 * i + kr) * 132 + n4 * 2; *(LAS unsigned*)p = pk2(v[i].x, v[i].y); *(LAS unsigned*)(p + 4) = pk2(v[i].z, v[i].w); }
    LDS_WAIT(); asm volatile("" ::: "memory");
    const int c = lane & 7;
#pragma unroll
    for (int j = 0; j < 8; ++j) { const int n = (lane >> 3) + 8 * j; const LAS unsigned char* p = scr + (8 * c) * 132 + n * 2;
        v4u o; o.x = (unsigned)*(const LAS bf16*)(p) | ((unsigned)*(const LAS bf16*)(p + 132) << 16); o.y = (unsigned)*(const LAS bf16*)(p + 264) | ((unsigned)*(const LAS bf16*)(p + 396) << 16);
        o.z = (unsigned)*(const LAS bf16*)(p + 528) | ((unsigned)*(const LAS bf16*)(p + 660) << 16); o.w = (unsigned)*(const LAS bf16*)(p + 792) | ((unsigned)*(const LAS bf16*)(p + 924) << 16);
        if (!out8) *(GAS v4u*)(WT + (size_t)(n0 + n) * Kdst + k0 + 8 * c) = o;
        else { v2u o8; o8.x = pg8::fp8x4((f32x4){bflo(o.x), bfhi(o.x), bflo(o.y), bfhi(o.y)}); o8.y = pg8::fp8x4((f32x4){bflo(o.z), bfhi(o.z), bflo(o.w), bfhi(o.w)});
            *(GAS v2u*)((unsigned char*)WT + (size_t)(n0 + n) * Kdst + k0 + 8 * c) = o8; } }
    LDS_WAIT(); asm volatile("" ::: "memory");
}
__device__ __forceinline__ void p0a(Frame& F, const Args& A) {
    if (F.bid < 192) {
        const int ls = F.bid / 48, col0 = (F.bid % 48) * 64;
        LAS float* sc = (LAS float*)(F.lds);
        LAS float* red = (LAS float*)(F.lds + 32768);
        const float* c = A.in[I_C];
        for (int i = F.tid; i < 8 * 1024; i += NTHR) sc[i] = silu(c[i]);
        __syncthreads();
        const float* w = A.in[I_ADAW] + (size_t)ls * 1024 * 3072 + col0 + F.lane;
        float acc[8];
#pragma unroll
        for (int b = 0; b < 8; ++b) acc[b] = 0.f;
        const int kb = F.wave * 128;
#pragma unroll 16
        for (int k = 0; k < 128; ++k) { const float wv = w[(size_t)(kb + k) * 3072];
#pragma unroll
            for (int b = 0; b < 8; ++b) acc[b] += sc[b * 1024 + kb + k] * wv; }
#pragma unroll
        for (int b = 0; b < 8; ++b) red[(F.wave * 8 + b) * 64 + F.lane] = acc[b];
        __syncthreads();
        { const int b = F.tid >> 6, l = F.tid & 63; float s = 0.f;
#pragma unroll
          for (int wv = 0; wv < 8; ++wv) s += red[(wv * 8 + b) * 64 + l];
          float* mod = (float*)(F.ws + WS_MOD);
          mod[((size_t)ls * 8 + b) * 3072 + col0 + l] = s + A.in[I_ADAB][ls * 3072 + col0 + l]; }
        __syncthreads();
    }
    {
        const double inv[16] = {1.0, 0.5623413251903491, 0.31622776601683794, 0.1778279410038923, 0.1, 0.05623413251903491, 0.03162277660168379, 0.01778279410038923,
                                0.01, 0.005623413251903491, 0.0031622776601683794, 0.0017782794100389228, 0.001, 0.0005623413251903491, 0.00031622776601683794, 0.00017782794100389227};
        float* rc = (float*)(F.ws + WS_ROPE); float* rs = rc + 4096 * 16;
        for (int idx = F.bid * NTHR + F.tid; idx < 4096 * 16; idx += F.G * NTHR) { const int t = idx >> 4, i = idx & 15;
            double iv = inv[0];
#pragma unroll
            for (int q = 1; q < 16; ++q) iv = (i == q) ? inv[q] : iv;
            const double rev = (double)t * iv * 0.15915494309189535; const float fr = (float)(rev - floor(rev));
            rc[idx] = __builtin_amdgcn_cosf(fr); rs[idx] = __builtin_amdgcn_sinf(fr); }
    }
    { const float* W = A.in[I_GMWS]; bf16* o = (bf16*)(F.ws + WS_GMW);
      for (int idx = F.bid * NTHR + F.tid; idx < 2 * 4 * 128 * 128; idx += F.G * NTHR) { const int s = idx & 127, t = (idx >> 7) & 127; o[idx] = (bf16)(s <= t ? f2bf(W[idx]) : 0u); } }
    LAS unsigned char* scr = F.lds + RING_OFF + F.wave * 16384;
    const int gw = F.bid * NWAVES + F.wave, NGW = F.G * NWAVES;
    constexpr int I_WINc = 16 * 36, I_WOUTc = 16 * 16, I_W13c = 16 * 88, I_W2c = 44 * 16, I_QBc = 4 * 8;
    constexpr int NITEMS = 2 * I_WINc + 2 * I_WOUTc + 9 * I_W13c + 9 * I_W2c + 4 * I_QBc;
    for (int it = gw; it < NITEMS; it += NGW) {
        int r = it;
        if (r < 9 * I_W13c) { const int e = r / I_W13c; r %= I_W13c; const int kb = r / 88, nb = r % 88; const int which = (nb >> 1) & 1;
            const float* W = e == 0 ? (which ? A.in[I_FW3] : A.in[I_FW1]) : ((which ? A.in[I_MW3] : A.in[I_MW1]) + (size_t)(e - 1) * 1024 * FF);
            bf16* WT = e == 0 ? (bf16*)(F.ws + WS_W13) : (bf16*)(F.ws + WS_MW13 + (size_t)(e - 1) * (W13_BYTES / 2));
            tr_item(W, FF, 1024, nullptr, SrcHalf(), WT, 1024, kb * 64, nb * 64, scr, F.lane, e > 0 ? 32.f : 0.f, e > 0); continue; } r -= 9 * I_W13c;
        if (r < 9 * I_W2c) { const int e = r / I_W2c; r %= I_W2c; const int kb = r / 16, nb = r % 16;
            const float* W = e == 0 ? A.in[I_FW2] : A.in[I_MW2] + (size_t)(e - 1) * FF * 1024;
            bf16* WT = e == 0 ? (bf16*)(F.ws + WS_W2) : (bf16*)(F.ws + WS_MW2 + (size_t)(e - 1) * (W2_BYTES / 2));
            tr_item(W, 1024, FF, nullptr, SrcId(), WT, FF, kb * 64, nb * 64, scr, F.lane, e > 0 ? 128.f : 0.f, e > 0); continue; } r -= 9 * I_W2c;
        if (r < 2 * I_WINc) { const int l = r / I_WINc; r %= I_WINc; const int kb = r / 36, nb = r % 36;
            tr_item(A.in[I_WIN] + (size_t)l * 1024 * DIN, DIN, 1024, nullptr, SrcWin(), (bf16*)(F.ws + WS_WIN + l * WIN_BYTES), 1024, kb * 64, nb * 64, scr, F.lane); continue; } r -= 2 * I_WINc;
        if (r < 2 * I_WOUTc) { const int l = r / I_WOUTc; r %= I_WOUTc; const int kb = r / 16, nb = r % 16;
            tr_item(A.in[I_WOUT] + (size_t)l * 1024 * 1024, 1024, 1024, nullptr, SrcId(), (bf16*)(F.ws + WS_WOUT + l * WOUT_BYTES), 1024, kb * 64, nb * 64, scr, F.lane); continue; } r -= 2 * I_WOUTc;
        { const int l = (r / I_QBc) & 1, isk = r / (2 * I_QBc); r %= I_QBc; const int kb = r / 8, nb = r % 8;
          if (!isk) tr_item(A.in[I_WQB] + (size_t)l * 256 * 384, 384, 256, A.in[I_QNORM] + l * 256, SrcQB(), (bf16*)(F.ws + WS_WQB + l * WQB_BYTES), 256, kb * 64, nb * 64, scr, F.lane);
          else      tr_item(A.in[I_WKVB] + (size_t)l * 128 * 512, 512, 128, A.in[I_KVNORM] + l * 128, SrcKVB(), (bf16*)(F.ws + WS_WKVB + l * WQB_BYTES), 256, kb * 64, nb * 64, scr, F.lane); }
    }
    __syncthreads();
}
__device__ __forceinline__ int lcol(int lane, int j) { return (j >> 1) * 512 + 8 * lane + 4 * (j & 1); }
__device__ __forceinline__ void unpack_row(const v4u a, const v4u b, f32x4 (&x)[4]) {
    x[0] = (f32x4){bflo(a.x), bfhi(a.x), bflo(a.y), bfhi(a.y)}; x[1] = (f32x4){bflo(a.z), bfhi(a.z), bflo(a.w), bfhi(a.w)};
    x[2] = (f32x4){bflo(b.x), bfhi(b.x), bflo(b.y), bfhi(b.y)}; x[3] = (f32x4){bflo(b.z), bfhi(b.z), bflo(b.w), bfhi(b.w)}; }
__device__ __forceinline__ void load_row(const float* pf, const bf16* pb, f32x4 (&x)[4], int lane) {
    if (pf) {
#pragma unroll
        for (int j = 0; j < 4; ++j) x[j] = *(const GAS f32x4*)(pf + lcol(lane, j)); }
    else unpack_row(*(const GAS v4u*)(pb + 8 * lane), *(const GAS v4u*)(pb + 512 + 8 * lane), x);
}
template <int NR> __device__ __forceinline__ void ln_rows(const float* g, const float* bt, f32x4 (&x)[NR][4], int lane) {
    float s[NR], s2[NR];
#pragma unroll
    for (int i = 0; i < NR; ++i) { s[i] = 0.f;
#pragma unroll
        for (int j = 0; j < 4; ++j) s[i] += (x[i][j].x + x[i][j].y) + (x[i][j].z + x[i][j].w); }
#pragma unroll
    for (int o = 1; o < 64; o <<= 1) {
#pragma unroll
        for (int i = 0; i < NR; ++i) s[i] += __shfl_xor(s[i], o); }
#pragma unroll
    for (int i = 0; i < NR; ++i) { const float mean = s[i] * (1.f / 1024.f); s2[i] = 0.f;
#pragma unroll
        for (int j = 0; j < 4; ++j) { x[i][j] = x[i][j] - mean; s2[i] += (x[i][j].x * x[i][j].x + x[i][j].y * x[i][j].y) + (x[i][j].z * x[i][j].z + x[i][j].w * x[i][j].w); } }
#pragma unroll
    for (int o = 1; o < 64; o <<= 1) {
#pragma unroll
        for (int i = 0; i < NR; ++i) s2[i] += __shfl_xor(s2[i], o); }
#pragma unroll
    for (int j = 0; j < 4; ++j) { const f32x4 gg = *(const GAS f32x4*)(g + lcol(lane, j)), bb = *(const GAS f32x4*)(bt + lcol(lane, j));
#pragma unroll
        for (int i = 0; i < NR; ++i) { const float rstd = 1.f / sqrtf(s2[i] * (1.f / 1024.f) + LN_EPS); x[i][j] = x[i][j] * rstd * gg + bb; } }
}
__device__ __forceinline__ void store_rows(f32x4 (&x)[4], bf16* xs, float* xf, bf16* hout, const float* modp, int lane) {
    if (xs) { *(GAS v4u*)(xs + 8 * lane) = __builtin_bit_cast(v4u, pg8::pack8(x[0], x[1])); *(GAS v4u*)(xs + 512 + 8 * lane) = __builtin_bit_cast(v4u, pg8::pack8(x[2], x[3])); }
    if (xf) {
#pragma unroll
        for (int j = 0; j < 4; ++j) *(GAS f32x4*)(xf + lcol(lane, j)) = x[j]; }
    if (hout) {
#pragma unroll
        for (int j = 0; j < 4; ++j) { const f32x4 sh = *(const GAS f32x4*)(modp + lcol(lane, j)), sc = *(const GAS f32x4*)(modp + 1024 + lcol(lane, j)); x[j] = x[j] * (sc + 1.f) + sh; }
        *(GAS v4u*)(hout + 8 * lane) = __builtin_bit_cast(v4u, pg8::pack8(x[0], x[1])); *(GAS v4u*)(hout + 512 + 8 * lane) = __builtin_bit_cast(v4u, pg8::pack8(x[2], x[3])); }
}
__device__ __forceinline__ void ln_phase(Frame& F, const Args& A, const float* vin, const float* g, const float* bt, int ls, bool route, bool dry) {
    const int gwv = F.bid * NWAVES + F.wave, NGW = F.G * NWAVES;
    const float* mod = (const float*)(F.ws + WS_MOD);
    bf16* hb = dry ? (bf16*)(F.ws + WS_Q) : (bf16*)(F.ws + WS_A); bf16* xs = (bf16*)(F.ws + WS_XS); bf16* xo = dry ? (bf16*)(F.ws + WS_PROJ) : xs;
    if (!route) {
        f32x4 nx[2][4];
        if (gwv * 2 < M_) {
#pragma unroll
            for (int i = 0; i < 2; ++i) load_row(vin ? vin + (size_t)(gwv * 2 + i) * 1024 : nullptr, xs + (size_t)(gwv * 2 + i) * 1024, nx[i], F.lane); }
        for (int m = gwv * 2; m < M_; m += NGW * 2) { f32x4 x[2][4];
#pragma unroll
            for (int i = 0; i < 2; ++i)
#pragma unroll
                for (int j = 0; j < 4; ++j) x[i][j] = nx[i][j];
            const int mn = m + NGW * 2;
            if (mn < M_) {
#pragma unroll
                for (int i = 0; i < 2; ++i) load_row(vin ? vin + (size_t)(mn + i) * 1024 : nullptr, xs + (size_t)(mn + i) * 1024, nx[i], F.lane); }
            ln_rows<2>(g, bt, x, F.lane);
#pragma unroll
            for (int i = 0; i < 2; ++i) store_rows(x[i], xo + (size_t)(m + i) * 1024, nullptr, ls >= 0 ? hb + (size_t)(m + i) * 1024 : nullptr, mod + ((size_t)(ls < 0 ? 0 : ls) * 8 + (m >> 12)) * 3072, F.lane); }
    } else {
        f32x4 wr[4][4][2];
        const float* R = A.in[I_ROUTER];
#pragma unroll
        for (int j = 0; j < 4; ++j)
#pragma unroll
            for (int i = 0; i < 4; ++i) { const float* rp = R + (size_t)(lcol(F.lane, j) + i) * 8; wr[j][i][0] = *(const f32x4*)rp; wr[j][i][1] = *(const f32x4*)(rp + 4); }
        int* re = (int*)(F.ws + WS_ROUTE); int* rs = re + 2 * M_; float* rg = (float*)(rs + 2 * M_);
        int it = 0, myE0 = -1, myE1 = -1, myM = 0; float myG0 = 0.f;
        v4u na = {0u, 0u, 0u, 0u}, nb = {0u, 0u, 0u, 0u};
        if (gwv < M_) { na = *(const GAS v4u*)(xs + (size_t)gwv * 1024 + 8 * F.lane); nb = *(const GAS v4u*)(xs + (size_t)gwv * 1024 + 512 + 8 * F.lane); }
        for (int m = gwv; m < M_; m += NGW) { f32x4 x1[1][4]; unpack_row(na, nb, x1[0]);
            if (m + NGW < M_) { na = *(const GAS v4u*)(xs + (size_t)(m + NGW) * 1024 + 8 * F.lane); nb = *(const GAS v4u*)(xs + (size_t)(m + NGW) * 1024 + 512 + 8 * F.lane); }
            ln_rows<1>(g, bt, x1, F.lane); f32x4 (&x)[4] = x1[0];
            store_rows(x, xo + (size_t)m * 1024, nullptr, hb + (size_t)m * 1024, mod + ((size_t)ls * 8 + (m >> 12)) * 3072, F.lane);
            f32x4 p0 = {0.f, 0.f, 0.f, 0.f}, p1 = {0.f, 0.f, 0.f, 0.f};
#pragma unroll
            for (int j = 0; j < 4; ++j) { p0 += wr[j][0][0] * x[j].x + wr[j][1][0] * x[j].y + wr[j][2][0] * x[j].z + wr[j][3][0] * x[j].w;
                                           p1 += wr[j][0][1] * x[j].x + wr[j][1][1] * x[j].y + wr[j][2][1] * x[j].z + wr[j][3][1] * x[j].w; }
            float lg[8] = {wave_sum(p0.x), wave_sum(p0.y), wave_sum(p0.z), wave_sum(p0.w), wave_sum(p1.x), wave_sum(p1.y), wave_sum(p1.z), wave_sum(p1.w)};
            int i0 = 0; float v0 = lg[0];
#pragma unroll
            for (int e = 1; e < 8; ++e) if (lg[e] > v0) { v0 = lg[e]; i0 = e; }
            int i1 = -1; float v1 = -INFINITY;
#pragma unroll
            for (int e = 0; e < 8; ++e) if (e != i0 && lg[e] > v1) { v1 = lg[e]; i1 = e; }
            if (F.lane == it) { myE0 = i0; myE1 = i1; myG0 = 1.f / (1.f + __expf(v1 - v0)); myM = m; }
            ++it;
            if (it == 16 || m + NGW >= M_) {
                const bool act = F.lane < it && !dry; unsigned base[8]; unsigned long long b0[8], b1[8];
#pragma unroll
                for (int e = 0; e < 8; ++e) { b0[e] = __ballot(act && myE0 == e); b1[e] = __ballot(act && myE1 == e); }
#pragma unroll
                for (int e = 0; e < 8; ++e) { base[e] = 0u;
                    if (F.lane == 0 && (b0[e] | b1[e])) base[e] = atomicAdd((unsigned*)(F.ctl + CW_CNT + e * 64), (unsigned)(__popcll(b0[e]) + __popcll(b1[e]))); }
                int s0 = 0, s1 = 0; const unsigned long long lt = (1ull << F.lane) - 1ull;
#pragma unroll
                for (int e = 0; e < 8; ++e) { const unsigned bb = __builtin_amdgcn_readfirstlane(base[e]);
                    if (myE0 == e) s0 = (int)bb + __popcll(b0[e] & lt); if (myE1 == e) s1 = (int)bb + __popcll(b0[e]) + __popcll(b1[e] & lt); }
                if (act) { re[myM] = myE0; re[M_ + myM] = myE1; rs[myM] = s0; rs[M_ + myM] = s1; rg[myM] = myG0; rg[M_ + myM] = 1.f - myG0; }
                it = 0; }
        }
    }
}
__device__ __forceinline__ float conv_silu(const bf16* proj, const float* cw, const float* cb, int b, int t, int ch, int pcol) {
    float a = cb[ch];
#pragma unroll
    for (int k = 0; k < 4; ++k) { const int tt = t - 3 + k; if (tt >= 0) a += cw[k * 768 + ch] * bf2f(proj[((size_t)b * T_ + tt) * NPROJ + pcol]); }
    return silu(a);
}
__device__ __forceinline__ void ssd_chunk_naive(Frame& F, const Args& A, int l, int unit) {
    const int h = unit & 7, c = (unit >> 3) & 31, b = unit >> 8, g = h >> 2;
    const int row0 = b * T_ + c * 128;
    const bf16* proj = (const bf16*)(F.ws + WS_PROJ);
    const float* cw = A.in[I_CONVW] + l * 4 * 768; const float* cb = A.in[I_CONVB] + l * 768;
    LAS float* xs = (LAS float*)(F.lds);
    LAS float* Bs = (LAS float*)(F.lds + 32768);
    LAS float* Cs = (LAS float*)(F.lds + 65536);
    LAS float* dts = (LAS float*)(F.lds + 98304);
    LAS float* acs = dts + 128;
    for (int idx = F.tid; idx < 128 * 64; idx += NTHR) { const int t = idx >> 6, p = idx & 63;
        xs[idx] = conv_silu(proj, cw, cb, b, c * 128 + t, 64 * h + p, PX + 64 * h + p);
        Bs[idx] = conv_silu(proj, cw, cb, b, c * 128 + t, 512 + 64 * g + p, PB + 64 * g + p);
        Cs[idx] = conv_silu(proj, cw, cb, b, c * 128 + t, 640 + 64 * g + p, PC + 64 * g + p); }
    const float* dtv = (const float*)(F.ws + WS_DTV); float* ACS = (float*)(F.ws + WS_ACS);
    if (F.tid < 128) { const float xv = dtv[(size_t)(row0 + F.tid) * 8 + h] + A.in[I_DTB][l * 8 + h]; const float ev = __expf(xv); dts[F.tid] = xv > 20.f ? xv : (ev < 0.01f ? ev * (1.f - ev * (0.5f - ev * 0.33333333f)) : __logf(1.f + ev)); }
    __syncthreads();
    if (F.tid == 0) { const float Ah = -__expf(A.in[I_ALOG][l * 8 + h]); float s = 0.f; for (int t = 0; t < 128; ++t) { s += dts[t] * Ah; acs[t] = s; } }
    __syncthreads();
    if (F.tid < 128) ACS[(size_t)(row0 + F.tid) * 8 + h] = acs[F.tid];
    { float* ST = (float*)(F.ws + WS_ST) + (size_t)((b * NCH + c) * 8 + h) * 4096; const float alast = acs[127];
      for (int idx = F.tid; idx < 4096; idx += NTHR) { const int p = idx >> 6, n = idx & 63; float a = 0.f;
          for (int s = 0; s < 128; ++s) a += xs[s * 64 + p] * Bs[s * 64 + n] * (dts[s] * __expf(alast - acs[s]));
          ST[idx] = a; } }
    { const int lq = F.tid >> 2, pq = (F.tid & 3) * 16; float y[16];
#pragma unroll
      for (int i = 0; i < 16; ++i) y[i] = 0.f;
      const float al = acs[lq];
      for (int s = 0; s <= lq; ++s) { float cbv = 0.f;
#pragma unroll 8
          for (int n = 0; n < 64; ++n) cbv += Cs[lq * 64 + n] * Bs[s * 64 + n];
          const float gg = cbv * __expf(al - acs[s]) * dts[s];
#pragma unroll
          for (int i = 0; i < 16; ++i) y[i] += gg * xs[s * 64 + pq + i]; }
      const float Dh = A.in[I_SSDD][l * 8 + h];
      bf16* yc = (bf16*)(F.ws + WS_A) + (size_t)(row0 + lq) * 1024 + 64 * h + pq;
#pragma unroll
      for (int i = 0; i < 16; i += 2) *(unsigned*)(yc + i) = pk2(y[i] + Dh * xs[lq * 64 + pq + i], y[i + 1] + Dh * xs[lq * 64 + pq + i + 1]); }
    __syncthreads();
}
__device__ __forceinline__ void gmlp_naive(Frame& F, const Args& A, int l, int unit) {
    const int row0 = unit * 128;
    const bf16* proj = (const bf16*)(F.ws + WS_PROJ);
    LAS float* vs = (LAS float*)(F.lds);
    for (int r = F.wave * 16; r < F.wave * 16 + 16; ++r) { const bf16* gp = proj + (size_t)(row0 + r) * NPROJ + PGV + 4 * F.lane; const v2u w = *(const v2u*)gp;
        float v[4] = {gelu_erf(bflo(w.x)), gelu_erf(bfhi(w.x)), gelu_erf(bflo(w.y)), gelu_erf(bfhi(w.y))};
        const float mean = wave_sum((v[0] + v[1]) + (v[2] + v[3])) * (1.f / 256.f); float s2 = 0.f;
#pragma unroll
        for (int i = 0; i < 4; ++i) { v[i] -= mean; s2 += v[i] * v[i]; }
        const float rstd = 1.f / sqrtf(wave_sum(s2) * (1.f / 256.f) + LN_EPS);
#pragma unroll
        for (int i = 0; i < 4; ++i) vs[r * 256 + 4 * F.lane + i] = v[i] * rstd * A.in[I_GMLNG][l * 256 + 4 * F.lane + i] + A.in[I_GMLNB][l * 256 + 4 * F.lane + i]; }
    __syncthreads();
    { const int t = F.tid >> 2, g = F.tid & 3; const float* W = A.in[I_GMWS] + ((size_t)(l * 4 + g) * 128 + t) * 128; float a[64];
#pragma unroll
      for (int i = 0; i < 64; ++i) a[i] = 0.f;
      for (int s = 0; s <= t; ++s) { const float w = W[s];
#pragma unroll
          for (int i = 0; i < 64; ++i) a[i] += w * vs[s * 256 + 64 * g + i]; }
      const float bs = A.in[I_GMBS][(l * 4 + g) * 128 + t];
      const bf16* gu = proj + (size_t)(row0 + t) * NPROJ + PGU + 64 * g; bf16* yc = (bf16*)(F.ws + WS_A) + (size_t)(row0 + t) * 1024 + 768 + 64 * g;
#pragma unroll
      for (int i = 0; i < 64; i += 2) { const unsigned w = *(const unsigned*)(gu + i); *(unsigned*)(yc + i) = pk2(gelu_erf(bflo(w)) * (a[i] + bs), gelu_erf(bfhi(w)) * (a[i + 1] + bs)); } }
    __syncthreads();
}
__device__ __forceinline__ void token_local(Frame& F) {
    const int gwv = F.bid * NWAVES + F.wave, NGW = F.G * NWAVES;
    const bf16* proj = (const bf16*)(F.ws + WS_PROJ); float* rq = (float*)(F.ws + WS_RSTD); float* rkv = rq + M_; bf16* kpe = (bf16*)(F.ws + WS_KPE);
    const float* rc = (const float*)(F.ws + WS_ROPE); const float* rsn = rc + 4096 * 16;
    const int g = (F.lane & 15) >> 2, w = F.lane & 3, ri = 4 * g + w;
    for (int m0 = gwv * 4; m0 < M_; m0 += NGW * 4) {
        v2u wq[4]; unsigned wk[4]; float x1[4], x2[4], cs[4], sn[4];
#pragma unroll
        for (int i = 0; i < 4; ++i) { const bf16* pr = proj + (size_t)(m0 + i) * NPROJ; wq[i] = *(const v2u*)(pr + PQ + 4 * F.lane); wk[i] = *(const unsigned*)(pr + PKV + 2 * F.lane);
            x1[i] = bf2f(pr[PKPE + 8 * g + w]); x2[i] = bf2f(pr[PKPE + 8 * g + 4 + w]); const int t = (m0 + i) & 4095; cs[i] = rc[t * 16 + ri]; sn[i] = rsn[t * 16 + ri]; }
        float sq[4], sk[4];
#pragma unroll
        for (int i = 0; i < 4; ++i) { sq[i] = bflo(wq[i].x) * bflo(wq[i].x) + bfhi(wq[i].x) * bfhi(wq[i].x) + bflo(wq[i].y) * bflo(wq[i].y) + bfhi(wq[i].y) * bfhi(wq[i].y); sk[i] = bflo(wk[i]) * bflo(wk[i]) + bfhi(wk[i]) * bfhi(wk[i]); }
#pragma unroll
        for (int o = 1; o < 64; o <<= 1) {
#pragma unroll
            for (int i = 0; i < 4; ++i) { sq[i] += __shfl_xor(sq[i], o); sk[i] += __shfl_xor(sk[i], o); } }
#pragma unroll
        for (int i = 0; i < 4; ++i) { const int m = m0 + i;
            if (F.lane == 0) { rq[m] = 1.f / sqrtf(sq[i] * (1.f / 256.f) + RMS_EPS); rkv[m] = 1.f / sqrtf(sk[i] * (1.f / 128.f) + RMS_EPS); }
            if (F.lane < 16) { kpe[(size_t)m * 32 + 8 * g + w] = (bf16)f2bf(x1[i] * cs[i] - x2[i] * sn[i]); kpe[(size_t)m * 32 + 8 * g + 4 + w] = (bf16)f2bf(x1[i] * sn[i] + x2[i] * cs[i]); } }
    }
}
__device__ __forceinline__ void state_scan(Frame& F) {
    float* ST = (float*)(F.ws + WS_ST); const float* ACS = (const float*)(F.ws + WS_ACS);
    for (int idx = F.bid * NTHR + F.tid; idx < NB * 8 * 4096; idx += F.G * NTHR) { const int pn = idx & 4095, h = (idx >> 12) & 7, b = idx >> 15; float cur = 0.f;
        for (int c = 0; c < NCH; ++c) { const size_t a = (size_t)((b * NCH + c) * 8 + h) * 4096 + pn; const float s = ST[a]; ST[a] = cur;
            cur = cur * __expf(ACS[(size_t)(b * T_ + c * 128 + 127) * 8 + h]) + s; } }
}
__device__ __forceinline__ void ssd_finish_naive(Frame& F, const Args& A, int l, int unit) {
    const int g = unit & 1, c = (unit >> 1) & 31, b = unit >> 6; const int row0 = b * T_ + c * 128;
    const bf16* proj = (const bf16*)(F.ws + WS_PROJ);
    const float* cw = A.in[I_CONVW] + l * 4 * 768; const float* cb = A.in[I_CONVB] + l * 768;
    LAS float* Sin = (LAS float*)(F.lds);
    LAS float* Cs = (LAS float*)(F.lds + 4 * 64 * 65 * 4);
    const float* ST = (const float*)(F.ws + WS_ST) + (size_t)((b * NCH + c) * 8 + 4 * g) * 4096;
    for (int idx = F.tid; idx < 4 * 4096; idx += NTHR) { const int r = idx >> 12, p = (idx >> 6) & 63, n = idx & 63; Sin[(r * 64 + p) * 65 + n] = ST[idx]; }
    for (int idx = F.tid; idx < 128 * 64; idx += NTHR) { const int t = idx >> 6, n = idx & 63; Cs[t * 65 + n] = conv_silu(proj, cw, cb, b, c * 128 + t, 640 + 64 * g + n, PC + 64 * g + n); }
    __syncthreads();
    const int lq = F.tid >> 2, r = F.tid & 3, h = 4 * g + r;
    float cv[64];
#pragma unroll
    for (int n = 0; n < 64; ++n) cv[n] = Cs[lq * 65 + n];
    const float ea = __expf(((const float*)(F.ws + WS_ACS))[(size_t)(row0 + lq) * 8 + h]);
    bf16* yc = (bf16*)(F.ws + WS_A) + (size_t)(row0 + lq) * 1024 + 64 * h; const bf16* zp = proj + (size_t)(row0 + lq) * NPROJ + PZ + 64 * h;
    float ss = 0.f;
#pragma unroll 1
    for (int p = 0; p < 64; ++p) { float a = 0.f;
#pragma unroll
        for (int n = 0; n < 64; ++n) a += cv[n] * Sin[(r * 64 + p) * 65 + n];
        const float y = bf2f(yc[p]) + ea * a, gy = y * silu(bf2f(zp[p])); ss += gy * gy; }
    ss += __shfl_xor(ss, 1); ss += __shfl_xor(ss, 2);
    const float rs = 1.f / sqrtf(ss * (1.f / 256.f) + RMS_EPS); const float* nw = A.in[I_SSDNW] + l * 512 + 64 * h;
#pragma unroll 1
    for (int p = 0; p < 64; ++p) { float a = 0.f;
#pragma unroll
        for (int n = 0; n < 64; ++n) a += cv[n] * Sin[(r * 64 + p) * 65 + n];
        const float y = bf2f(yc[p]) + ea * a, gy = y * silu(bf2f(zp[p])); yc[p] = (bf16)f2bf(gy * rs * nw[p]); }
    __syncthreads();
}
__device__ __forceinline__ void attn_naive(Frame& F, int unit) {
    const int qb = unit & 63, h = (unit >> 6) & 3, b = unit >> 8;
    const bf16* Q = (const bf16*)(F.ws + WS_Q); const bf16* KN = (const bf16*)(F.ws + WS_KN); const bf16* V = (const bf16*)(F.ws + WS_V); const bf16* KPE = (const bf16*)(F.ws + WS_KPE);
    LAS float* Kt = (LAS float*)(F.lds);
    LAS float* Vt = (LAS float*)(F.lds + 64 * 97 * 4);
    LAS float* Qs = Vt + 64 * 64;
    LAS float* Pw = Qs + 64 * 96 + F.wave * 64;
    for (int idx = F.tid; idx < 64 * 96; idx += NTHR) { const int r = idx / 96, d = idx % 96; Qs[idx] = bf2f(Q[(size_t)(b * T_ + qb * 64 + r) * 384 + h * 96 + d]); }
    float mx[8], ls[8], o[8];
#pragma unroll
    for (int i = 0; i < 8; ++i) { mx[i] = -INFINITY; ls[i] = 0.f; o[i] = 0.f; }
    for (int kt = 0; kt <= qb; ++kt) {
        __syncthreads();
        for (int idx = F.tid; idx < 64 * 96; idx += NTHR) { const int j = idx / 96, d = idx % 96; const size_t row = (size_t)(b * T_ + kt * 64 + j);
            Kt[j * 97 + d] = d < 64 ? bf2f(KN[row * 256 + h * 64 + d]) : bf2f(KPE[row * 32 + d - 64]); }
        for (int idx = F.tid; idx < 64 * 64; idx += NTHR) { const int j = idx >> 6, d = idx & 63; Vt[idx] = bf2f(V[(size_t)(b * T_ + kt * 64 + j) * 256 + h * 64 + d]); }
        __syncthreads();
#pragma unroll
        for (int i = 0; i < 8; ++i) { const int qr = F.wave * 8 + i; float s = 0.f;
#pragma unroll 8
            for (int d = 0; d < 96; ++d) s += Qs[qr * 96 + d] * Kt[F.lane * 97 + d];
            if (kt * 64 + F.lane > qb * 64 + qr) s = -INFINITY;
            const float mn = fmaxf(mx[i], wave_max(s)), p = exp2f(s - mn), corr = exp2f(mx[i] - mn);
            ls[i] = ls[i] * corr + wave_sum(p); mx[i] = mn;
            Pw[F.lane] = p; LDS_WAIT(); asm volatile("" ::: "memory");
            float a = 0.f;
#pragma unroll 8
            for (int j = 0; j < 64; ++j) a += Pw[j] * Vt[j * 64 + F.lane];
            o[i] = o[i] * corr + a; LDS_WAIT(); asm volatile("" ::: "memory"); }
    }
    bf16* yc = (bf16*)(F.ws + WS_A);
#pragma unroll
    for (int i = 0; i < 8; ++i) yc[(size_t)(b * T_ + qb * 64 + F.wave * 8 + i) * 1024 + 512 + h * 64 + F.lane] = (bf16)f2bf(o[i] / ls[i]);
    __syncthreads();
}
namespace att {
typedef short bf16x8 __attribute__((ext_vector_type(8)));
typedef short s16x4 __attribute__((ext_vector_type(4)));
typedef float f32x16 __attribute__((ext_vector_type(16)));
typedef unsigned u32x4 __attribute__((ext_vector_type(4)));
constexpr int KSLOT = 12288, VSLOT = 8192, NSLOT = 3, LDS_K = 0, LDS_V = NSLOT * KSLOT, LDS_TOTAL = NSLOT * (KSLOT + VSLOT);
__device__ __forceinline__ int crow(int r, int hi) { return (r & 3) + 8 * (r >> 2) + 4 * hi; }
__device__ __forceinline__ s16x4 vtr(const LAS unsigned char* p) { return __builtin_bit_cast(s16x4, __builtin_amdgcn_ds_read_tr16_b64_v4i16((LAS s16x4*)p)); }
__device__ __forceinline__ float xhalf(float v) { return __shfl_xor(v, 32); }
__device__ __forceinline__ unsigned pk(float lo, float hi) { typedef float f2 __attribute__((ext_vector_type(2))); typedef __bf16 b2 __attribute__((ext_vector_type(2))); f2 v = {lo, hi}; b2 b = __builtin_convertvector(v, b2); return __builtin_bit_cast(unsigned, b); }
__device__ __forceinline__ bf16x8 pack8r(const f32x16& x, int s) { u32x4 w; w.x = pk(x[8 * s], x[8 * s + 1]); w.y = pk(x[8 * s + 2], x[8 * s + 3]); w.z = pk(x[8 * s + 4], x[8 * s + 5]); w.w = pk(x[8 * s + 6], x[8 * s + 7]); return __builtin_bit_cast(bf16x8, w); }
#define ATT_MFMA(a, b, c) __builtin_amdgcn_mfma_f32_32x32x16_bf16((a), (b), (c), 0, 0, 0)
__device__ __forceinline__ void attn_unit(Frame& F, int b, int h, int qb) {
    const int lane = F.lane, r32 = lane & 31, hi = lane >> 5, wid = F.wave;
    const size_t rowbase = (size_t)b * T_; const int q0 = qb * 256, qrow = q0 + 32 * wid + r32;
    const bf16* Q = (const bf16*)(F.ws + WS_Q); const bf16* KN = (const bf16*)(F.ws + WS_KN); const bf16* V = (const bf16*)(F.ws + WS_V); const bf16* KPE = (const bf16*)(F.ws + WS_KPE);
    LAS unsigned char* lds = F.lds;
    const int NT = (q0 + 256) / 64;
    const bf16* srcA = KN + (rowbase + lane) * 256 + h * 64 + 8 * wid; const int dstA = LDS_K + wid * 1024;
    const bf16* srcB; int dstB; size_t strB;
    if (wid < 4) { srcB = KPE + (rowbase + lane) * 32 + 8 * wid; dstB = LDS_K + (8 + wid) * 1024; strB = 64 * 32; }
    else { srcB = V + (rowbase + 16 * (wid - 4) + (lane >> 2)) * 256 + h * 64 + 8 * (lane & 3); dstB = LDS_V + (wid - 4) * 1024; strB = 64 * 256; }
    const bf16* srcC = V + (rowbase + 16 * (wid & 3) + (lane >> 2)) * 256 + h * 64 + 32 + 8 * (lane & 3); const int dstC = LDS_V + (4 + (wid & 3)) * 1024;
    const int slotB = wid < 4 ? KSLOT : VSLOT;
#define ATT_DMA(t, s) do { \
        __builtin_amdgcn_global_load_lds((const unsigned*)(srcA + (size_t)(t) * 64 * 256), (LAS unsigned*)(lds + dstA + (s) * KSLOT), 16, 0, 0); \
        __builtin_amdgcn_global_load_lds((const unsigned*)(srcB + (size_t)(t) * strB), (LAS unsigned*)(lds + dstB + (s) * slotB), 16, 0, 0); \
        __builtin_amdgcn_global_load_lds((const unsigned*)(srcC + (size_t)(t) * 64 * 256), (LAS unsigned*)(lds + dstC + (s) * VSLOT), 16, 0, 0); } while (0)
    bf16x8 qr[6];
#pragma unroll
    for (int d0 = 0; d0 < 6; ++d0) qr[d0] = *(const GAS bf16x8*)(Q + (rowbase + qrow) * 384 + h * 96 + 16 * d0 + 8 * hi);
    asm volatile("s_waitcnt vmcnt(0)" ::: "memory");
    ATT_DMA(0, 0); ATT_DMA(1, 1);
    f32x16 o0, o1;
#pragma unroll
    for (int i = 0; i < 16; ++i) { o0[i] = 0.f; o1[i] = 0.f; }
    float m = -INFINITY, l = 0.f;
    const int voff = ((lane >> 4) & 1) * 32 + (lane & 3) * 8 + (4 * hi + ((lane & 15) >> 2)) * 64;
    int slot = 0;
    for (int t = 0; t < NT; ++t) {
        if (t + 1 < NT) asm volatile("s_waitcnt vmcnt(3)" ::: "memory"); else asm volatile("s_waitcnt vmcnt(0)" ::: "memory");
        __builtin_amdgcn_s_barrier(); asm volatile("" ::: "memory");
        if (t + 2 < NT) { const int s2 = slot == 0 ? 2 : slot - 1; ATT_DMA(t + 2, s2); }
        if (64 * t <= q0 + 32 * wid + 31) {
            const LAS unsigned char* kb = lds + LDS_K + slot * KSLOT + hi * 1024 + r32 * 16;
            const LAS unsigned char* vb = lds + LDS_V + slot * VSLOT + voff;
            bf16x8 kf[12]; s16x4 vlo[8], vhi[8];
#pragma unroll
            for (int d0 = 0; d0 < 6; ++d0) { kf[2 * d0] = *(const LAS bf16x8*)(kb + d0 * 2048); kf[2 * d0 + 1] = *(const LAS bf16x8*)(kb + d0 * 2048 + 512); }
#pragma unroll
            for (int i = 0; i < 8; ++i) { vlo[i] = vtr(vb + (i & 1) * 4096 + (i >> 1) * 1024); vhi[i] = vtr(vb + (i & 1) * 4096 + (i >> 1) * 1024 + 512); }
            __builtin_amdgcn_sched_barrier(0);
            f32x16 p0, p1;
#pragma unroll
            for (int i = 0; i < 16; ++i) { p0[i] = 0.f; p1[i] = 0.f; }
#pragma unroll
            for (int d0 = 0; d0 < 6; ++d0) { p0 = ATT_MFMA(kf[2 * d0], qr[d0], p0); p1 = ATT_MFMA(kf[2 * d0 + 1], qr[d0], p1); }
            if (64 * t + 63 > q0 + 32 * wid) {
#pragma unroll
                for (int r = 0; r < 16; ++r) { const int kv = 64 * t + crow(r, hi); if (kv > qrow) p0[r] = -INFINITY; if (kv + 32 > qrow) p1[r] = -INFINITY; }
            }
            float mx = fmaxf(p0[0], p1[0]);
#pragma unroll
            for (int r = 1; r < 16; ++r) mx = fmaxf(mx, fmaxf(p0[r], p1[r]));
            mx = fmaxf(mx, xhalf(mx));
            const float mn = fmaxf(m, mx);
            if (__any(mn > m)) { const float corr = __builtin_amdgcn_exp2f(m - mn); l *= corr;
#pragma unroll
                for (int i = 0; i < 16; ++i) { o0[i] *= corr; o1[i] *= corr; }
                m = mn; }
            float sum = 0.f;
#pragma unroll
            for (int r = 0; r < 16; ++r) { p0[r] = __builtin_amdgcn_exp2f(p0[r] - m); p1[r] = __builtin_amdgcn_exp2f(p1[r] - m); sum += p0[r] + p1[r]; }
            l += sum;
            const bf16x8 pa[4] = {pack8r(p0, 0), pack8r(p0, 1), pack8r(p1, 0), pack8r(p1, 1)};
#pragma unroll
            for (int ks = 0; ks < 4; ++ks) {
                o0 = ATT_MFMA(((bf16x8){vlo[2 * ks][0], vlo[2 * ks][1], vlo[2 * ks][2], vlo[2 * ks][3], vhi[2 * ks][0], vhi[2 * ks][1], vhi[2 * ks][2], vhi[2 * ks][3]}), pa[ks], o0);
                o1 = ATT_MFMA(((bf16x8){vlo[2 * ks + 1][0], vlo[2 * ks + 1][1], vlo[2 * ks + 1][2], vlo[2 * ks + 1][3], vhi[2 * ks + 1][0], vhi[2 * ks + 1][1], vhi[2 * ks + 1][2], vhi[2 * ks + 1][3]}), pa[ks], o1); }
        }
        slot = slot == 2 ? 0 : slot + 1;
    }
    l += xhalf(l);
    const float rl = 1.f / l;
    bf16* yc = (bf16*)(F.ws + WS_A) + (rowbase + qrow) * 1024 + 512 + h * 64;
#pragma unroll
    for (int g = 0; g < 4; ++g) { v2u w0, w1; w0.x = pk(o0[4 * g] * rl, o0[4 * g + 1] * rl); w0.y = pk(o0[4 * g + 2] * rl, o0[4 * g + 3] * rl); w1.x = pk(o1[4 * g] * rl, o1[4 * g + 1] * rl); w1.y = pk(o1[4 * g + 2] * rl, o1[4 * g + 3] * rl);
        *(GAS v2u*)(yc + 8 * g + 4 * hi) = w0; *(GAS v2u*)(yc + 32 + 8 * g + 4 * hi) = w1; }
    asm volatile("s_waitcnt lgkmcnt(0)" ::: "memory"); __builtin_amdgcn_s_barrier(); asm volatile("" ::: "memory");
#undef ATT_DMA
}
#undef ATT_MFMA
}
namespace mix {
typedef short bf16x8 __attribute__((ext_vector_type(8)));
typedef short s16x4 __attribute__((ext_vector_type(4)));
typedef float f32x2 __attribute__((ext_vector_type(2)));
#define MIX_MFMA(a, b, c) __builtin_amdgcn_mfma_f32_16x16x32_bf16((a), (b), (c), 0, 0, 0)
constexpr int XP = 272, BP = 80;
constexpr int LX = 0, LBS = LX + 128 * XP * 2, LCS = LBS + 128 * BP * 2, LDT = LCS + 128 * BP * 2, LACS = LDT + 4 * 128 * 4, LEND = LACS + 4 * 128 * 4;
static_assert(LEND <= RING_BYTES, "SSD LDS map");
__device__ __forceinline__ s16x4 trd(const LAS unsigned char* img, int P, int row0, int col0, int lane) {
    return __builtin_bit_cast(s16x4, __builtin_amdgcn_ds_read_tr16_b64_v4i16((LAS s16x4*)(img + (row0 + ((lane & 15) >> 2)) * P + col0 * 2 + (lane & 3) * 8))); }
#define MIX_CAT(a, b) ((bf16x8){(a)[0], (a)[1], (a)[2], (a)[3], (b)[0], (b)[1], (b)[2], (b)[3]})
__device__ __forceinline__ float softplus(float xv) { const float ev = __expf(xv); return xv > 20.f ? xv : (ev < 0.01f ? ev * (1.f - ev * (0.5f - ev * 0.33333333f)) : __logf(1.f + ev)); }
__device__ __forceinline__ f32x2 gelu_pk(f32x2 v) {
    const f32x2 av = __builtin_elementwise_abs(v), d = av * 0.2316418882f + 1.0f;
    f32x2 t; t.x = __builtin_amdgcn_rcpf(d.x); t.y = __builtin_amdgcn_rcpf(d.y);
    f32x2 q = t * 0.5307027145f + (-0.7265760135f); q = q * t + 0.7107068705f; q = q * t + (-0.142248368f); q = q * t + 0.127414796f; q = q * t;
    const f32x2 s = (v * v) * (-0.72134752044f);
    f32x2 e; e.x = __builtin_amdgcn_exp2f(s.x); e.y = __builtin_amdgcn_exp2f(s.y);
    const f32x2 m = v * (q * e), r = v - m;
    f32x2 o; o.x = v.x < 0.f ? m.x : r.x; o.y = v.y < 0.f ? m.y : r.y; return o;
}
__device__ __forceinline__ void ssd_chunk(Frame& F, const Args& A, int l, int unit) {
    const int g = unit & 1, c = (unit >> 1) & 31, b = unit >> 6; const int row0 = b * T_ + c * 128, tq0 = c * 128;
    const int tid = F.tid, lane = F.lane, w = F.wave, fr = lane & 15, fq = lane >> 4;
    const bf16* proj = (const bf16*)(F.ws + WS_PROJ);
    const float* cw = A.in[I_CONVW] + l * 4 * 768; const float* cb = A.in[I_CONVB] + l * 768;
    LAS unsigned char* lds = F.lds;
    { const int chp = tid & 127, tseg = tid >> 7, cg = 2 * chp, ch = 256 * g + cg;
      float wk[4][2];
#pragma unroll
      for (int k = 0; k < 4; ++k) { wk[k][0] = cw[k * 768 + ch]; wk[k][1] = cw[k * 768 + ch + 1]; }
      const float b0 = cb[ch], b1 = cb[ch + 1];
      unsigned xin[35];
#pragma unroll
      for (int i = 0; i < 35; ++i) { const int tt = tq0 + 32 * tseg - 3 + i; xin[i] = tt >= 0 ? *(const unsigned*)(proj + (size_t)(b * T_ + tt) * NPROJ + PX + ch) : 0u; }
      LAS unsigned char* x0p = lds + LX + (32 * tseg) * XP * 2 + cg * 2;
#pragma unroll
      for (int i = 0; i < 32; i += 2) { float y[2][2];
#pragma unroll
          for (int u = 0; u < 2; ++u) { float a0 = b0, a1 = b1;
#pragma unroll
              for (int k = 0; k < 4; ++k) { a0 += wk[k][0] * bflo(xin[i + u + k]); a1 += wk[k][1] * bfhi(xin[i + u + k]); }
              y[u][0] = silu(a0); y[u][1] = silu(a1); }
          *(LAS unsigned*)(x0p + i * XP * 2) = pk2(y[0][0], y[0][1]); *(LAS unsigned*)(x0p + (i + 1) * XP * 2) = pk2(y[1][0], y[1][1]); } }
    { const int which = tid >> 8, chp = tid & 31, tseg = (tid >> 5) & 7, n0 = 2 * chp, ch = 512 + which * 128 + 64 * g + n0, pcol = (which ? PC : PB) + 64 * g + n0;
      float wk[4][2];
#pragma unroll
      for (int k = 0; k < 4; ++k) { wk[k][0] = cw[k * 768 + ch]; wk[k][1] = cw[k * 768 + ch + 1]; }
      const float b0 = cb[ch], b1 = cb[ch + 1];
      unsigned xin[19];
#pragma unroll
      for (int i = 0; i < 19; ++i) { const int tt = tq0 + 16 * tseg - 3 + i; xin[i] = tt >= 0 ? *(const unsigned*)(proj + (size_t)(b * T_ + tt) * NPROJ + pcol) : 0u; }
      bf16* CC = (bf16*)(F.ws + WS_CC);
#pragma unroll
      for (int i = 0; i < 16; i += 2) { float y[2][2];
#pragma unroll
          for (int u = 0; u < 2; ++u) { float a0 = b0, a1 = b1;
#pragma unroll
              for (int k = 0; k < 4; ++k) { a0 += wk[k][0] * bflo(xin[i + u + k]); a1 += wk[k][1] * bfhi(xin[i + u + k]); }
              y[u][0] = silu(a0); y[u][1] = silu(a1); }
          const int s = 16 * tseg + i;
          const unsigned r0 = pk2(y[0][0], y[0][1]), r1 = pk2(y[1][0], y[1][1]);
          if (which == 0) { *(LAS unsigned*)(lds + LBS + (s * BP + n0) * 2) = r0; *(LAS unsigned*)(lds + LBS + ((s + 1) * BP + n0) * 2) = r1; }
          else { *(LAS unsigned*)(lds + LCS + (s * BP + n0) * 2) = r0; *(LAS unsigned*)(lds + LCS + ((s + 1) * BP + n0) * 2) = r1;
              *(unsigned*)(CC + (size_t)(row0 + s) * 128 + 64 * g + n0) = r0; *(unsigned*)(CC + (size_t)(row0 + s + 1) * 128 + 64 * g + n0) = r1; } } }
    if (w < 4) { const int h = 4 * g + w; const float* dtv = (const float*)(F.ws + WS_DTV); const float bias = A.in[I_DTB][l * 8 + h], Ah = -__expf(A.in[I_ALOG][l * 8 + h]);
        const float d0 = softplus(dtv[(size_t)(row0 + 2 * lane) * 8 + h] + bias), d1 = softplus(dtv[(size_t)(row0 + 2 * lane + 1) * 8 + h] + bias);
        const float a0 = d0 * Ah, a1 = d1 * Ah; float s = a0 + a1;
#pragma unroll
        for (int o = 1; o < 64; o <<= 1) { const float v = __shfl_up(s, o); if (lane >= o) s += v; }
        const float c1 = s, c0 = s - a1;
        LAS float* dts = (LAS float*)(lds + LDT) + w * 128; LAS float* acs = (LAS float*)(lds + LACS) + w * 128;
        dts[2 * lane] = d0; dts[2 * lane + 1] = d1; acs[2 * lane] = c0; acs[2 * lane + 1] = c1;
        float* ACS = (float*)(F.ws + WS_ACS); ACS[(size_t)(row0 + 2 * lane) * 8 + h] = c0; ACS[(size_t)(row0 + 2 * lane + 1) * 8 + h] = c1; }
    __syncthreads();
    f32x4 cbT[8];
    { bf16x8 cf[2];
#pragma unroll
      for (int ks = 0; ks < 2; ++ks) cf[ks] = *(const LAS bf16x8*)(lds + LCS + ((16 * w + fr) * BP + 32 * ks + 8 * fq) * 2);
#pragma unroll
      for (int st = 0; st < 8; ++st) { cbT[st] = (f32x4){0.f, 0.f, 0.f, 0.f};
          {
#pragma unroll
              for (int ks = 0; ks < 2; ++ks) { const bf16x8 bfg = *(const LAS bf16x8*)(lds + LBS + ((16 * st + fr) * BP + 32 * ks + 8 * fq) * 2); cbT[st] = MIX_MFMA(bfg, cf[ks], cbT[st]); } } } }
    const int lrow = 16 * w + fr;
#pragma unroll 1
    for (int r = 0; r < 4; ++r) { const int h = 4 * g + r;
        const LAS float* dts = (const LAS float*)(lds + LDT) + r * 128; const LAS float* acs = (const LAS float*)(lds + LACS) + r * 128;
        const float al = acs[lrow];
        bf16x8 gf[4];
#pragma unroll
        for (int i = 0; i < 4; ++i) { float gv[8];
#pragma unroll
            for (int hf = 0; hf < 2; ++hf) { const int st = 2 * i + hf; const f32x4 a4 = *(const LAS f32x4*)(acs + 16 * st + 4 * fq), d4 = *(const LAS f32x4*)(dts + 16 * st + 4 * fq);
#pragma unroll
                for (int j = 0; j < 4; ++j) { const int s = 16 * st + 4 * fq + j; gv[4 * hf + j] = s <= lrow ? cbT[st][j] * __expf(al - a4[j]) * d4[j] : 0.f; } }
            v4u pw; pw.x = pk2(gv[0], gv[1]); pw.y = pk2(gv[2], gv[3]); pw.z = pk2(gv[4], gv[5]); pw.w = pk2(gv[6], gv[7]); gf[i] = __builtin_bit_cast(bf16x8, pw); }
        const float Dh = A.in[I_SSDD][l * 8 + h];
        const LAS unsigned char* ximg = lds + LX;
        bf16* yc = (bf16*)(F.ws + WS_A) + (size_t)(row0 + lrow) * 1024 + 64 * h;
#pragma unroll
        for (int pt = 0; pt < 4; ++pt) { f32x4 acc = {0.f, 0.f, 0.f, 0.f};
#pragma unroll
            for (int i = 0; i < 4; ++i) { const s16x4 x0 = trd(ximg, XP * 2, 32 * i + 4 * fq, 64 * r + 16 * pt, lane), x1 = trd(ximg, XP * 2, 32 * i + 16 + 4 * fq, 64 * r + 16 * pt, lane);
                acc = MIX_MFMA(MIX_CAT(x0, x1), gf[i], acc); }
            const v2u xl = *(const LAS v2u*)(ximg + (lrow * XP + 64 * r + 16 * pt + 4 * fq) * 2);
            v2u o; o.x = pk2(acc[0] + Dh * bflo(xl.x), acc[1] + Dh * bfhi(xl.x)); o.y = pk2(acc[2] + Dh * bflo(xl.y), acc[3] + Dh * bfhi(xl.y));
            *(v2u*)(yc + 16 * pt + 4 * fq) = o; }
        { const float alast = acs[127]; const int pt = w >> 1; f32x4 s0 = {0.f, 0.f, 0.f, 0.f}, s1 = {0.f, 0.f, 0.f, 0.f};
#pragma unroll
          for (int ks = 0; ks < 4; ++ks) { const s16x4 xlo = trd(ximg, XP * 2, 32 * ks + 8 * fq, 64 * r + 16 * pt, lane), xhi = trd(ximg, XP * 2, 32 * ks + 8 * fq + 4, 64 * r + 16 * pt, lane);
              const v2u xa2 = __builtin_bit_cast(v2u, xlo), xb2 = __builtin_bit_cast(v2u, xhi); v4u xw; xw.x = xa2.x; xw.y = xa2.y; xw.z = xb2.x; xw.w = xb2.y;
              const f32x4 a0 = *(const LAS f32x4*)(acs + 32 * ks + 8 * fq), a1 = *(const LAS f32x4*)(acs + 32 * ks + 8 * fq + 4), d0 = *(const LAS f32x4*)(dts + 32 * ks + 8 * fq), d1 = *(const LAS f32x4*)(dts + 32 * ks + 8 * fq + 4);
              v4u sw; sw.x = pk2(bflo(xw.x) * d0[0] * __expf(alast - a0[0]), bfhi(xw.x) * d0[1] * __expf(alast - a0[1])); sw.y = pk2(bflo(xw.y) * d0[2] * __expf(alast - a0[2]), bfhi(xw.y) * d0[3] * __expf(alast - a0[3]));
              sw.z = pk2(bflo(xw.z) * d1[0] * __expf(alast - a1[0]), bfhi(xw.z) * d1[1] * __expf(alast - a1[1])); sw.w = pk2(bflo(xw.w) * d1[2] * __expf(alast - a1[2]), bfhi(xw.w) * d1[3] * __expf(alast - a1[3]));
              const bf16x8 xa = __builtin_bit_cast(bf16x8, sw);
              const LAS unsigned char* bimg = lds + LBS;
              const bf16x8 bt0 = MIX_CAT(trd(bimg, BP * 2, 32 * ks + 8 * fq, 16 * (2 * (w & 1)), lane), trd(bimg, BP * 2, 32 * ks + 8 * fq + 4, 16 * (2 * (w & 1)), lane));
              const bf16x8 bt1 = MIX_CAT(trd(bimg, BP * 2, 32 * ks + 8 * fq, 16 * (2 * (w & 1) + 1), lane), trd(bimg, BP * 2, 32 * ks + 8 * fq + 4, 16 * (2 * (w & 1) + 1), lane));
              s0 = MIX_MFMA(xa, bt0, s0); s1 = MIX_MFMA(xa, bt1, s1); }
          float* ST = (float*)(F.ws + WS_ST) + (size_t)((b * NCH + c) * 8 + h) * 4096 + (16 * pt + 4 * fq) * 64 + 32 * (w & 1) + fr;
#pragma unroll
          for (int j = 0; j < 4; ++j) { ST[j * 64] = s0[j]; ST[j * 64 + 16] = s1[j]; } }
    }
    __syncthreads();
}
__device__ __forceinline__ void state_scan2(Frame& F) {
    const float* ST = (const float*)(F.ws + WS_ST); const float* ACS = (const float*)(F.ws + WS_ACS); bf16* SB = (bf16*)(F.ws + WS_SB);
    for (int idx = F.bid * NTHR + F.tid; idx < NB * 8 * 4096; idx += F.G * NTHR) { const int pn = idx & 4095, h = (idx >> 12) & 7, b = idx >> 15; float cur = 0.f;
#pragma unroll 4
        for (int c = 0; c < NCH; ++c) { const size_t a = (size_t)((b * NCH + c) * 8 + h) * 4096 + pn; const float s = ST[a]; SB[a] = (bf16)f2bf(cur);
            cur = cur * __expf(ACS[(size_t)(b * T_ + c * 128 + 127) * 8 + h]) + s; } }
}
__device__ __forceinline__ void ssd_finish(Frame& F, const Args& A, int l, int unit, bool dry = false) {
    const int g = unit & 1, c = (unit >> 1) & 31, b = unit >> 6; const int row0 = b * T_ + c * 128;
    const int lane = F.lane, w = F.wave, fr = lane & 15, fq = lane >> 4, lrow = row0 + 16 * w + fr;
    const bf16* proj = (const bf16*)(F.ws + WS_PROJ); const bf16* CC = (const bf16*)(F.ws + WS_CC); const bf16* SB = (const bf16*)(F.ws + WS_SB) + (size_t)((b * NCH + c) * 8 + 4 * g) * 4096;
    bf16x8 cf[2];
#pragma unroll
    for (int ks = 0; ks < 2; ++ks) cf[ks] = *(const bf16x8*)(CC + (size_t)lrow * 128 + 64 * g + 32 * ks + 8 * fq);
    const f32x4 acs4 = *(const f32x4*)((const float*)(F.ws + WS_ACS) + (size_t)lrow * 8 + 4 * g);
    bf16* yc = (bf16*)(F.ws + WS_A) + (size_t)lrow * 1024 + 256 * g + 4 * fq; const bf16* zp = proj + (size_t)lrow * NPROJ + PZ + 256 * g + 4 * fq;
    float gy[4][4][4]; float ss = 0.f;
    bf16x8 sf[2][4][2]; v2u yd[2][4], zz[2][4];
#define SSDF_LOAD(buf, r) do { _Pragma("unroll") for (int pt = 0; pt < 4; ++pt) { _Pragma("unroll") for (int ks = 0; ks < 2; ++ks) sf[buf][pt][ks] = *(const bf16x8*)(SB + (size_t)(r) * 4096 + (16 * pt + fr) * 64 + 32 * ks + 8 * fq); \
        yd[buf][pt] = *(const v2u*)(yc + 64 * (r) + 16 * pt); zz[buf][pt] = *(const v2u*)(zp + 64 * (r) + 16 * pt); } } while (0)
    SSDF_LOAD(0, 0);
#pragma unroll
    for (int r = 0; r < 4; ++r) { const float ea = __expf(acs4[r]); const int cur = r & 1;
        if (r < 3) SSDF_LOAD(cur ^ 1, r + 1);
#pragma unroll
        for (int pt = 0; pt < 4; ++pt) { f32x4 acc = {0.f, 0.f, 0.f, 0.f};
#pragma unroll
            for (int ks = 0; ks < 2; ++ks) acc = MIX_MFMA(sf[cur][pt][ks], cf[ks], acc);
            const float y0 = bflo(yd[cur][pt].x) + ea * acc[0], y1 = bfhi(yd[cur][pt].x) + ea * acc[1], y2 = bflo(yd[cur][pt].y) + ea * acc[2], y3 = bfhi(yd[cur][pt].y) + ea * acc[3];
            gy[r][pt][0] = y0 * silu(bflo(zz[cur][pt].x)); gy[r][pt][1] = y1 * silu(bfhi(zz[cur][pt].x)); gy[r][pt][2] = y2 * silu(bflo(zz[cur][pt].y)); gy[r][pt][3] = y3 * silu(bfhi(zz[cur][pt].y));
            ss += (gy[r][pt][0] * gy[r][pt][0] + gy[r][pt][1] * gy[r][pt][1]) + (gy[r][pt][2] * gy[r][pt][2] + gy[r][pt][3] * gy[r][pt][3]); } }
#undef SSDF_LOAD
    ss += __shfl_xor(ss, 16); ss += __shfl_xor(ss, 32);
    const float rs = 1.f / sqrtf(ss * (1.f / 256.f) + RMS_EPS); const float* nw = A.in[I_SSDNW] + l * 512 + 256 * g + 4 * fq;
#pragma unroll
    for (int r = 0; r < 4; ++r)
#pragma unroll
        for (int pt = 0; pt < 4; ++pt) { const f32x4 n4 = *(const f32x4*)(nw + 64 * r + 16 * pt); v2u o; o.x = pk2(gy[r][pt][0] * rs * n4[0], gy[r][pt][1] * rs * n4[1]); o.y = pk2(gy[r][pt][2] * rs * n4[2], gy[r][pt][3] * rs * n4[3]);
            *(v2u*)((dry ? (bf16*)(F.ws + WS_ST) + (size_t)lrow * 512 + 256 * g + 4 * fq : yc) + 64 * r + 16 * pt) = o; }
}
__device__ __forceinline__ void gmlp(Frame& F, const Args& A, int l, int unit) {
    const int row0 = unit * 128; const int lane = F.lane, w = F.wave, fr = lane & 15, fq = lane >> 4;
    const GAS bf16* proj = (const GAS bf16*)(F.ws + WS_PROJ); LAS unsigned char* lds = F.lds;
    const int trow = row0 + 16 * w + fr; const GAS bf16* GMW = (const GAS bf16*)(F.ws + WS_GMW) + (size_t)l * 4 * 128 * 128;
    v2u wv[16], guv[16]; bf16x8 wf[4][4]; float bs[4];
#pragma unroll
    for (int i = 0; i < 16; ++i) wv[i] = *(const GAS v2u*)(proj + (size_t)(row0 + 16 * w + i) * NPROJ + PGV + 4 * lane);
#pragma unroll
    for (int ct = 0; ct < 16; ++ct) guv[ct] = *(const GAS v2u*)(proj + (size_t)trow * NPROJ + PGU + 16 * ct + 4 * fq);
#pragma unroll
    for (int gi = 0; gi < 4; ++gi) { bs[gi] = A.in[I_GMBS][(l * 4 + gi) * 128 + 16 * w + fr];
#pragma unroll
        for (int ks = 0; ks < 4; ++ks) wf[gi][ks] = *(const GAS bf16x8*)(GMW + ((size_t)gi * 128 + 16 * w + fr) * 128 + 32 * ks + 8 * fq); }
    { const f32x4 lg = *(const f32x4*)(A.in[I_GMLNG] + l * 256 + 4 * lane), lb = *(const f32x4*)(A.in[I_GMLNB] + l * 256 + 4 * lane);
#pragma unroll
      for (int i0 = 0; i0 < 16; i0 += 4) { float v[4][4], sm[4], s2[4];
#pragma unroll
          for (int i = 0; i < 4; ++i) { const f32x2 g0 = gelu_pk((f32x2){bflo(wv[i0 + i].x), bfhi(wv[i0 + i].x)}), g1 = gelu_pk((f32x2){bflo(wv[i0 + i].y), bfhi(wv[i0 + i].y)});
              v[i][0] = g0.x; v[i][1] = g0.y; v[i][2] = g1.x; v[i][3] = g1.y; sm[i] = (v[i][0] + v[i][1]) + (v[i][2] + v[i][3]); }
#pragma unroll
          for (int o = 1; o < 64; o <<= 1) {
#pragma unroll
              for (int i = 0; i < 4; ++i) sm[i] += __shfl_xor(sm[i], o); }
#pragma unroll
          for (int i = 0; i < 4; ++i) { const float mean = sm[i] * (1.f / 256.f); s2[i] = 0.f;
#pragma unroll
              for (int k = 0; k < 4; ++k) { v[i][k] -= mean; s2[i] += v[i][k] * v[i][k]; } }
#pragma unroll
          for (int o = 1; o < 64; o <<= 1) {
#pragma unroll
              for (int i = 0; i < 4; ++i) s2[i] += __shfl_xor(s2[i], o); }
#pragma unroll
          for (int i = 0; i < 4; ++i) { const float rstd = 1.f / sqrtf(s2[i] * (1.f / 256.f) + LN_EPS); const int sr = 16 * w + i0 + i;
              v2u o; o.x = pk2(v[i][0] * rstd * lg[0] + lb[0], v[i][1] * rstd * lg[1] + lb[1]); o.y = pk2(v[i][2] * rstd * lg[2] + lb[2], v[i][3] * rstd * lg[3] + lb[3]); *(LAS v2u*)(lds + (sr * XP + 4 * lane) * 2) = o; } } }
    __syncthreads();
    GAS bf16* yc = (GAS bf16*)(F.ws + WS_A) + (size_t)trow * 1024 + 768 + 4 * fq;
#pragma unroll
    for (int ct = 0; ct < 16; ++ct) { f32x4 acc = {0.f, 0.f, 0.f, 0.f};
#pragma unroll
        for (int ks = 0; ks < 4; ++ks) { const bf16x8 vf = MIX_CAT(trd(lds, XP * 2, 32 * ks + 8 * fq, 16 * ct, lane), trd(lds, XP * 2, 32 * ks + 8 * fq + 4, 16 * ct, lane)); acc = MIX_MFMA(vf, wf[ct >> 2][ks], acc); }
        const f32x2 g0 = gelu_pk((f32x2){bflo(guv[ct].x), bfhi(guv[ct].x)}), g1 = gelu_pk((f32x2){bflo(guv[ct].y), bfhi(guv[ct].y)}); const float bb = bs[ct >> 2];
        v2u o; o.x = pk2(g0.x * (acc[0] + bb), g0.y * (acc[1] + bb)); o.y = pk2(g1.x * (acc[2] + bb), g1.y * (acc[3] + bb)); *(GAS v2u*)(yc + 16 * ct) = o; }
    __syncthreads();
}
#undef MIX_MFMA
#undef MIX_CAT
}
__device__ __forceinline__ void moe_offsets(Frame& F, int (&poff)[9]) {
    int acc = 0;
#pragma unroll
    for (int e = 0; e < 8; ++e) { const int c = (int)__hip_atomic_load(F.ctl + CW_CNT + e * 64, RLX_AGENT); poff[e] = acc; acc += (c + 255) >> 8; }
    poff[8] = acc;
}
__device__ __forceinline__ void moe_permute(Frame& F) {
    int poff[9]; moe_offsets(F, poff);
    const int* re = (const int*)(F.ws + WS_ROUTE); int* rs = (int*)(F.ws + WS_ROUTE) + 2 * M_;
    const bf16* hb = (const bf16*)(F.ws + WS_A); unsigned char* hp = F.ws + WS_HP;
    const int gwv = F.bid * NWAVES + F.wave, NGW = F.G * NWAVES;
    for (int m = gwv; m < M_; m += NGW) {
        const GAS v4u* src = (const GAS v4u*)(hb + (size_t)m * 1024);
        const v4u c0 = src[2 * F.lane], c1 = src[2 * F.lane + 1]; v4u o;
        o.x = pg8::fp8x4((f32x4){bflo(c0.x), bfhi(c0.x), bflo(c0.y), bfhi(c0.y)}); o.y = pg8::fp8x4((f32x4){bflo(c0.z), bfhi(c0.z), bflo(c0.w), bfhi(c0.w)});
        o.z = pg8::fp8x4((f32x4){bflo(c1.x), bfhi(c1.x), bflo(c1.y), bfhi(c1.y)}); o.w = pg8::fp8x4((f32x4){bflo(c1.z), bfhi(c1.z), bflo(c1.w), bfhi(c1.w)});
#pragma unroll
        for (int k = 0; k < 2; ++k) { const int e = re[k * M_ + m], sl = rs[k * M_ + m]; int po = 0;
#pragma unroll
            for (int q = 0; q < 8; ++q) po = (e == q) ? poff[q] : po;
            const int prow = po * 256 + sl;
            ((GAS v4u*)(hp + (size_t)prow * 1024))[F.lane] = o;
            if (F.lane == 0) rs[k * M_ + m] = prow; }
    }
}
__device__ __forceinline__ void ln_moe_final(Frame& F, const Args& A, const float* g, const float* bt, int ls, bool dry) {
    const int gwv = F.bid * NWAVES + F.wave, NGW = F.G * NWAVES;
    const float* mod = (const float*)(F.ws + WS_MOD); const int* rs = (const int*)(F.ws + WS_ROUTE) + 2 * M_; const float* rg = (const float*)(F.ws + WS_ROUTE) + 4 * M_;
    const bf16* yp = (const bf16*)(F.ws + WS_YP); const bf16* xs = (const bf16*)(F.ws + WS_XS);
    for (int m = gwv * 2; m < M_; m += NGW * 2) { f32x4 x[2][4];
#pragma unroll
        for (int i = 0; i < 2; ++i) { const int p0 = rs[m + i], p1 = rs[M_ + m + i]; const float g0 = rg[m + i], g1 = rg[M_ + m + i];
            f32x4 xv[4], y0[4], y1[4]; load_row(nullptr, xs + (size_t)(m + i) * 1024, xv, F.lane); load_row(nullptr, yp + (size_t)p0 * 1024, y0, F.lane); load_row(nullptr, yp + (size_t)p1 * 1024, y1, F.lane);
            const float* gt = mod + ((size_t)ls * 8 + ((m + i) >> 12)) * 3072 + 2048;
#pragma unroll
            for (int j = 0; j < 4; ++j) { const f32x4 gv = *(const GAS f32x4*)(gt + lcol(F.lane, j)); x[i][j] = xv[j] * DN_ALPHA + (gv + 1.f) * (y0[j] * g0 + y1[j] * g1); } }
        ln_rows<2>(g, bt, x, F.lane);
#pragma unroll
        for (int i = 0; i < 2; ++i) store_rows(x[i], nullptr, (dry ? (float*)(F.ws + WS_PROJ) : F.out) + (size_t)(m + i) * 1024, nullptr, mod, F.lane);
    }
}
constexpr int N_PHASES = 21;
#define MODP ((const float*)(F.ws + WS_MOD))
#define HA ((bf16*)(F.ws + WS_A))
#define PROJ ((bf16*)(F.ws + WS_PROJ))
#ifndef PHMASK
#define PHMASK 0x7FFF
#endif
#define EN(k) (((PHMASK) >> (k)) & 1)
#ifndef PROBE_SITE
#define PROBE_SITE -1
#endif
#define NREP(k) ((PROBE_SITE) == (k) ? 2 : 1)
__global__ void __launch_bounds__(NTHR, 2) fwd_kernel(Args args) {
    extern __shared__ __attribute__((aligned(16))) unsigned char lds[];
    Frame F0;
    F0.lds = (LAS unsigned char*)lds; F0.tid = threadIdx.x; F0.lane = F0.tid & 63; F0.wave = __builtin_amdgcn_readfirstlane(F0.tid >> 6);
    F0.G = gridDim.x; F0.bid = blockIdx.x; F0.ws = args.ws; F0.ctl = (gu32*)(args.ws + WS_CTL); F0.out = args.out;
    for (int u = F0.tid; u < (LDS_BYTES - LDSCTL_OFF) / 4; u += NTHR) ((LAS unsigned*)(F0.lds + LDSCTL_OFF))[u] = 0u;
    __syncthreads();
#if N_LAUNCH_MODE == 0
    XcdBarrier bar = xcd_barrier_post((unsigned*)(F0.ctl + CW_BAR), (volatile LAS unsigned*)(F0.lds + MISC_OFF) + 8);
#define GRID_BAR() do { const Frame Fb = phase_frame(F0); xcd_barrier(bar, Fb.tid == 0); } while (0)
#else
#define GRID_BAR() do {} while (0)
#endif
    const int lo = args.ph_lo, hi = args.ph_hi;
#define IN(k) (lo <= (k) && (k) < hi)
#define SEAM(k) do { if (IN(k) && IN((k) + 1)) GRID_BAR(); } while (0)

    if (EN(0) && IN(0)) for (int rep = 0; rep < NREP(0); ++rep) { Frame F = phase_frame(F0); const bool dry = rep > 0; (void)dry; p0a(F, args); } SEAM(0);
    if (EN(1) && IN(1)) for (int rep = 0; rep < NREP(1); ++rep) { Frame F = phase_frame(F0); const bool dry = rep > 0; (void)dry; ln_phase(F, args, args.in[I_X], args.in[I_LN0G], args.in[I_LN0B], 0, false, false); } SEAM(1);

    for (int l = 0; l < 2; ++l) {
        const int base = l == 0 ? 2 : 11;
        if (EN(2) && IN(base + 0)) for (int rep = 0; rep < NREP(2); ++rep) { Frame F = phase_frame(F0); const bool dry = rep > 0; (void)dry;
            pg8::Gemm g{HA, (const bf16*)(F.ws + WS_WIN + l * WIN_BYTES), M_, NPROJ, 1024, 1024, 0, 0}; pg8::StaticOrder S; S.init(M_, NPROJ, F.G, F.bid);
            pg8::EpiProj E{PROJ, (float*)(F.ws + WS_DTV)};
            pg8::gemm_phase<pg8::EpiProj, pg8::StaticOrder, true, true>(F.lds + RING_OFF, g, S, E, F.tid);
        } SEAM(base + 0);
#if PROBE_SITE == 100
        for (int xb = 0; xb < 8; ++xb) GRID_BAR();
#endif
        if (EN(3) && IN(base + 1)) for (int rep = 0; rep < NREP(3); ++rep) { Frame F = phase_frame(F0); const bool dry = rep > 0; (void)dry;
            token_local(F);
#if PROBE_SITE == 31
            token_local(F);
#endif
#ifdef MIX_NAIVE
            for (int u = F.bid; u < NB * NCH * 8; u += F.G) ssd_chunk_naive(F, args, l, u);
            for (int u = F.bid; u < NB * NCH; u += F.G) gmlp_naive(F, args, l, u);
#else
            for (int u = F.bid; u < NB * NCH * 2; u += F.G) mix::ssd_chunk(F, args, l, u);
#if PROBE_SITE == 32
            for (int u = F.bid; u < NB * NCH * 2; u += F.G) mix::ssd_chunk(F, args, l, u);
#endif
            for (int u = F.bid; u < NB * NCH; u += F.G) mix::gmlp(F, args, l, u);
#if PROBE_SITE == 33
            for (int u = F.bid; u < NB * NCH; u += F.G) mix::gmlp(F, args, l, u);
#endif
#endif
        } SEAM(base + 1);
        if (EN(4) && IN(base + 2)) for (int rep = 0; rep < NREP(4); ++rep) { Frame F = phase_frame(F0); const bool dry = rep > 0; (void)dry;
#ifdef MIX_NAIVE
            state_scan(F);
#else
            mix::state_scan2(F);
#endif
            { pg8::Gemm g{PROJ + PQ, (const bf16*)(F.ws + WS_WQB + l * WQB_BYTES), M_, 1024, 256, NPROJ, WS_WKVB - WS_WQB, (size_t)(PKV - PQ) * 2}; pg8::QkvOrder S; S.init(M_, 1024, F.G, F.bid);
              pg8::EpiQKV E{{(bf16*)(F.ws + WS_Q), (const float*)(F.ws + WS_RSTD), (const float*)(F.ws + WS_ROPE), (const float*)(F.ws + WS_ROPE) + 4096 * 16, QSCALE},
                            {(bf16*)(F.ws + WS_KN), (bf16*)(F.ws + WS_V), (const float*)(F.ws + WS_RSTD) + M_}};
              pg8::gemm_phase<pg8::EpiQKV, pg8::QkvOrder, true, true>(F.lds + RING_OFF, g, S, E, F.tid); }
        } SEAM(base + 2);
        if (EN(5) && IN(base + 3)) for (int rep = 0; rep < NREP(5); ++rep) { Frame F = phase_frame(F0); const bool dry = rep > 0; (void)dry;
#ifdef MIX_NAIVE
            for (int u = F.bid; u < NB * NCH * 2; u += F.G) ssd_finish_naive(F, args, l, u);
#else
#if PROBE_SITE == 55
            for (int u = F.bid; u < NB * NCH * 2; u += F.G) mix::ssd_finish(F, args, l, u, true);
#endif
            if (!dry) for (int u = F.bid; u < NB * NCH * 2; u += F.G) mix::ssd_finish(F, args, l, u);
#endif
#ifdef ATTN_NAIVE
            for (int u = F.bid; u < NB * 4 * 64; u += F.G) attn_naive(F, u);
#else
            for (int v0 = F.bid; v0 < NB * 4 * 8; v0 += F.G) { const int v = (F.G == 256) ? (v0 & 7) * 32 + (v0 >> 3) : v0;
                const int bh = v >> 3, s = v & 7; att::attn_unit(F, bh >> 2, bh & 3, s); att::attn_unit(F, bh >> 2, bh & 3, 15 - s); }
#endif
        } SEAM(base + 3);
        if (EN(6) && IN(base + 4)) for (int rep = 0; rep < NREP(6); ++rep) { Frame F = phase_frame(F0); const bool dry = rep > 0; (void)dry;
            pg8::Gemm g{HA, (const bf16*)(F.ws + WS_WOUT + l * WOUT_BYTES), M_, 1024, 1024, 1024, 0, 0}; pg8::StaticOrder S; S.init(M_, 1024, F.G, F.bid);
            pg8::EpiResid E{(bf16*)(F.ws + WS_XS), MODP + (size_t)((l * 2 + 0) * 8) * 3072 + 2048, DN_ALPHA, dry, 1.f};
            pg8::gemm_phase<pg8::EpiResid, pg8::StaticOrder, true, true>(F.lds + RING_OFF, g, S, E, F.tid);
        } SEAM(base + 4);
        if (EN(7) && IN(base + 5)) for (int rep = 0; rep < NREP(7); ++rep) { Frame F = phase_frame(F0); const bool dry = rep > 0; (void)dry; ln_phase(F, args, nullptr, args.in[I_PLG] + (l * 2 + 0) * 1024, args.in[I_PLB] + (l * 2 + 0) * 1024, l * 2 + 1, l == 1, dry); } SEAM(base + 5);
        if (l == 0) {
            if (EN(9) && IN(base + 6)) for (int rep = 0; rep < NREP(9); ++rep) { Frame F = phase_frame(F0);
                pg8::Gemm g{HA, (const bf16*)(F.ws + WS_W13), M_, 5632, 1024, 1024, 0, 0}; pg8::StaticOrder S; S.init(M_, 5632, F.G, F.bid);
                pg8::EpiSwiGLU E{(void*)(F.ws + WS_ACT), FF, 1.f, 0.f};
                pg8::gemm_phase<pg8::EpiSwiGLU, pg8::StaticOrder, true, true, 2>(F.lds + RING_OFF, g, S, E, F.tid);
            } SEAM(base + 6);
            if (EN(10) && IN(base + 7)) for (int rep = 0; rep < NREP(10); ++rep) { Frame F = phase_frame(F0); const bool dry = rep > 0;
                pg8::Gemm g{(const bf16*)(F.ws + WS_ACT), (const bf16*)(F.ws + WS_W2), M_, 1024, FF, FF, 0, 0}; pg8::StaticOrder S; S.init(M_, 1024, F.G, F.bid);
                pg8::EpiResid E{(bf16*)(F.ws + WS_XS), MODP + (size_t)((l * 2 + 1) * 8) * 3072 + 2048, DN_ALPHA, dry, 1.f};
                pg8::gemm_phase<pg8::EpiResid, pg8::StaticOrder, true, true, 2>(F.lds + RING_OFF, g, S, E, F.tid);
            } SEAM(base + 7);
            if (EN(11) && IN(base + 8)) for (int rep = 0; rep < NREP(11); ++rep) { Frame F = phase_frame(F0); const bool dry = rep > 0;
                ln_phase(F, args, nullptr, args.in[I_PLG] + (l * 2 + 1) * 1024, args.in[I_PLB] + (l * 2 + 1) * 1024, 2, false, dry); } SEAM(base + 8);
        } else {
            if (EN(8) && IN(base + 6)) for (int rep = 0; rep < NREP(8); ++rep) { Frame F = phase_frame(F0); moe_permute(F); } SEAM(base + 6);
            if (EN(12) && IN(base + 7)) for (int rep = 0; rep < NREP(12); ++rep) { Frame F = phase_frame(F0);
                pg8::MoeOrder S; moe_offsets(F, S.poff); const int npan = S.poff[8]; S.init(npan * 256, 5632, F.G, F.bid);
                pg8::Gemm g{(const bf16*)(F.ws + WS_HP), (const bf16*)(F.ws + WS_MW13), npan * 256, 5632, 1024, 1024, W13_BYTES / 2, 0};
                pg8::EpiSwiGLU E{(void*)(F.ws + WS_ACTM), FF, 1.f / 32.f, 8.f};
                pg8::gemm_phase<pg8::EpiSwiGLU, pg8::MoeOrder, true, true, 1>(F.lds + RING_OFF, g, S, E, F.tid);
            } SEAM(base + 7);
            if (EN(13) && IN(base + 8)) for (int rep = 0; rep < NREP(13); ++rep) { Frame F = phase_frame(F0);
                pg8::MoeOrder S; moe_offsets(F, S.poff); const int npan = S.poff[8]; S.init(npan * 256, 1024, F.G, F.bid);
                pg8::Gemm g{(const bf16*)(F.ws + WS_ACTM), (const bf16*)(F.ws + WS_MW2), npan * 256, 1024, FF, FF, W2_BYTES / 2, 0};
                pg8::EpiY E{(bf16*)(F.ws + WS_YP), 1024, 1.f / 1024.f};
                pg8::gemm_phase<pg8::EpiY, pg8::MoeOrder, true, true, 1>(F.lds + RING_OFF, g, S, E, F.tid);
            } SEAM(base + 8);
            if (EN(14) && IN(base + 9)) for (int rep = 0; rep < NREP(14); ++rep) { Frame F = phase_frame(F0); const bool dry = rep > 0;
                ln_moe_final(F, args, args.in[I_PLG] + (l * 2 + 1) * 1024, args.in[I_PLB] + (l * 2 + 1) * 1024, l * 2 + 1, dry); }
        }
    }
}

extern "C" void kernel_launch(void* const* d_in, const int* in_sizes, int n_in, void* d_out, int out_size, void* d_ws, size_t ws_size, hipStream_t stream) {
    static int grid = 0;
    if (grid == 0) {
        if (n_in != 31 || out_size != M_ * D_ || ws_size < WS_END) { fprintf(stderr, "kernel_launch: unexpected shapes (n_in %d, out %d, ws %zu)\n", n_in, out_size, ws_size); grid = -1; return; }
        int dev = 0, cus = 0;
        if (hipGetDevice(&dev) != hipSuccess || hipDeviceGetAttribute(&cus, hipDeviceAttributeMultiprocessorCount, dev) != hipSuccess) { grid = -1; return; }
        if (hipFuncSetAttribute((const void*)fwd_kernel, hipFuncAttributeMaxDynamicSharedMemorySize, LDS_BYTES) != hipSuccess) { fprintf(stderr, "kernel_launch: hipFuncSetAttribute failed\n"); grid = -1; return; }
        int per_cu = 0;
        if (hipOccupancyMaxActiveBlocksPerMultiprocessor(&per_cu, (const void*)fwd_kernel, NTHR, LDS_BYTES) != hipSuccess || per_cu < 1) fprintf(stderr, "kernel_launch: occupancy query reports %d\n", per_cu);
        (void)hipGetLastError();
        grid = cus;
    }
    if (grid < 0) return;
    (void)hipMemsetAsync((char*)d_ws + WS_CTL, 0, CTL_ZERO_BYTES, stream);
    Args a{};
    for (int i = 0; i < 31; ++i) a.in[i] = (const float*)d_in[i];
    a.out = (float*)d_out; a.ws = (unsigned char*)d_ws;
#if N_LAUNCH_MODE == 0
    a.ph_lo = 0; a.ph_hi = N_PHASES;
    hipLaunchKernelGGL(fwd_kernel, dim3(grid), dim3(NTHR), LDS_BYTES, stream, a);
#else
    for (int p = 0; p < N_PHASES; ++p) { a.ph_lo = p; a.ph_hi = p + 1; hipLaunchKernelGGL(fwd_kernel, dim3(grid), dim3(NTHR), LDS_BYTES, stream, a); }
#endif
}
```
